# Optimizing an MI355X kernel written in HIP

```python
import math
import jax, jax.numpy as jnp
from jax import lax
import numpy as np

D_MODEL = 2048
BATCH = 4
SEQ = 2048
DEPTH = 1

CTX_LEN = 256
GRID_W = 64
MIX_WIDTH = D_MODEL
POOL_WIDTH = MIX_WIDTH // 4
POOL_WINDOWS = (2, 4, 8, 16)
POOL_GROUPS = len(POOL_WINDOWS)
POOL_GROUP_DIM = POOL_WIDTH // POOL_GROUPS
ATTN_WIDTH = MIX_WIDTH - POOL_WIDTH
DIFF_VDIM = 128
DIFF_HEADS = ATTN_WIDTH // DIFF_VDIM
DIFF_QKDIM = DIFF_VDIM // 2
IN_WIDTH = POOL_WIDTH + 3 * ATTN_WIDTH
Q_BLOCK = 128
ROPE_BASE = 10000.0
ROPE_AXIS_DIM = DIFF_QKDIM // 2
PEER_HEADS = 8
PEER_NKEYS = 128
PEER_EXPERTS = PEER_NKEYS * PEER_NKEYS
PEER_QDIM = 256
PEER_HALF = PEER_QDIM // 2
PEER_TOPK = 16
TOKEN_BLOCK = 128
EPS = 1e-6

kernel_name = "hybrid_pool_diffattn_peer_dit_block"


def rmsnorm(x, g):
    xf = x.astype(jnp.float32)
    y = xf * lax.rsqrt(jnp.mean(xf * xf, axis=-1, keepdims=True) + EPS)
    return (y * g.astype(jnp.float32)).astype(x.dtype)


def modulate(h, shift, scale):
    return h * (1 + scale) + shift


def lambda_init(layer_idx):
    return 0.8 - 0.6 * math.exp(-0.3 * layer_idx)


def axial_rope_tables(L):
    n_rows = L // GRID_W
    row = jnp.repeat(jnp.arange(n_rows, dtype=jnp.float32), GRID_W, total_repeat_length=L)
    col = jnp.tile(jnp.arange(GRID_W, dtype=jnp.float32), n_rows)
    half = ROPE_AXIS_DIM // 2
    inv_freq = ROPE_BASE ** (-jnp.arange(half, dtype=jnp.float32) / half)
    ang = jnp.stack([row, col], axis=-1)[:, :, None] * inv_freq
    return jnp.cos(ang), jnp.sin(ang)


def apply_axial_rope(x, cos, sin):
    half = ROPE_AXIS_DIM // 2
    xf = x.astype(jnp.float32).reshape(x.shape[:-1] + (2, 2, half))
    x1, x2 = xf[..., 0, :], xf[..., 1, :]
    c = cos[:, None, None, :, :]
    s = sin[:, None, None, :, :]
    out = jnp.stack([x1 * c - x2 * s, x1 * s + x2 * c], axis=-2)
    return out.reshape(x.shape).astype(x.dtype)


def diff_attend(q, k, v, lam):
    s = jnp.einsum('bqhmd,bkhmd->bhmqk', q, k, preferred_element_type=jnp.float32)
    a = jax.nn.softmax(s * (DIFF_QKDIM ** -0.5), axis=-1)
    a = a[:, :, 0] - lam * a[:, :, 1]
    return jnp.einsum('bhqk,bkhv->bqhv', a.astype(v.dtype), v)


def diff_head_norm(o, subln_g, lam_init):
    B, L = o.shape[0], o.shape[1]
    return (rmsnorm(o, subln_g) * (1.0 - lam_init)).reshape(B, L, ATTN_WIDTH)


def pool_mix(z, pool_w, pool_b, pool_scale):
    B, L = z.shape[0], z.shape[1]
    zg = z.reshape(B, L, POOL_GROUPS, POOL_GROUP_DIM)
    cs = jnp.concatenate([jnp.zeros((B, 1, POOL_GROUPS, POOL_GROUP_DIM), jnp.float32),
                          jnp.cumsum(zg.astype(jnp.float32), axis=1)], axis=1)
    t = jnp.arange(L)
    means = []
    for g, w in enumerate(POOL_WINDOWS):
        lo = jnp.clip(t - w // 2, 0, L)
        hi = jnp.clip(t + w // 2, 0, L)
        total = cs[:, hi, g] - cs[:, lo, g]
        means.append(total / (hi - lo).astype(jnp.float32)[:, None])
    pooled = jnp.stack(means, axis=2)
    y = (pooled - zg.astype(jnp.float32)).astype(z.dtype)
    y = jnp.einsum('blgc,gcd->blgd', y, pool_w) + pool_b
    return y.reshape(B, L, POOL_WIDTH) * pool_scale


def peer(h, peer_wq, peer_keys, peer_u, peer_v):
    B, L, D = h.shape
    hb_all = h.reshape((B * L) // TOKEN_BLOCK, TOKEN_BLOCK, D)

    def block_fn(hb):
        q = (hb @ peer_wq).reshape(TOKEN_BLOCK, PEER_HEADS, 2, PEER_HALF)
        s = jnp.einsum('thpc,hpkc->thpk', q, peer_keys, preferred_element_type=jnp.float32)
        va, ia = lax.top_k(s[:, :, 0], PEER_TOPK)
        vb, ib = lax.top_k(s[:, :, 1], PEER_TOPK)
        cand = (va[..., :, None] + vb[..., None, :]).reshape(TOKEN_BLOCK, PEER_HEADS, PEER_TOPK * PEER_TOPK)
        cand_idx = (ia[..., :, None] * PEER_NKEYS + ib[..., None, :]).reshape(TOKEN_BLOCK, PEER_HEADS, PEER_TOPK * PEER_TOPK)
        top_s, pos = lax.top_k(cand, PEER_TOPK)
        eidx = jnp.take_along_axis(cand_idx, pos, axis=-1)
        gate = jax.nn.softmax(top_s, axis=-1).astype(h.dtype)
        u = peer_u[eidx]
        act = jax.nn.gelu(jnp.einsum('thkd,td->thk', u, hb), approximate=False)
        v = peer_v[eidx]
        return jnp.einsum('thk,thkd->td', gate * act, v)

    return lax.map(block_fn, hb_all).reshape(B, L, D)


def setup_inputs(seed: int = 0) -> dict:
    key = jax.random.key(seed)
    ks = jax.random.split(key, 24)
    f32 = jnp.float32
    nrm = lambda k, shape, s: jax.random.normal(k, shape, f32) * s
    return {
        "x": nrm(ks[0], (BATCH, SEQ, D_MODEL), 1.0),
        "c": nrm(ks[1], (BATCH, D_MODEL), 1.0),
        "ctx": nrm(ks[2], (BATCH, CTX_LEN, D_MODEL), 1.0),
        "c_ctx": nrm(ks[3], (D_MODEL,), 1.0),
        "ada_w": nrm(ks[4], (DEPTH, D_MODEL, 6 * D_MODEL), 0.5 * D_MODEL ** -0.5),
        "ada_b": nrm(ks[5], (DEPTH, 6 * D_MODEL), 0.02),
        "norm1_g": 1.0 + nrm(ks[6], (DEPTH, D_MODEL), 0.02),
        "w_in": nrm(ks[7], (DEPTH, D_MODEL, IN_WIDTH), D_MODEL ** -0.5),
        "pool_w": nrm(ks[8], (DEPTH, POOL_GROUPS, POOL_GROUP_DIM, POOL_GROUP_DIM), POOL_GROUP_DIM ** -0.5),
        "pool_b": nrm(ks[9], (DEPTH, POOL_GROUPS, POOL_GROUP_DIM), 0.02),
        "pool_scale": 1.0 + nrm(ks[10], (DEPTH, POOL_WIDTH), 0.02),
        "diff_lambda": nrm(ks[11], (DEPTH, 4, DIFF_QKDIM), 0.1),
        "subln_g": 1.0 + nrm(ks[12], (DEPTH, DIFF_VDIM), 0.02),
        "w_out": nrm(ks[13], (DEPTH, MIX_WIDTH, D_MODEL), MIX_WIDTH ** -0.5),
        "norm2_g": 1.0 + nrm(ks[14], (DEPTH, D_MODEL), 0.02),
        "peer_wq": nrm(ks[15], (DEPTH, D_MODEL, PEER_HEADS * PEER_QDIM), D_MODEL ** -0.5),
        "peer_keys": nrm(ks[16], (DEPTH, PEER_HEADS, 2, PEER_NKEYS, PEER_HALF), PEER_HALF ** -0.5),
        "peer_u": nrm(ks[17], (DEPTH, PEER_EXPERTS, D_MODEL), D_MODEL ** -0.5),
        "peer_v": nrm(ks[18], (DEPTH, PEER_EXPERTS, D_MODEL), 0.5),
        "final_g": 1.0 + nrm(ks[19], (D_MODEL,), 0.02),
    }


def reference(x, c, ctx, c_ctx, ada_w, ada_b, norm1_g, w_in, pool_w, pool_b, pool_scale,
              diff_lambda, subln_g, w_out, norm2_g, peer_wq, peer_keys, peer_u, peer_v, final_g):
    B, L, D = x.shape
    C = ctx.shape[1]
    n_blocks = L // Q_BLOCK
    cos, sin = axial_rope_tables(L)
    split_pts = [POOL_WIDTH, POOL_WIDTH + ATTN_WIDTH, POOL_WIDTH + 2 * ATTN_WIDTH]

    def project(h, l):
        z_pool, z_q, z_k, z_v = jnp.split(h @ w_in[l], split_pts, axis=-1)
        Bh, Lh = h.shape[0], h.shape[1]
        q = z_q.reshape(Bh, Lh, DIFF_HEADS, 2, DIFF_QKDIM)
        k = z_k.reshape(Bh, Lh, DIFF_HEADS, 2, DIFF_QKDIM)
        v = z_v.reshape(Bh, Lh, DIFF_HEADS, DIFF_VDIM)
        return z_pool, q, k, v

    for l in range(DEPTH):
        last = l == DEPTH - 1
        lam_init = lambda_init(l)
        lq = diff_lambda[l].astype(jnp.float32)
        lam = jnp.exp(jnp.sum(lq[0] * lq[1])) - jnp.exp(jnp.sum(lq[2] * lq[3])) + lam_init

        mod_lat = jax.nn.silu(c) @ ada_w[l] + ada_b[l]
        mod_ctx = jax.nn.silu(c_ctx) @ ada_w[l] + ada_b[l]
        sh1, sc1, g1, sh2, sc2, g2 = [m[:, None, :] for m in jnp.split(mod_lat, 6, axis=-1)]
        csh1, csc1, cg1, csh2, csc2, cg2 = jnp.split(mod_ctx, 6, axis=-1)

        h_lat = modulate(rmsnorm(x, norm1_g[l]), sh1, sc1)
        h_ctx = modulate(rmsnorm(ctx, norm1_g[l]), csh1, csc1)
        zp_lat, q_lat, k_lat, v_lat = project(h_lat, l)
        zp_ctx, q_ctx, k_ctx, v_ctx = project(h_ctx, l)
        q_lat = apply_axial_rope(q_lat, cos, sin)
        k_lat = apply_axial_rope(k_lat, cos, sin)
        k_all = jnp.concatenate([k_ctx, k_lat], axis=1)
        v_all = jnp.concatenate([v_ctx, v_lat], axis=1)

        q_blocks = q_lat.reshape(B, n_blocks, Q_BLOCK, DIFF_HEADS, 2, DIFF_QKDIM).transpose(1, 0, 2, 3, 4, 5)
        o_lat = lax.map(lambda qb: diff_attend(qb, k_all, v_all, lam), q_blocks)
        o_lat = o_lat.transpose(1, 0, 2, 3, 4).reshape(B, L, DIFF_HEADS, DIFF_VDIM)
        attn_lat = diff_head_norm(o_lat, subln_g[l], lam_init)
        pool_lat = pool_mix(zp_lat, pool_w[l], pool_b[l], pool_scale[l])
        x = x + g1 * (jnp.concatenate([pool_lat, attn_lat], axis=-1) @ w_out[l])

        if not last:
            o_ctx = diff_attend(q_ctx, k_ctx, v_ctx, lam)
            attn_ctx = diff_head_norm(o_ctx, subln_g[l], lam_init)
            pool_ctx = pool_mix(zp_ctx, pool_w[l], pool_b[l], pool_scale[l])
            ctx = ctx + cg1 * (jnp.concatenate([pool_ctx, attn_ctx], axis=-1) @ w_out[l])

        f_lat = modulate(rmsnorm(x, norm2_g[l]), sh2, sc2)
        x = x + g2 * peer(f_lat, peer_wq[l], peer_keys[l], peer_u[l], peer_v[l])
        if not last:
            f_ctx = modulate(rmsnorm(ctx, norm2_g[l]), csh2, csc2)
            ctx = ctx + cg2 * peer(f_ctx, peer_wq[l], peer_keys[l], peer_u[l], peer_v[l])

    return rmsnorm(x, final_g)
```

```cpp
#include <hip/hip_runtime.h>
#include <math.h>
#include <stdint.h>

namespace {
constexpr int D = 2048, NB = 4, L = 2048, CT = 256;
constexpr int NLAT = NB * L;
constexpr int NCTX = NB * CT;
constexpr int NTOK = NLAT + NCTX;
constexpr int INW = 5120, POOLW = 512, ATTW = 1536, NH = 12, DV = 128, DQK = 64;
constexpr int QOFF = POOLW, KOFF = POOLW + ATTW, VOFF = POOLW + 2 * ATTW;
constexpr int LK = CT + L;
constexpr int PH = 8, PNK = 128, PTOPK = 16;
constexpr float EPS = 1e-6f;

__global__ void k_prep(const float* __restrict__ dl, float* __restrict__ lam_out, float* __restrict__ rope  ) {
    int gid = blockIdx.x * blockDim.x + threadIdx.x;
    if (gid == 0) {
        double s01 = 0, s23 = 0;
        for (int i = 0; i < 64; ++i) { s01 += (double)dl[i] * dl[64 + i]; s23 += (double)dl[128 + i] * dl[192 + i]; }
        lam_out[0] = (float)(exp(s01) - exp(s23) + 0.2);
    }
    if (gid < L * 32) {
        int t = gid / 32, a = (gid / 16) & 1, i = gid & 15;
        double pos = a == 0 ? (double)(t / 64) : (double)(t % 64);
        double invf = pow(10000.0, -(double)i / 16.0);
        double ang = pos * invf;
        rope[gid * 2 + 0] = (float)cos(ang);
        rope[gid * 2 + 1] = (float)sin(ang);
    }
}

__global__ void k_ada(const float* __restrict__ c, const float* __restrict__ cctx, const float* __restrict__ w, const float* __restrict__ bvec, float* __restrict__ mod) {
    __shared__ float sv[5][D];
    for (int i = threadIdx.x; i < 5 * D; i += blockDim.x) {
        int r = i / D, k = i % D;
        float x = r < 4 ? c[r * D + k] : cctx[k];
        sv[r][k] = x / (1.f + expf(-x));
    }
    __syncthreads();
    int j = blockIdx.x * blockDim.x + threadIdx.x;
    float a0 = 0, a1 = 0, a2 = 0, a3 = 0, a4 = 0;
#pragma unroll 8
    for (int k = 0; k < D; ++k) {
        float wv = w[(size_t)k * (6 * D) + j];
        a0 += sv[0][k] * wv; a1 += sv[1][k] * wv; a2 += sv[2][k] * wv; a3 += sv[3][k] * wv; a4 += sv[4][k] * wv;
    }
    float bb = bvec[j];
    mod[0 * 6 * D + j] = a0 + bb; mod[1 * 6 * D + j] = a1 + bb; mod[2 * 6 * D + j] = a2 + bb; mod[3 * 6 * D + j] = a3 + bb; mod[4 * 6 * D + j] = a4 + bb;
}

__global__ void k_norm_mod(const float* __restrict__ xlat, const float* __restrict__ xctx, int nlat, const float* __restrict__ g,
                           const float* __restrict__ mod, int sh_off, int sc_off, float* __restrict__ out) {
    int row = blockIdx.x, tid = threadIdx.x;
    const float* xr = row < nlat ? xlat + (size_t)row * D : xctx + (size_t)(row - nlat) * D;
    int mr = row < nlat ? row / L : 4;
    float v[8]; float ss = 0;
#pragma unroll
    for (int i = 0; i < 8; ++i) { v[i] = xr[tid + 256 * i]; ss += v[i] * v[i]; }
    __shared__ float red[256];
    red[tid] = ss; __syncthreads();
    for (int s = 128; s > 0; s >>= 1) { if (tid < s) red[tid] += red[tid + s]; __syncthreads(); }
    float rstd = 1.0f / sqrtf(red[0] / (float)D + EPS);
    const float* mrow = mod + (size_t)mr * 6 * D;
#pragma unroll
    for (int i = 0; i < 8; ++i) {
        int col = tid + 256 * i;
        out[(size_t)row * D + col] = v[i] * rstd * g[col] * (1.f + mrow[sc_off + col]) + mrow[sh_off + col];
    }
}

__global__ void __launch_bounds__(256) k_gemm(const float* __restrict__ A, int lda, const float* __restrict__ Bm, int ldb, float* __restrict__ Cm, int ldc, int K,
                                              const float* __restrict__ resid, const float* __restrict__ gate, int gate_stride) {
    __shared__ float As[16][128 + 4];
    __shared__ float Bs[16][128 + 4];
    int tid = threadIdx.x, tx = tid & 15, ty = tid >> 4;
    int m0 = blockIdx.y * 128, n0 = blockIdx.x * 128;
    float acc[8][8];
#pragma unroll
    for (int i = 0; i < 8; ++i)
#pragma unroll
        for (int j = 0; j < 8; ++j) acc[i][j] = 0.f;
    for (int k0 = 0; k0 < K; k0 += 16) {
#pragma unroll
        for (int p = 0; p < 2; ++p) {
            int r = (tid >> 2) + 64 * p, kk = (tid & 3) * 4;
            float4 a = *(const float4*)&A[(size_t)(m0 + r) * lda + k0 + kk];
            As[kk + 0][r] = a.x; As[kk + 1][r] = a.y; As[kk + 2][r] = a.z; As[kk + 3][r] = a.w;
            int kb = (tid >> 5) + 8 * p, nn = (tid & 31) * 4;
            float4 b = *(const float4*)&Bm[(size_t)(k0 + kb) * ldb + n0 + nn];
            *(float4*)&Bs[kb][nn] = b;
        }
        __syncthreads();
#pragma unroll
        for (int kk = 0; kk < 16; ++kk) {
            float4 a0 = *(const float4*)&As[kk][ty * 4], a1 = *(const float4*)&As[kk][64 + ty * 4];
            float4 b0 = *(const float4*)&Bs[kk][tx * 4], b1 = *(const float4*)&Bs[kk][64 + tx * 4];
            float av[8] = {a0.x, a0.y, a0.z, a0.w, a1.x, a1.y, a1.z, a1.w};
            float bv[8] = {b0.x, b0.y, b0.z, b0.w, b1.x, b1.y, b1.z, b1.w};
#pragma unroll
            for (int i = 0; i < 8; ++i)
#pragma unroll
                for (int j = 0; j < 8; ++j) acc[i][j] += av[i] * bv[j];
        }
        __syncthreads();
    }
#pragma unroll
    for (int i = 0; i < 8; ++i) {
        int row = m0 + (i < 4 ? ty * 4 + i : 64 + ty * 4 + (i - 4));
#pragma unroll
        for (int jh = 0; jh < 2; ++jh) {
            int col = n0 + jh * 64 + tx * 4;
            float4 o = make_float4(acc[i][jh * 4 + 0], acc[i][jh * 4 + 1], acc[i][jh * 4 + 2], acc[i][jh * 4 + 3]);
            if (resid) {
                float4 r = *(const float4*)&resid[(size_t)row * ldc + col];
                float4 gv = *(const float4*)&gate[(size_t)(row / L) * gate_stride + col];
                o.x = r.x + gv.x * o.x; o.y = r.y + gv.y * o.y; o.z = r.z + gv.z * o.z; o.w = r.w + gv.w * o.w;
            }
            *(float4*)&Cm[(size_t)row * ldc + col] = o;
        }
    }
}

__global__ void k_rope(float* __restrict__ z, const float* __restrict__ rope) {
    size_t gid = (size_t)blockIdx.x * blockDim.x + threadIdx.x;
    if (gid >= (size_t)NLAT * 1536) return;
    int row = (int)(gid / 1536), r = (int)(gid % 1536);
    int kind = r / 768, rr = r % 768, h = rr / 64, r2 = rr % 64, m = r2 / 32, a = (r2 / 16) & 1, i = r2 & 15;
    int t = row % L;
    float cs = rope[((t * 2 + a) * 16 + i) * 2 + 0], sn = rope[((t * 2 + a) * 16 + i) * 2 + 1];
    size_t base = (size_t)row * INW + (kind == 0 ? QOFF : KOFF) + h * 128 + m * 64 + a * 32 + i;
    float x1 = z[base], x2 = z[base + 16];
    z[base] = x1 * cs - x2 * sn;
    z[base + 16] = x1 * sn + x2 * cs;
}

constexpr int AQR = 4;
__global__ void __launch_bounds__(256) k_attn(const float* __restrict__ z, const float* __restrict__ lamp, const float* __restrict__ subg, float* __restrict__ mix) {
    extern __shared__ float sm[];
    float* sa = sm;
    float* ss = sm + AQR * LK;
    float* qs = ss + AQR * LK;
    float* red = qs + AQR * 64;
    float* po = red + 256;
    const int tid = threadIdx.x;
    const int qt = blockIdx.x, h = blockIdx.y, b = blockIdx.z;
    const int q0 = qt * AQR;
    const float lam = lamp[0];
    for (int m = 0; m < 2; ++m) {
        __syncthreads();
        for (int i = tid; i < AQR * 64; i += 256) { int r = i / 64, d = i % 64; qs[i] = z[(size_t)(b * L + q0 + r) * INW + QOFF + h * 128 + m * 64 + d]; }
        __syncthreads();
        for (int k = tid; k < LK; k += 256) {
            int krow = k < CT ? NLAT + b * CT + k : b * L + (k - CT);
            const float* kp = z + (size_t)krow * INW + KOFF + h * 128 + m * 64;
            float acc[AQR];
#pragma unroll
            for (int r = 0; r < AQR; ++r) acc[r] = 0.f;
            for (int d = 0; d < 64; d += 4) {
                float4 kv = *(const float4*)(kp + d);
#pragma unroll
                for (int r = 0; r < AQR; ++r) acc[r] += kv.x * qs[r * 64 + d] + kv.y * qs[r * 64 + d + 1] + kv.z * qs[r * 64 + d + 2] + kv.w * qs[r * 64 + d + 3];
            }
#pragma unroll
            for (int r = 0; r < AQR; ++r) ss[r * LK + k] = acc[r] * 0.125f;
        }
        __syncthreads();
        for (int r = 0; r < AQR; ++r) {
            float mx = -INFINITY;
            for (int k = tid; k < LK; k += 256) mx = fmaxf(mx, ss[r * LK + k]);
            red[tid] = mx; __syncthreads();
            for (int s = 128; s > 0; s >>= 1) { if (tid < s) red[tid] = fmaxf(red[tid], red[tid + s]); __syncthreads(); }
            mx = red[0]; __syncthreads();
            float sum = 0.f;
            for (int k = tid; k < LK; k += 256) { float e = expf(ss[r * LK + k] - mx); ss[r * LK + k] = e; sum += e; }
            red[tid] = sum; __syncthreads();
            for (int s = 128; s > 0; s >>= 1) { if (tid < s) red[tid] += red[tid + s]; __syncthreads(); }
            float inv = 1.f / red[0]; __syncthreads();
            for (int k = tid; k < LK; k += 256) {
                float p = ss[r * LK + k] * inv;
                if (m == 0) sa[r * LK + k] = p; else sa[r * LK + k] -= lam * p;
            }
        }
    }
    __syncthreads();
    {
        int d = tid & 127, par = tid >> 7;
        float acc[AQR];
#pragma unroll
        for (int r = 0; r < AQR; ++r) acc[r] = 0.f;
        for (int k = par; k < LK; k += 2) {
            int krow = k < CT ? NLAT + b * CT + k : b * L + (k - CT);
            float vv = z[(size_t)krow * INW + VOFF + h * 128 + d];
#pragma unroll
            for (int r = 0; r < AQR; ++r) acc[r] += sa[r * LK + k] * vv;
        }
#pragma unroll
        for (int r = 0; r < AQR; ++r) po[(par * AQR + r) * 128 + d] = acc[r];
    }
    __syncthreads();
    {
        int r = tid >> 6, ln = tid & 63;
        float o0 = po[(0 * AQR + r) * 128 + ln] + po[(1 * AQR + r) * 128 + ln];
        float o1 = po[(0 * AQR + r) * 128 + 64 + ln] + po[(1 * AQR + r) * 128 + 64 + ln];
        float s2 = o0 * o0 + o1 * o1;
        for (int o = 32; o > 0; o >>= 1) s2 += __shfl_xor(s2, o);
        float rstd = 1.0f / sqrtf(s2 / 128.f + EPS);
        size_t ob = (size_t)(b * L + q0 + r) * D + POOLW + h * 128;
        mix[ob + ln] = o0 * rstd * subg[ln] * 0.8f;
        mix[ob + 64 + ln] = o1 * rstd * subg[64 + ln] * 0.8f;
    }
}

__global__ void k_pool(const float* __restrict__ z, const float* __restrict__ pw, const float* __restrict__ pb, const float* __restrict__ psc, float* __restrict__ mix) {
    __shared__ float y[128];
    int row = blockIdx.x, g = blockIdx.y, c = threadIdx.x;
    int b = row / L, t = row % L;
    int w = 2 << g;
    int lo = t - w / 2; if (lo < 0) lo = 0;
    int hi = t + w / 2; if (hi > L) hi = L;
    float s = 0.f;
    for (int tt = lo; tt < hi; ++tt) s += z[(size_t)(b * L + tt) * INW + g * 128 + c];
    y[c] = s / (float)(hi - lo) - z[(size_t)row * INW + g * 128 + c];
    __syncthreads();
    float acc = 0.f;
    for (int cc = 0; cc < 128; ++cc) acc += y[cc] * pw[((size_t)g * 128 + cc) * 128 + c];
    mix[(size_t)row * D + g * 128 + c] = (acc + pb[g * 128 + c]) * psc[g * 128 + c];
}

__global__ void __launch_bounds__(64) k_peer_topk(const float* __restrict__ qp, const float* __restrict__ keys, int* __restrict__ eidx, float* __restrict__ egate) {
    __shared__ float sc[64][129];
    __shared__ float tv[64][17];
    __shared__ int ti[64][17];
    int tid = threadIdx.x, tl = tid >> 1, p = tid & 1;
    int h = blockIdx.y, t = blockIdx.x * 32 + tl;
    const float* qr = qp + (size_t)t * D + h * 256 + p * 128;
    const float* kb = keys + ((size_t)(h * 2 + p) * PNK) * 128;
    for (int k = 0; k < PNK; ++k) {
        float s = 0.f;
        for (int c = 0; c < 128; c += 4) {
            float4 qv = *(const float4*)(qr + c); float4 kv = *(const float4*)(kb + (size_t)k * 128 + c);
            s += qv.x * kv.x + qv.y * kv.y + qv.z * kv.z + qv.w * kv.w;
        }
        sc[tid][k] = s;
    }
    float pv = INFINITY; int pi = -1;
    for (int j = 0; j < PTOPK; ++j) {
        float bv = -INFINITY; int bi = PNK;
        for (int k = 0; k < PNK; ++k) {
            float v = sc[tid][k];
            bool elig = (v < pv) || (v == pv && k > pi);
            if (elig && (v > bv)) { bv = v; bi = k; }
        }
        tv[tid][j] = bv; ti[tid][j] = bi; pv = bv; pi = bi;
    }
    __syncthreads();
    if (p == 0) {
        int ta = tid, tb = tid + 1;
        float sv[PTOPK]; int si[PTOPK];
        float pv2 = INFINITY; int pi2 = -1;
        float mx = 0.f;
#pragma unroll
        for (int j = 0; j < PTOPK; ++j) {
            float bv = -INFINITY; int bi = 256;
            for (int c = 0; c < 256; ++c) {
                float v = tv[ta][c >> 4] + tv[tb][c & 15];
                bool elig = (v < pv2) || (v == pv2 && c > pi2);
                if (elig && (v > bv)) { bv = v; bi = c; }
            }
            sv[j] = bv; si[j] = bi; pv2 = bv; pi2 = bi;
            if (j == 0) mx = bv;
        }
        float sum = 0.f;
#pragma unroll
        for (int j = 0; j < PTOPK; ++j) { sv[j] = expf(sv[j] - mx); sum += sv[j]; }
        float inv = 1.f / sum;
#pragma unroll
        for (int j = 0; j < PTOPK; ++j) {
            int c = si[j];
            eidx[((size_t)t * PH + h) * PTOPK + j] = ti[ta][c >> 4] * PNK + ti[tb][c & 15];
            egate[((size_t)t * PH + h) * PTOPK + j] = sv[j] * inv;
        }
    }
}

__global__ void __launch_bounds__(512) k_peer_main(const float* __restrict__ f, const int* __restrict__ eidx, const float* __restrict__ egate,
                                                   const float* __restrict__ pu, const float* __restrict__ pv, const float* __restrict__ mod,
                                                   const float* __restrict__ fg, float* __restrict__ xio  ) {
    __shared__ float part[PH][D];
    __shared__ float red[8];
    int t = blockIdx.x, tid = threadIdx.x, wv = tid >> 6, ln = tid & 63;
    float fr[32], acc[32];
#pragma unroll
    for (int i = 0; i < 32; ++i) { fr[i] = f[(size_t)t * D + ln + 64 * i]; acc[i] = 0.f; }
    for (int k = 0; k < PTOPK; ++k) {
        int e = eidx[((size_t)t * PH + wv) * PTOPK + k];
        float gt = egate[((size_t)t * PH + wv) * PTOPK + k];
        const float* ur = pu + (size_t)e * D;
        float dsum = 0.f;
#pragma unroll
        for (int i = 0; i < 32; ++i) dsum += ur[ln + 64 * i] * fr[i];
        for (int o = 32; o > 0; o >>= 1) dsum += __shfl_xor(dsum, o);
        float act = 0.5f * dsum * (1.f + erff(dsum * 0.70710678118654752f));
        float wgt = gt * act;
        const float* vr = pv + (size_t)e * D;
#pragma unroll
        for (int i = 0; i < 32; ++i) acc[i] += wgt * vr[ln + 64 * i];
    }
#pragma unroll
    for (int i = 0; i < 32; ++i) part[wv][ln + 64 * i] = acc[i];
    __syncthreads();
    const float* g2 = mod + (size_t)(t / L) * 6 * D + 5 * D;
    float v[4]; float ss = 0.f;
#pragma unroll
    for (int i = 0; i < 4; ++i) {
        int col = tid + 512 * i;
        float s = 0.f;
#pragma unroll
        for (int hh = 0; hh < PH; ++hh) s += part[hh][col];
        v[i] = xio[(size_t)t * D + col] + g2[col] * s;
        ss += v[i] * v[i];
    }
    for (int o = 32; o > 0; o >>= 1) ss += __shfl_xor(ss, o);
    if (ln == 0) red[wv] = ss;
    __syncthreads();
    float tot = 0.f;
#pragma unroll
    for (int i = 0; i < 8; ++i) tot += red[i];
    float rstd = 1.0f / sqrtf(tot / (float)D + EPS);
#pragma unroll
    for (int i = 0; i < 4; ++i) { int col = tid + 512 * i; xio[(size_t)t * D + col] = v[i] * rstd * fg[col]; }
}
}

extern "C" void kernel_launch(void* const* d_in, const int* in_sizes, int n_in, void* d_out, int out_size, void* d_ws, size_t ws_size, hipStream_t stream) {
    const float* x = (const float*)d_in[0];
    const float* c = (const float*)d_in[1];
    const float* ctx = (const float*)d_in[2];
    const float* cctx = (const float*)d_in[3];
    const float* ada_w = (const float*)d_in[4];
    const float* ada_b = (const float*)d_in[5];
    const float* norm1_g = (const float*)d_in[6];
    const float* w_in = (const float*)d_in[7];
    const float* pool_w = (const float*)d_in[8];
    const float* pool_b = (const float*)d_in[9];
    const float* pool_scale = (const float*)d_in[10];
    const float* diff_lambda = (const float*)d_in[11];
    const float* subln_g = (const float*)d_in[12];
    const float* w_out = (const float*)d_in[13];
    const float* norm2_g = (const float*)d_in[14];
    const float* peer_wq = (const float*)d_in[15];
    const float* peer_keys = (const float*)d_in[16];
    const float* peer_u = (const float*)d_in[17];
    const float* peer_v = (const float*)d_in[18];
    const float* final_g = (const float*)d_in[19];
    float* out = (float*)d_out;

    char* ws = (char*)d_ws;
    size_t off = 0;
    auto carve = [&](size_t bytes) { char* p = ws + off; off += (bytes + 255) & ~(size_t)255; return p; };
    float* lam = (float*)carve(256);
    float* rope = (float*)carve((size_t)L * 32 * 2 * 4);
    float* mod = (float*)carve((size_t)5 * 6 * D * 4);
    int* eidx = (int*)carve((size_t)NLAT * PH * PTOPK * 4);
    float* egate = (float*)carve((size_t)NLAT * PH * PTOPK * 4);
    float* hbuf = (float*)carve((size_t)NTOK * D * 4);
    float* zbuf = (float*)carve((size_t)NTOK * INW * 4);
    float* mix = (float*)carve((size_t)NLAT * D * 4);
    float* fbuf = hbuf;
    float* qpbuf = zbuf;
    float* x1 = out;

    k_prep<<<(L * 32 + 255) / 256, 256, 0, stream>>>(diff_lambda, lam, rope);
    k_ada<<<6 * D / 256, 256, 0, stream>>>(c, cctx, ada_w, ada_b, mod);
    k_norm_mod<<<NTOK, 256, 0, stream>>>(x, ctx, NLAT, norm1_g, mod, 0, D, hbuf);
    k_gemm<<<dim3(INW / 128, NTOK / 128), 256, 0, stream>>>(hbuf, D, w_in, INW, zbuf, INW, D, nullptr, nullptr, 0);
    k_rope<<<(unsigned)(((size_t)NLAT * 1536 + 255) / 256), 256, 0, stream>>>(zbuf, rope);
    {
        size_t shm = (size_t)(2 * AQR * LK + AQR * 64 + 256 + 2 * AQR * 128) * 4;
        static bool attr_done = false;
        if (!attr_done) { hipFuncSetAttribute((const void*)k_attn, hipFuncAttributeMaxDynamicSharedMemorySize, (int)shm); attr_done = true; }
        k_attn<<<dim3(L / AQR, NH, NB), 256, shm, stream>>>(zbuf, lam, subln_g, mix);
    }
    k_pool<<<dim3(NLAT, 4), 128, 0, stream>>>(zbuf, pool_w, pool_b, pool_scale, mix);
    k_gemm<<<dim3(D / 128, NLAT / 128), 256, 0, stream>>>(mix, D, w_out, D, x1, D, D, x, mod + 2 * D, 6 * D);
    k_norm_mod<<<NLAT, 256, 0, stream>>>(x1, nullptr, NLAT, norm2_g, mod, 3 * D, 4 * D, fbuf);
    k_gemm<<<dim3(D / 128, NLAT / 128), 256, 0, stream>>>(fbuf, D, peer_wq, D, qpbuf, D, D, nullptr, nullptr, 0);
    k_peer_topk<<<dim3(NLAT / 32, PH), 64, 0, stream>>>(qpbuf, peer_keys, eidx, egate);
    k_peer_main<<<NLAT, 512, 0, stream>>>(fbuf, eidx, egate, peer_u, peer_v, mod, final_g, x1);
}
```

```cpp
#include <hip/hip_runtime.h>
#include <math.h>
#include <stdint.h>
#include <cstdio>

constexpr int D = 2048, NB = 4, L = 2048, CT = 256;
constexpr int NLAT = NB * L;
constexpr int NCTX = NB * CT;
constexpr int NTOK = NLAT + NCTX;
constexpr int INW = 5120, POOLW = 512, ATTW = 1536, NH = 12, DV = 128, DQK = 64;
constexpr int QOFF = POOLW, KOFF = POOLW + ATTW, VOFF = POOLW + 2 * ATTW;
constexpr int LK = CT + L;
constexpr int PH = 8, PNK = 128, PTOPK = 16, NEXP = PNK * PNK;
constexpr float EPS = 1e-6f;
namespace pg8 {
#define PG8_LAS __attribute__((address_space(3)))
typedef unsigned short bf16_t;
typedef short bf16x8 __attribute__((ext_vector_type(8)));
typedef float f32x4 __attribute__((ext_vector_type(4)));
typedef unsigned u32x4 __attribute__((ext_vector_type(4)));
constexpr int BM = 256, BK = 64, HALF = 128, HTB = HALF * BK * 2  , STAGE_BYTES = 8 * HTB, NXCD = 8, WGM = 8;

__host__ __device__ __forceinline__ int lds_byte(int r, int c) { const int st = (r >> 4) * 2 + (c >> 5), rr = r & 15, cc = c & 31, ob = rr * 64 + cc * 2; return st * 1024 + (ob ^ (((ob >> 9) & 1) << 5)); }
__host__ __device__ __forceinline__ void stage_rc(int b, int& R, int& C) { const int st = b / 1024, sb = b % 1024, swz = sb ^ (((sb >> 9) & 1) << 5); R = (st >> 1) * 16 + swz / 64; C = (st & 1) * 32 + (swz % 64) / 2; }
__host__ __device__ __forceinline__ int perm32(int rho) { const int n = rho >> 4, i = rho & 15; return 8 * (i >> 2) + 4 * n + (i & 3); }

struct Unit { int pm, pn; };
struct Gemm { const bf16_t* A; const bf16_t* Bt; int M, N, K; };

struct StaticOrder {
    int nM, nN, nwg, G, c;
    __host__ __device__ void init(int M, int N, int G_, int c_) { nM = M / BM; nN = N / BM; nwg = nM * nN; G = G_; c = c_; }
    __host__ __device__ bool next(int i, Unit& u) const {
        const long L = (long)i * G + c; if (L >= nwg) return false;
        int wgid = (int)L; { const int q = nwg / NXCD, r = nwg % NXCD, xcd = wgid % NXCD, off = wgid / NXCD; wgid = (xcd < r ? xcd * (q + 1) : r * (q + 1) + (xcd - r) * q) + off; }
        const int nig = WGM * nN, gid = wgid / nig, fm = gid * WGM, gsz = (nM - fm) < WGM ? (nM - fm) : WGM;
        u.pm = fm + ((wgid % nig) % gsz); u.pn = (wgid % nig) / gsz; return true;
    }
    __device__ __forceinline__ void a_ready(const Unit&) const {}
    __device__ __forceinline__ void done(const Unit&) const {}
};

__device__ __forceinline__ unsigned cvt_pk_bf16(float lo, float hi) { unsigned r; asm volatile("v_cvt_pk_bf16_f32 %0, %1, %2" : "=v"(r) : "v"(lo), "v"(hi)); return r; }
typedef unsigned u32x2 __attribute__((ext_vector_type(2)));

struct InProjOrder {
    StaticOrder lat; int G, c;
    __device__ void init(int G_, int c_) { lat.init(8192, 5120, G_, c_); G = G_; c = c_; }
    __device__ bool next(int i, Unit& u) const {
        const int Lx = i * G + c;
        if (Lx < 640) return lat.next(i, u);
        const int j = Lx - 640; if (j >= 48) return false;
        u.pm = 32 + j / 12; u.pn = 8 + j % 12; return true;
    }
    __device__ __forceinline__ void a_ready(const Unit&) const {}
    __device__ __forceinline__ void done(const Unit&) const {}
};

struct EpiInProj {
    static constexpr bool PERM = false, AFTER_DRAIN = false;
    bf16_t *ZP, *Q, *Kb, *Vb; const float* rope;
    __device__ __forceinline__ void operator()(const f32x4 (&acc)[2][2][4][2], const Unit& u, int wr, int wc, int fr, int fq) const {
        const bool isctx = u.pm >= 32;
        const int kind = u.pn < 2 ? 0 : (u.pn < 8 ? 1 : (u.pn < 14 ? 2 : 3));
        const int pnl = kind == 0 ? u.pn : (kind == 1 ? u.pn - 2 : (kind == 2 ? u.pn - 8 : u.pn - 14));
        const int colt = pnl * 256 + wc * 32 + 4 * fq;
        bf16_t* dst = kind == 0 ? ZP : (kind == 1 ? Q : (kind == 2 ? Kb : Vb));
        const int ld = kind == 0 ? 512 : 1536;
        const bool dorope = (kind == 1 || kind == 2) && !isctx;
        const int ax = wc & 1;
#pragma unroll
        for (int ai = 0; ai < 2; ++ai)
#pragma unroll
            for (int m = 0; m < 4; ++m) {
                const int rl = ai * 128 + wr * 64 + m * 16 + fr;
                int orow, t = 0;
                if (!isctx) { const int g = u.pm * 256 + rl; t = g & 2047; orow = (kind >= 2) ? (g >> 11) * 2304 + 256 + t : g; }
                else orow = (u.pm - 32) * 2304 + rl;
                f32x4 cs0 = {1.f, 0.f, 1.f, 0.f}, cs1 = {1.f, 0.f, 1.f, 0.f};
                if (dorope) { const float* rp = rope + ((t * 2 + ax) * 16 + 4 * fq) * 2; cs0 = *(const f32x4*)rp; cs1 = *(const f32x4*)(rp + 4); }
#pragma unroll
                for (int bj = 0; bj < 2; ++bj) {
                    f32x4 v0 = acc[ai][bj][m][0], v1 = acc[ai][bj][m][1];
                    if (dorope) {
                        f32x4 o0, o1;
                        o0[0] = v0[0] * cs0[0] - v1[0] * cs0[1]; o1[0] = v0[0] * cs0[1] + v1[0] * cs0[0];
                        o0[1] = v0[1] * cs0[2] - v1[1] * cs0[3]; o1[1] = v0[1] * cs0[3] + v1[1] * cs0[2];
                        o0[2] = v0[2] * cs1[0] - v1[2] * cs1[1]; o1[2] = v0[2] * cs1[1] + v1[2] * cs1[0];
                        o0[3] = v0[3] * cs1[2] - v1[3] * cs1[3]; o1[3] = v0[3] * cs1[3] + v1[3] * cs1[2];
                        v0 = o0; v1 = o1;
                    }
                    bf16_t* p = dst + (size_t)orow * ld + colt + bj * 128;
                    u32x2 w0, w1; w0.x = cvt_pk_bf16(v0[0], v0[1]); w0.y = cvt_pk_bf16(v0[2], v0[3]); w1.x = cvt_pk_bf16(v1[0], v1[1]); w1.y = cvt_pk_bf16(v1[2], v1[3]);
                    *(u32x2*)p = w0; *(u32x2*)(p + 16) = w1;
                }
            }
    }
};

struct EpiOutProj {
    static constexpr bool PERM = false, AFTER_DRAIN = false;
    const float* x; const float* mod; float* x1; float* ssq;
    __device__ __forceinline__ void operator()(const f32x4 (&acc)[2][2][4][2], const Unit& u, int wr, int wc, int fr, int fq) const {
        const float* g1 = mod + (size_t)(u.pm >> 3) * (6 * 2048) + 2 * 2048;
        const int col0 = u.pn * 256 + wc * 32 + 4 * fq;
        f32x4 gv[2][2];
#pragma unroll
        for (int bj = 0; bj < 2; ++bj)
#pragma unroll
            for (int n = 0; n < 2; ++n) gv[bj][n] = *(const f32x4*)(g1 + col0 + bj * 128 + n * 16);
#pragma unroll
        for (int ai = 0; ai < 2; ++ai)
#pragma unroll
            for (int m = 0; m < 4; ++m) {
                const int row = u.pm * 256 + ai * 128 + wr * 64 + m * 16 + fr;
                float s = 0.f;
#pragma unroll
                for (int bj = 0; bj < 2; ++bj)
#pragma unroll
                    for (int n = 0; n < 2; ++n) {
                        const size_t off = (size_t)row * 2048 + col0 + bj * 128 + n * 16;
                        const f32x4 xv = *(const f32x4*)(x + off);
                        const f32x4 o = xv + gv[bj][n] * acc[ai][bj][m][n];
                        *(f32x4*)(x1 + off) = o;
                        s += (o[0] * o[0] + o[1] * o[1]) + (o[2] * o[2] + o[3] * o[3]);
                    }
                s += __shfl_xor(s, 16); s += __shfl_xor(s, 32);
                if (fq == 0) ssq[(size_t)row * 32 + u.pn * 4 + wc] = s;
            }
    }
};

struct EpiBf16Plain {
    static constexpr bool PERM = true, AFTER_DRAIN = false;
    bf16_t* O; int ldc;
    __device__ __forceinline__ void operator()(const f32x4 (&acc)[2][2][4][2], const Unit& u, int wr, int wc, int fr, int fq) const {
        const int row0 = u.pm * BM + wr * 64 + fr, col0 = u.pn * BM + wc * 32 + 8 * fq;
#pragma unroll
        for (int ai = 0; ai < 2; ++ai)
#pragma unroll
            for (int m = 0; m < 4; ++m) { bf16_t* rowp = O + (size_t)(row0 + ai * HALF + m * 16) * ldc + col0;
#pragma unroll
                for (int bj = 0; bj < 2; ++bj) { const f32x4 v0 = acc[ai][bj][m][0], v1 = acc[ai][bj][m][1];
                    u32x4 w; w.x = cvt_pk_bf16(v0[0], v0[1]); w.y = cvt_pk_bf16(v0[2], v0[3]); w.z = cvt_pk_bf16(v1[0], v1[1]); w.w = cvt_pk_bf16(v1[2], v1[3]);
                    *(u32x4*)(rowp + bj * HALF) = w; } }
    }
};

template <class Epi, class Sched, bool ALIGN_EPI = false, bool SP2 = false>
__device__ __forceinline__ void gemm_phase(PG8_LAS unsigned char* lds, const Gemm g, const Sched& S, const Epi& E) {
    const int tid = threadIdx.x, wid = __builtin_amdgcn_readfirstlane(tid >> 6), lane = tid & 63, wr = wid >> 2, wc = wid & 3, fr = lane & 15, fq = lane >> 4;
    const int K = g.K, nt = K / BK;
    unsigned voffA[2], voffB[2];
#pragma unroll
    for (int i = 0; i < 2; ++i) { int R, C; stage_rc(tid * 16 + i * 8192, R, C); const int Rb = Epi::PERM ? ((R & ~31) + perm32(R & 31)) : R;
        voffA[i] = (unsigned)(R * K + C) * 2u; voffB[i] = (unsigned)(Rb * K + C) * 2u; }
    const size_t kstep = (size_t)(BK * 2);
    const size_t hstep = (size_t)HALF * K * 2;
    const size_t tstep = 2 * hstep;
    const unsigned ldsw = (unsigned)wid * 1024u;
    const int aoff = lds_byte(wr * 64 + fr, fq * 8), boff = lds_byte(wc * 32 + fr, fq * 8);
#define PG8_SA(b, h) (((b) * 2 + (h)) * HTB)
#define PG8_SB(b, h) ((4 + (b) * 2 + (h)) * HTB)
#define PG8_STAGE(bufoff, gbase, voff) do { _Pragma("unroll") for (int _i = 0; _i < 2; ++_i) \
        __builtin_amdgcn_global_load_lds((const unsigned*)((const char*)(gbase) + (voff)[_i]), (PG8_LAS unsigned*)(lds + (bufoff) + ldsw + _i * 8192), 16, 0, 0); } while (0)
#define PG8_LDA(dst, b, h) do { _Pragma("unroll") for (int m = 0; m < 4; ++m) _Pragma("unroll") for (int k = 0; k < 2; ++k) dst[m][k] = *(const PG8_LAS bf16x8*)(lds + PG8_SA(b, h) + aoff + m * 2048 + k * 1024); } while (0)
#define PG8_LDB(dst, b, h) do { _Pragma("unroll") for (int n = 0; n < 2; ++n) _Pragma("unroll") for (int k = 0; k < 2; ++k) dst[n][k] = *(const PG8_LAS bf16x8*)(lds + PG8_SB(b, h) + boff + n * 2048 + k * 1024); } while (0)
#define PG8_MMA(ai, bj, At, Bt) do { __builtin_amdgcn_s_setprio(1); _Pragma("unroll") for (int m = 0; m < 4; ++m) _Pragma("unroll") for (int n = 0; n < 2; ++n) _Pragma("unroll") for (int k = 0; k < 2; ++k) \
        acc[ai][bj][m][n] = __builtin_amdgcn_mfma_f32_16x16x32_bf16(Bt[n][k], At[m][k], acc[ai][bj][m][n], 0, 0, 0); __builtin_amdgcn_s_setprio(0); } while (0)
#define PG8_WAIT_V(n) asm volatile("s_waitcnt vmcnt(" #n ")" ::: "memory")
#define PG8_WAIT_L(n) asm volatile("s_waitcnt lgkmcnt(" #n ")" ::: "memory")
#define PG8_BAR __builtin_amdgcn_s_barrier()
#define PG8_SCHED __builtin_amdgcn_sched_barrier(0)
    Unit cur, nxt; int ui = 0;
    if (!S.next(0, cur)) return;
    f32x4 acc[2][2][4][2];
#pragma unroll
    for (int a = 0; a < 2; ++a)
#pragma unroll
        for (int b = 0; b < 2; ++b)
#pragma unroll
            for (int m = 0; m < 4; ++m)
#pragma unroll
                for (int n = 0; n < 2; ++n) acc[a][b][m][n] = (f32x4){0.f, 0.f, 0.f, 0.f};
    bf16x8 At[4][2], B0[2][2], B1[2][2];
    const char* cA = (const char*)g.A + (size_t)cur.pm * tstep; const char* cB = (const char*)g.Bt + (size_t)cur.pn * tstep;
    S.a_ready(cur);
    if constexpr (SP2) {
        PG8_STAGE(PG8_SB(0, 0), cB, voffB); PG8_STAGE(PG8_SB(0, 1), cB + hstep, voffB); PG8_STAGE(PG8_SA(0, 0), cA, voffA); PG8_STAGE(PG8_SA(0, 1), cA + hstep, voffA);
        if (wr == 1) PG8_BAR;
        PG8_WAIT_V(2); PG8_BAR;
        PG8_STAGE(PG8_SB(1, 0), cB + kstep, voffB); PG8_STAGE(PG8_SA(1, 0), cA + kstep, voffA); PG8_STAGE(PG8_SB(1, 1), cB + hstep + kstep, voffB);
        PG8_WAIT_V(6); PG8_BAR;
    } else {
        PG8_STAGE(PG8_SB(0, 0), cB, voffB); PG8_STAGE(PG8_SA(0, 0), cA, voffA); PG8_STAGE(PG8_SB(0, 1), cB + hstep, voffB); PG8_STAGE(PG8_SA(0, 1), cA + hstep, voffA);
        if (wr == 1) PG8_BAR;
        PG8_WAIT_V(4); PG8_BAR;
        PG8_STAGE(PG8_SB(1, 0), cB + kstep, voffB); PG8_STAGE(PG8_SA(1, 0), cA + kstep, voffA); PG8_STAGE(PG8_SB(1, 1), cB + hstep + kstep, voffB);
        PG8_WAIT_V(6); PG8_BAR;
    }
    for (;;) {
        const bool has_next = S.next(ui + 1, nxt);
        const char* nA = has_next ? (const char*)g.A + (size_t)nxt.pm * tstep : cA; const char* nB = has_next ? (const char*)g.Bt + (size_t)nxt.pn * tstep : cB;
        for (int t = 0; t < nt; t += 2) {
            const bool last = (t == nt - 2);
            const char* a1 = cA + (size_t)(t + 1) * kstep;
            const char* a2 = last ? nA : cA + (size_t)(t + 2) * kstep; const char* b2 = last ? nB : cB + (size_t)(t + 2) * kstep;
            const char* a3 = a2 + kstep; const char* b3 = b2 + kstep;
            if (last && has_next) S.a_ready(nxt);
            if constexpr (SP2) {
            PG8_LDB(B0, 0, 0); PG8_LDB(B1, 0, 1); PG8_SCHED; PG8_LDA(At, 0, 0); PG8_STAGE(PG8_SA(1, 1), a1 + hstep, voffA);
            PG8_WAIT_V(8); PG8_WAIT_L(0); PG8_BAR; PG8_MMA(0, 0, At, B0); PG8_MMA(0, 1, At, B1); PG8_BAR; PG8_SCHED;
            PG8_LDA(At, 0, 1); PG8_STAGE(PG8_SB(0, 0), b2, voffB); PG8_STAGE(PG8_SB(0, 1), b2 + hstep, voffB); PG8_STAGE(PG8_SA(0, 0), a2, voffA);
            PG8_WAIT_V(8); PG8_WAIT_L(0); PG8_BAR; PG8_MMA(1, 0, At, B0); PG8_MMA(1, 1, At, B1); PG8_BAR; PG8_SCHED;
            PG8_LDB(B0, 1, 0); PG8_LDB(B1, 1, 1); PG8_SCHED; PG8_LDA(At, 1, 0); PG8_STAGE(PG8_SA(0, 1), a2 + hstep, voffA);
            PG8_WAIT_V(8); PG8_WAIT_L(0); PG8_BAR; PG8_MMA(0, 0, At, B0); PG8_MMA(0, 1, At, B1); PG8_BAR; PG8_SCHED;
            PG8_LDA(At, 1, 1); PG8_STAGE(PG8_SB(1, 0), b3, voffB); PG8_STAGE(PG8_SB(1, 1), b3 + hstep, voffB); PG8_STAGE(PG8_SA(1, 0), a3, voffA);
            PG8_WAIT_V(8); PG8_WAIT_L(0); PG8_BAR; PG8_MMA(1, 0, At, B0); PG8_MMA(1, 1, At, B1); PG8_BAR; PG8_SCHED;
            } else {
            PG8_LDB(B0, 0, 0); PG8_SCHED; PG8_LDA(At, 0, 0); PG8_STAGE(PG8_SA(1, 1), a1 + hstep, voffA);
            PG8_WAIT_L(8); PG8_BAR; PG8_WAIT_L(0); PG8_MMA(0, 0, At, B0); PG8_BAR; PG8_SCHED;
            PG8_LDB(B1, 0, 1); PG8_STAGE(PG8_SB(0, 0), b2, voffB);
            PG8_BAR; PG8_WAIT_L(0); PG8_MMA(0, 1, At, B1); PG8_BAR;
            PG8_LDA(At, 0, 1); PG8_STAGE(PG8_SA(0, 0), a2, voffA);
            PG8_BAR; PG8_WAIT_L(0); PG8_MMA(1, 0, At, B0); PG8_BAR; PG8_SCHED;
            PG8_STAGE(PG8_SB(0, 1), b2 + hstep, voffB);
            PG8_WAIT_V(6); PG8_BAR; PG8_MMA(1, 1, At, B1); PG8_BAR;
            PG8_LDB(B0, 1, 0); PG8_SCHED; PG8_LDA(At, 1, 0); PG8_STAGE(PG8_SA(0, 1), a2 + hstep, voffA);
            PG8_WAIT_L(8); PG8_BAR; PG8_WAIT_L(0); PG8_MMA(0, 0, At, B0); PG8_BAR; PG8_SCHED;
            PG8_LDB(B1, 1, 1); PG8_STAGE(PG8_SB(1, 0), b3, voffB);
            PG8_BAR; PG8_WAIT_L(0); PG8_MMA(0, 1, At, B1); PG8_BAR;
            PG8_LDA(At, 1, 1); PG8_STAGE(PG8_SA(1, 0), a3, voffA);
            PG8_BAR; PG8_WAIT_L(0); PG8_MMA(1, 0, At, B0); PG8_BAR; PG8_SCHED;
            PG8_STAGE(PG8_SB(1, 1), b3 + hstep, voffB);
            PG8_WAIT_V(6); PG8_BAR; PG8_MMA(1, 1, At, B1); PG8_BAR;
            }
        }
        if constexpr (ALIGN_EPI) { if (wr == 0) PG8_BAR; }
        if constexpr (!Epi::AFTER_DRAIN) { E(acc, cur, wr, wc, fr, fq); S.done(cur); }
        if (!has_next) break;
#pragma unroll
        for (int a = 0; a < 2; ++a)
#pragma unroll
            for (int b = 0; b < 2; ++b)
#pragma unroll
                for (int m = 0; m < 4; ++m)
#pragma unroll
                    for (int n = 0; n < 2; ++n) acc[a][b][m][n] = (f32x4){0.f, 0.f, 0.f, 0.f};
        cur = nxt; cA = nA; cB = nB; ++ui;
        if constexpr (ALIGN_EPI) { if (wr == 1) PG8_BAR; }
    }
    PG8_WAIT_V(0);
    if constexpr (!ALIGN_EPI) { if (wr == 0) PG8_BAR; }
    PG8_BAR;
    if constexpr (Epi::AFTER_DRAIN) { E.fused(acc, cur, wr, wc, fr, fq, lds, wid, lane); S.done(cur); }
#undef PG8_SA
#undef PG8_SB
#undef PG8_STAGE
#undef PG8_LDA
#undef PG8_LDB
#undef PG8_MMA
#undef PG8_WAIT_V
#undef PG8_WAIT_L
#undef PG8_BAR
#undef PG8_SCHED
}
}
constexpr size_t MiB = 1u << 20, KiB = 1u << 10;
constexpr size_t WS_CTL = 0, CTL_ZERO_BYTES = 1 * MiB;
constexpr size_t WS_LAM = 1 * MiB;
constexpr size_t WS_ROPE = 1 * MiB + 64 * KiB;
constexpr size_t WS_MOD = 1 * MiB + 640 * KiB;
constexpr size_t WS_ADAP = 2 * MiB;
constexpr size_t WS_SSQ = 6 * MiB;
constexpr size_t WS_SU = 7 * MiB, WS_SV = 7 * MiB + 64 * KiB;
constexpr size_t WS_EIDX = 8 * MiB, WS_EGATE = 12 * MiB;
constexpr size_t WS_KEYS16 = 16 * MiB, WS_PWT16 = 16 * MiB + 512 * KiB;
constexpr size_t WS_WIN = 18 * MiB, WS_WOUT = 38 * MiB, WS_WQ = 46 * MiB;
constexpr size_t WS_HF = 54 * MiB, WS_ZF = 126 * MiB, WS_MIXF = 306 * MiB;
constexpr size_t WS_H16 = 370 * MiB, WS_Q16 = 406 * MiB, WS_K16 = 430 * MiB, WS_V16 = 457 * MiB, WS_ZP16 = 484 * MiB;
constexpr size_t WS_MIX16 = 370 * MiB, WS_F16 = 406 * MiB, WS_QP16 = 438 * MiB;
constexpr size_t WS_U8 = 192 * MiB, WS_V8 = 224 * MiB;
constexpr size_t WS_ESU = 256 * MiB;
constexpr size_t WS_END = 512 * MiB;
constexpr int CW_BAR = 4096;

constexpr int RING_OFF = 0, RING_BYTES = 131072;
constexpr int LDSCTL_OFF = RING_BYTES, MISC_OFF = LDSCTL_OFF + 320;
constexpr int LDS_BYTES = 147456;
constexpr int NWAVES = 8;
#define GAS __attribute__((address_space(1)))
#define LAS __attribute__((address_space(3)))
typedef unsigned short bf16;
typedef unsigned v4u __attribute__((ext_vector_type(4)));
typedef float f32x4 __attribute__((ext_vector_type(4)));
typedef short bf16x8 __attribute__((ext_vector_type(8)));
typedef GAS unsigned gu32;
typedef GAS unsigned long long gu64;
#define RLX_AGENT __ATOMIC_RELAXED, __HIP_MEMORY_SCOPE_AGENT
#define LDS_WAIT() asm volatile("s_waitcnt lgkmcnt(0)" ::: "memory")
#define VM_WAIT() asm volatile("s_waitcnt vmcnt(0)" ::: "memory")
__device__ __forceinline__ unsigned long long rt() { return __builtin_amdgcn_s_memrealtime(); }
__device__ __forceinline__ unsigned f2bf(float f) { unsigned u = __builtin_bit_cast(unsigned, f); return (u + 0x7fffu + ((u >> 16) & 1u)) >> 16; }
__device__ __forceinline__ unsigned pk2(float lo, float hi) { return f2bf(lo) | (f2bf(hi) << 16); }

#define XB_TMO      128
#define XB_XCNT(j)  (256  + 64 * (j))
#define XB_XSUB(j)  (1280 + 64 * (j))
#define XB_XGEN(j)  (2304 + 64 * (j))
#define XB_TOP      3328
#define XB_TOPGEN   3392
#define XCD_BAR_WORDS 3456
#define XB_SPIN_CAP (1u << 18)

__device__ __forceinline__ unsigned xb_ld(unsigned* p)              { return __hip_atomic_load(p, __ATOMIC_RELAXED, __HIP_MEMORY_SCOPE_AGENT); }
__device__ __forceinline__ unsigned xb_add(unsigned* p, unsigned v) { return __hip_atomic_fetch_add(p, v, __ATOMIC_RELAXED, __HIP_MEMORY_SCOPE_AGENT); }
__device__ __forceinline__ unsigned xb_xcc_id() { return (unsigned)__builtin_amdgcn_s_getreg((3 << 11) | 20) & 0xFu; }
#define XB_SPIN(cond, bar) do { unsigned _sp = 0; while (cond) { __builtin_amdgcn_s_sleep(1); \
    if ((++_sp & 255u) == 0u) { if (xb_ld(&(bar)[XB_TMO])) break; if (_sp > XB_SPIN_CAP) { atomicAdd(&(bar)[XB_TMO], 1u); break; } } } } while (0)

struct XcdBarrier {
    unsigned* bar; unsigned x;
    volatile LAS unsigned* st;
};

__device__ __forceinline__ XcdBarrier xcd_barrier_post(unsigned* bar, volatile LAS unsigned* st) {
    XcdBarrier b; b.bar = bar; b.x = xb_xcc_id(); b.st = st;
    if (threadIdx.x == 0) (void)xb_add(&bar[XB_XCNT(b.x)], 1u);
    return b;
}
__device__ __forceinline__ void xcd_barrier_complete(unsigned* bar, unsigned x, unsigned& nloc, unsigned& nx) {
    const unsigned G = gridDim.x * gridDim.y * gridDim.z;
    unsigned sum, cnt, mine, sp = 0u;
    for (;;) {
        sum = 0u; cnt = 0u; mine = 0u;
#pragma unroll
        for (unsigned j = 0; j < 16; ++j) { const unsigned c = xb_ld(&bar[XB_XCNT(j)]); sum += c; cnt += (c > 0u) ? 1u : 0u; mine = (j == x) ? c : mine; }
        if (sum == G) break;
        __builtin_amdgcn_s_sleep(1);
        if ((++sp & 255u) == 0u) { if (xb_ld(&bar[XB_TMO])) break; if (sp > XB_SPIN_CAP) { atomicAdd(&bar[XB_TMO], 1u); break; } }
    }
    nloc = mine > 0u ? mine : 1u; nx = cnt > 0u ? cnt : 1u;
}

__device__ __forceinline__ void xcd_barrier(const XcdBarrier& b) {
    asm volatile("s_waitcnt vmcnt(0)" ::: "memory");
    __syncthreads();
    if (threadIdx.x == 0) {
        unsigned* bar = b.bar;
        __builtin_amdgcn_s_waitcnt(0);
        unsigned nloc = b.st[0], nx = b.st[1];
        if (nloc == 0u) { xcd_barrier_complete(bar, b.x, nloc, nx); b.st[0] = nloc; b.st[1] = nx; }
        const unsigned old = xb_add(&bar[XB_XSUB(b.x)], 1u);
        const unsigned gen = old / nloc;
        if (old + 1u == (gen + 1u) * nloc) {
            __builtin_amdgcn_fence(__ATOMIC_RELEASE, "agent");
            asm volatile("s_waitcnt vmcnt(0)" ::: "memory");
            const unsigned og = xb_add(&bar[XB_TOP], 1u);
            const unsigned tg = og / nx;
            if (og + 1u == (tg + 1u) * nx) xb_add(&bar[XB_TOPGEN], 1u);
            else XB_SPIN(xb_ld(&bar[XB_TOPGEN]) == tg, bar);
            __builtin_amdgcn_fence(__ATOMIC_ACQUIRE, "agent");
            xb_add(&bar[XB_XGEN(b.x)], 1u);
            asm volatile("s_waitcnt vmcnt(0)" ::: "memory");
        } else {
            XB_SPIN(xb_ld(&bar[XB_XGEN(b.x)]) == gen, bar);
            __builtin_amdgcn_fence(__ATOMIC_ACQUIRE, "agent");
            asm volatile("s_waitcnt vmcnt(0)" ::: "memory");
        }
    }
    __syncthreads();
}
namespace att {
using s16x4  = __attribute__((ext_vector_type(4))) short;
using f32x16 = __attribute__((ext_vector_type(16))) float;
constexpr int NW = 8, QBLK = 32, KVBLK = 64, LDQ = 1536, LDK = 1536;
constexpr float SCALE = 0.125f, THR = 8.f;
constexpr int SHM_V = KVBLK * 128 * 2, SHM_K = KVBLK * 128 * 2;
#define KSWZ(row, colB) ((row) * 256 + ((colB) ^ (((row) & 7) << 4)))
#define SBAR() __builtin_amdgcn_sched_barrier(0)
__device__ __forceinline__ int crow(int r, int hi) { return (r & 3) + 8 * (r >> 2) + 4 * hi; }
__device__ __forceinline__ unsigned cvtpk(float lo, float hi) { unsigned r; asm volatile("v_cvt_pk_bf16_f32 %0, %1, %2" : "=v"(r) : "v"(lo), "v"(hi)); return r; }

__device__ __forceinline__ void partialSM(f32x16& p0, f32x16& p1, float& m_reg, float& mn, float& alpha) {
  constexpr float C = SCALE * 1.4426950408889634f;
  float pmax = p0[0]; for (int r = 1; r < 16; ++r) pmax = fmaxf(pmax, p0[r]); for (int r = 0; r < 16; ++r) pmax = fmaxf(pmax, p1[r]);
  { auto rr = __builtin_amdgcn_permlane32_swap(__float_as_uint(pmax), __float_as_uint(pmax), false, false);
    pmax = fmaxf(__uint_as_float(rr[0]), __uint_as_float(rr[1])); }
  if (__builtin_expect(__all(pmax - m_reg <= THR / SCALE), 1)) { mn = m_reg; alpha = 1.f; }
  else { mn = fmaxf(m_reg, pmax); alpha = __builtin_amdgcn_exp2f((m_reg - mn) * C); m_reg = mn; }
  float mnC = -mn * C;
  for (int r = 0; r < 16; ++r) p0[r] = fmaf(p0[r], C, mnC); for (int r = 0; r < 16; ++r) p1[r] = fmaf(p1[r], C, mnC);
  for (int r = 0; r < 16; ++r) p0[r] = __builtin_amdgcn_exp2f(p0[r]);
}
__device__ __forceinline__ void finishSM(f32x16& p0, f32x16& p1, float alpha, float& l_reg, bf16x8& pa0, bf16x8& pa1, bf16x8& pa2, bf16x8& pa3) {
  for (int r = 0; r < 16; ++r) p1[r] = __builtin_amdgcn_exp2f(p1[r]);
  float ps = 0; for (int r = 0; r < 16; ++r) ps += p0[r]; for (int r = 0; r < 16; ++r) ps += p1[r];
  { auto rr = __builtin_amdgcn_permlane32_swap(__float_as_uint(ps), __float_as_uint(ps), false, false);
    ps = __uint_as_float(rr[0]) + __uint_as_float(rr[1]); }
  l_reg = l_reg * alpha + ps;
#define PK4(P, BASE, OUT) do { unsigned a0 = cvtpk(P[BASE + 0], P[BASE + 1]), a1 = cvtpk(P[BASE + 2], P[BASE + 3]);   \
    unsigned b0 = cvtpk(P[BASE + 4], P[BASE + 5]), b1 = cvtpk(P[BASE + 6], P[BASE + 7]);                              \
    auto r0 = __builtin_amdgcn_permlane32_swap(a0, b0, false, false); auto r1 = __builtin_amdgcn_permlane32_swap(a1, b1, false, false); \
    v4u w = {r0[0], r1[0], r0[1], r1[1]}; OUT = *reinterpret_cast<bf16x8*>(&w); } while (0)
  PK4(p0, 0, pa0); PK4(p0, 8, pa1); PK4(p1, 0, pa2); PK4(p1, 8, pa3);
#undef PK4
}
__device__ __forceinline__ void qkt(f32x16& p0, f32x16& p1, const bf16* Ks, const bf16x8* qr, int r32, int hi, int mp) {
  p0 = f32x16{}; p1 = f32x16{};
  for (int d0 = 0; d0 < 4; ++d0) { int cb = (mp * 64 + d0 * 16 + hi * 8) * 2;
    bf16x8 b0 = *reinterpret_cast<const bf16x8*>((const char*)Ks + KSWZ(r32, cb));
    bf16x8 b1 = *reinterpret_cast<const bf16x8*>((const char*)Ks + KSWZ(32 + r32, cb));
    p0 = __builtin_amdgcn_mfma_f32_32x32x16_bf16(b0, qr[d0], p0, 0, 0, 0);
    p1 = __builtin_amdgcn_mfma_f32_32x32x16_bf16(b1, qr[d0], p1, 0, 0, 0); }
}
__device__ __forceinline__ int v_st(int k, int c) { const int kk = (k & ~0xC) | ((k & 4) << 1) | ((k & 8) >> 1); return ((kk >> 3) * 4 + (c >> 5)) * 512 + ((kk & 7) * 32 + (c & 31)) * 2; }
__device__ __forceinline__ int v_rd_base(int lane) { return ((lane & 3) << 3) | (((lane >> 2) & 3) << 6) | (((lane >> 4) & 1) << 5) | (((lane >> 5) & 1) << 8); }
constexpr int v_rd_off(int d0, int ks, int half) { return d0 * 512 + ks * 4096 + half * 2048; }
template <int OFF> __device__ __forceinline__ s16x4 tr_read(int vb) {
  s16x4 r; asm volatile("ds_read_b64_tr_b16 %0, %1 offset:%2" : "=&v"(r) : "v"(vb), "i"(OFF) : "memory"); return r;
}
template <int D0> __device__ __forceinline__ void pv_one(f32x16& od, int vb, bf16x8 pa0, bf16x8 pa1, bf16x8 pa2, bf16x8 pa3) {
  const s16x4 l0 = tr_read<v_rd_off(D0, 0, 0)>(vb), h0 = tr_read<v_rd_off(D0, 0, 1)>(vb), l1 = tr_read<v_rd_off(D0, 1, 0)>(vb), h1 = tr_read<v_rd_off(D0, 1, 1)>(vb);
  const s16x4 l2 = tr_read<v_rd_off(D0, 2, 0)>(vb), h2 = tr_read<v_rd_off(D0, 2, 1)>(vb), l3 = tr_read<v_rd_off(D0, 3, 0)>(vb), h3 = tr_read<v_rd_off(D0, 3, 1)>(vb);
  asm volatile("s_waitcnt lgkmcnt(0)" ::: "memory"); SBAR();
#define PK(L, H) (bf16x8){L[0], L[1], L[2], L[3], H[0], H[1], H[2], H[3]}
  od = __builtin_amdgcn_mfma_f32_32x32x16_bf16(pa0, PK(l0, h0), od, 0, 0, 0);
  od = __builtin_amdgcn_mfma_f32_32x32x16_bf16(pa1, PK(l1, h1), od, 0, 0, 0);
  od = __builtin_amdgcn_mfma_f32_32x32x16_bf16(pa2, PK(l2, h2), od, 0, 0, 0);
  od = __builtin_amdgcn_mfma_f32_32x32x16_bf16(pa3, PK(l3, h3), od, 0, 0, 0);
#undef PK
}
__device__ __forceinline__ void pv_d0(f32x16* o, int vb, bf16x8 pa0, bf16x8 pa1, bf16x8 pa2, bf16x8 pa3) {
  pv_one<0>(o[0], vb, pa0, pa1, pa2, pa3); pv_one<1>(o[1], vb, pa0, pa1, pa2, pa3); pv_one<2>(o[2], vb, pa0, pa1, pa2, pa3); pv_one<3>(o[3], vb, pa0, pa1, pa2, pa3);
}

__device__ __forceinline__ void attn_unit(int b, int h, int qb, const bf16* __restrict__ Q16, const bf16* __restrict__ K16, const bf16* __restrict__ V16,
                                          bf16* __restrict__ mix16, float lam, const float* __restrict__ subg, char* lds) {
  const int tid = threadIdx.x, wid = tid >> 6, lane = tid & 63, r32 = lane & 31, hi = lane >> 5, mp = wid >> 2, qs = wid & 3;
  bf16* V_lds = (bf16*)lds; bf16* K_lds = (bf16*)(lds + 2 * SHM_V);
  float* wsx = (float*)(lds + 2 * SHM_V + 2 * SHM_K) + wid * 64; float* li_l = wsx; float* al_l = wsx + 32;
  float m_reg = -1e30f, l_reg = 0; f32x16 o[4] = {}; bf16x8 qr[4];
  const bf16* Qw = Q16 + (size_t)(b * L + qb * 128 + qs * 32 + r32) * LDQ + h * 128 + mp * 64 + hi * 8;
#pragma unroll
  for (int d0 = 0; d0 < 4; ++d0) qr[d0] = *reinterpret_cast<const bf16x8*>(Qw + d0 * 16);
  const bf16* Kh = K16 + (size_t)(b * LK) * LDK + h * 128;
  const bf16* Vh = V16 + (size_t)(b * LK) * LDK + h * 128;
  const int sr = tid >> 4, sc = (tid & 15) * 8, vst0 = v_st(sr, sc), vst1 = v_st(32 + sr, sc);
  const int vb0 = (int)(uintptr_t)V_lds + v_rd_base(lane);
  struct { bf16x8 vs0, vs1, ks0, ks1; } sr_[2];
#define SLOAD(i, k0) do { sr_[i].vs0 = *(const bf16x8*)(&Vh[(size_t)((k0) + sr) * LDK + sc]); sr_[i].vs1 = *(const bf16x8*)(&Vh[(size_t)((k0) + 32 + sr) * LDK + sc]); \
    sr_[i].ks0 = *(const bf16x8*)(&Kh[(size_t)((k0) + sr) * LDK + sc]); sr_[i].ks1 = *(const bf16x8*)(&Kh[(size_t)((k0) + 32 + sr) * LDK + sc]); } while (0)
#define SWRITE(bb, i) do { *(bf16x8*)((char*)V_lds + (bb) * SHM_V + vst0) = sr_[i].vs0;          \
    *(bf16x8*)((char*)V_lds + (bb) * SHM_V + vst1) = sr_[i].vs1; int kc = sc * 2;               \
    *(bf16x8*)((char*)K_lds + (bb) * SHM_K + KSWZ(sr, kc)) = sr_[i].ks0;                       \
    *(bf16x8*)((char*)K_lds + (bb) * SHM_K + KSWZ(32 + sr, kc)) = sr_[i].ks1; } while (0)
#define SWAIT() asm volatile("s_waitcnt vmcnt(4)" ::: "memory")
#define RESC(a) do { if (__any((a) < 1.f)) { if (hi == 0) al_l[r32] = (a); asm volatile("s_waitcnt lgkmcnt(0)" ::: "memory"); \
    for (int d = 0; d < 4; ++d) for (int r = 0; r < 16; ++r) o[d][r] *= al_l[crow(r, hi)]; } } while (0)
  f32x16 pA0, pA1, pB0, pB1; float mnA, mnB, alA, alB; bf16x8 pa0, pa1, pa2, pa3; constexpr int NT = LK / KVBLK;
  constexpr int SE = 0, SO = 1;
  SLOAD(SE, 0); asm volatile("s_waitcnt vmcnt(0)" ::: "memory"); SWRITE(0, SE); __syncthreads();
  qkt(pA0, pA1, K_lds, qr, r32, hi, mp); partialSM(pA0, pA1, m_reg, mnA, alA);
  SLOAD(SO, KVBLK); SLOAD(SE, 2 * KVBLK);
  SWAIT(); SWRITE(1, SO); __syncthreads();
  for (int j = 1; j + 1 < NT; j += 2) {
    SBAR(); qkt(pB0, pB1, (bf16*)((char*)K_lds + SHM_K), qr, r32, hi, mp);
    finishSM(pA0, pA1, alA, l_reg, pa0, pa1, pa2, pa3); SBAR();
    SLOAD(SO, (j + 2) * KVBLK); SBAR();
    pv_d0(o, vb0, pa0, pa1, pa2, pa3); partialSM(pB0, pB1, m_reg, mnB, alB);
    __syncthreads(); SWAIT(); SWRITE(0, SE);
    RESC(alB); __syncthreads();
    SBAR(); qkt(pA0, pA1, K_lds, qr, r32, hi, mp);
    finishSM(pB0, pB1, alB, l_reg, pa0, pa1, pa2, pa3); SBAR();
    if (j + 3 < NT) SLOAD(SE, (j + 3) * KVBLK); SBAR();
    pv_d0(o, vb0 + SHM_V, pa0, pa1, pa2, pa3); partialSM(pA0, pA1, m_reg, mnA, alA);
    __syncthreads(); SWAIT(); SWRITE(1, SO);
    RESC(alA); __syncthreads();
  }
  SBAR(); qkt(pB0, pB1, (bf16*)((char*)K_lds + SHM_K), qr, r32, hi, mp);
  finishSM(pA0, pA1, alA, l_reg, pa0, pa1, pa2, pa3); SBAR();
  pv_d0(o, vb0, pa0, pa1, pa2, pa3); partialSM(pB0, pB1, m_reg, mnB, alB);
  __syncthreads(); RESC(alB);
  finishSM(pB0, pB1, alB, l_reg, pa0, pa1, pa2, pa3); SBAR();
  pv_d0(o, vb0 + SHM_V, pa0, pa1, pa2, pa3);
  if (hi == 0) li_l[r32] = l_reg;
  asm volatile("s_waitcnt lgkmcnt(0)" ::: "memory");
  float rli[16];
#pragma unroll
  for (int r = 0; r < 16; ++r) rli[r] = 1.0f / li_l[crow(r, hi)];
  __syncthreads();
  float* X = (float*)lds + qs * (32 * 128);
  if (mp == 1) {
#pragma unroll
    for (int r = 0; r < 16; ++r)
#pragma unroll
      for (int d0 = 0; d0 < 4; ++d0) X[crow(r, hi) * 128 + d0 * 32 + r32] = lam * o[d0][r] * rli[r];
  }
  __syncthreads();
  if (mp == 0) {
    float ssq[16];
#pragma unroll
    for (int r = 0; r < 16; ++r) { float s = 0.f;
#pragma unroll
      for (int d0 = 0; d0 < 4; ++d0) { const float v = o[d0][r] * rli[r] - X[crow(r, hi) * 128 + d0 * 32 + r32]; o[d0][r] = v; s += v * v; }
      ssq[r] = s; }
#pragma unroll
    for (int r = 0; r < 16; ++r) {
      float s = ssq[r];
      s += __shfl_xor(s, 1); s += __shfl_xor(s, 2); s += __shfl_xor(s, 4); s += __shfl_xor(s, 8); s += __shfl_xor(s, 16);
      ssq[r] = 1.0f / sqrtf(s * (1.0f / 128.f) + EPS);
    }
    float sg[4];
#pragma unroll
    for (int d0 = 0; d0 < 4; ++d0) sg[d0] = subg[d0 * 32 + r32] * 0.8f;
    asm volatile("s_waitcnt lgkmcnt(0)" ::: "memory");
    unsigned short* Y = (unsigned short*)X;
#pragma unroll
    for (int r = 0; r < 16; ++r)
#pragma unroll
      for (int d0 = 0; d0 < 4; ++d0) Y[crow(r, hi) * 128 + d0 * 32 + r32] = (unsigned short)f2bf(o[d0][r] * ssq[r] * sg[d0]);
    asm volatile("s_waitcnt lgkmcnt(0)" ::: "memory");
    bf16* Ob = mix16 + (size_t)(b * L + qb * 128 + qs * 32) * D + POOLW + h * 128;
#pragma unroll
    for (int j = 0; j < 8; ++j) { const int idx = j * 64 + lane, row = idx >> 4, ch = idx & 15;
      const v4u w = *(const v4u*)(Y + row * 128 + ch * 8);
      *(v4u*)(Ob + (size_t)row * D + ch * 8) = w; }
  }
  __syncthreads();
#undef SLOAD
#undef SWRITE
#undef SWAIT
#undef RESC
}

__device__ __forceinline__ void pool_item(int tile, int g, const bf16* __restrict__ ZP16, const bf16* __restrict__ pwT16, const float* __restrict__ pool_b,
                                          const float* __restrict__ pool_scale, bf16* __restrict__ mix16, int lane) {
  const int r32 = lane & 31, hi = lane >> 5;
  const int row0 = tile * 32, t = (row0 & 2047) + r32, rb = row0 & ~2047;
  const int w = 2 << g, hw = w >> 1;
  const int lo = t - hw < 0 ? 0 : t - hw, hi_ = t + hw > L ? L : t + hw;
  const float inv = 1.0f / (float)(hi_ - lo);
  bf16x8 af[8];
#pragma unroll
  for (int ks = 0; ks < 8; ++ks) {
    const int c0 = g * 128 + ks * 16 + hi * 8;
    float s[8];
#pragma unroll
    for (int e = 0; e < 8; ++e) s[e] = 0.f;
    for (int j = 0; j < w; ++j) {
      const int tt = t - hw + j; const bool ok = tt >= 0 && tt < L; const int tc = tt < 0 ? 0 : (tt >= L ? L - 1 : tt);
      const bf16x8 v = *(const bf16x8*)(ZP16 + (size_t)(rb + tc) * 512 + c0);
      const float m = ok ? 1.f : 0.f;
#pragma unroll
      for (int e = 0; e < 8; ++e) s[e] += m * __uint_as_float((unsigned)(unsigned short)v[e] << 16);
    }
    const bf16x8 own = *(const bf16x8*)(ZP16 + (size_t)(rb + t) * 512 + c0);
    v4u pk;
    pk.x = cvtpk(s[0] * inv - __uint_as_float((unsigned)(unsigned short)own[0] << 16), s[1] * inv - __uint_as_float((unsigned)(unsigned short)own[1] << 16));
    pk.y = cvtpk(s[2] * inv - __uint_as_float((unsigned)(unsigned short)own[2] << 16), s[3] * inv - __uint_as_float((unsigned)(unsigned short)own[3] << 16));
    pk.z = cvtpk(s[4] * inv - __uint_as_float((unsigned)(unsigned short)own[4] << 16), s[5] * inv - __uint_as_float((unsigned)(unsigned short)own[5] << 16));
    pk.w = cvtpk(s[6] * inv - __uint_as_float((unsigned)(unsigned short)own[6] << 16), s[7] * inv - __uint_as_float((unsigned)(unsigned short)own[7] << 16));
    af[ks] = *reinterpret_cast<bf16x8*>(&pk);
  }
  f32x16 acc[4] = {};
#pragma unroll
  for (int d0 = 0; d0 < 4; ++d0)
#pragma unroll
    for (int ks = 0; ks < 8; ++ks) {
      const bf16x8 bfr = *(const bf16x8*)(pwT16 + ((size_t)g * 128 + d0 * 32 + r32) * 128 + ks * 16 + hi * 8);
      acc[d0] = __builtin_amdgcn_mfma_f32_32x32x16_bf16(af[ks], bfr, acc[d0], 0, 0, 0);
    }
#pragma unroll
  for (int d0 = 0; d0 < 4; ++d0) {
    const int dcol = g * 128 + d0 * 32 + r32; const float pb = pool_b[dcol], ps = pool_scale[dcol];
#pragma unroll
    for (int r = 0; r < 16; ++r) mix16[(size_t)(row0 + crow(r, hi)) * D + dcol] = (unsigned short)f2bf((acc[d0][r] + pb) * ps);
  }
}
#undef KSWZ
#undef SBAR
}
__device__ __forceinline__ float wave_sum(float v) {
#pragma unroll
    for (int o = 1; o < 64; o <<= 1) v += __shfl_xor(v, o);
    return v;
}
__device__ __forceinline__ float wave_max(float v) {
#pragma unroll
    for (int o = 1; o < 64; o <<= 1) v = fmaxf(v, __shfl_xor(v, o));
    return v;
}
__device__ __forceinline__ void p0_lam_rope(const float* __restrict__ dl, float* __restrict__ lam_out, float* __restrict__ rope, int gtid, int gthreads) {
    if (gtid == 0) {
        double s01 = 0, s23 = 0;
        for (int i = 0; i < 64; ++i) { s01 += (double)dl[i] * dl[64 + i]; s23 += (double)dl[128 + i] * dl[192 + i]; }
        lam_out[0] = (float)(exp(s01) - exp(s23) + 0.2);
    }
    for (int gid = gtid; gid < L * 32; gid += gthreads) {
        const int t = gid / 32, a = (gid / 16) & 1, i = gid & 15;
        const double pos = a == 0 ? (double)(t / 64) : (double)(t % 64);
        const double ang = pos * pow(10000.0, -(double)i / 16.0);
        rope[gid * 2 + 0] = (float)cos(ang);
        rope[gid * 2 + 1] = (float)sin(ang);
    }
}
__device__ __forceinline__ void p0_ada_unit(int unit, const float* __restrict__ ada_w, float* __restrict__ part, LAS float* sv, LAS float* red, int wave, int lane, int tid) {
    const int cc = unit % 48, ks = unit / 48;
    const int col = cc * 256 + lane * 4;
    f32x4 acc[5];
#pragma unroll
    for (int r = 0; r < 5; ++r) acc[r] = (f32x4){0.f, 0.f, 0.f, 0.f};
    const int k0 = ks * 128 + wave * 16;
#pragma unroll 4
    for (int kk = 0; kk < 16; ++kk) {
        const int k = k0 + kk;
        const f32x4 wv = *(const f32x4*)(ada_w + (size_t)k * (6 * D) + col);
#pragma unroll
        for (int r = 0; r < 5; ++r) acc[r] += wv * sv[r * D + k];
    }
#pragma unroll
    for (int r = 0; r < 5; ++r) *(LAS f32x4*)(red + (wave * 5 + r) * 256 + lane * 4) = acc[r];
    __syncthreads();
    for (int idx = tid; idx < 5 * 256; idx += NWAVES * 64) {
        float s = 0.f;
#pragma unroll
        for (int w = 0; w < 8; ++w) s += red[w * 1280 + idx];
        part[((size_t)ks * 5 + idx / 256) * (6 * D) + cc * 256 + (idx & 255)] = s;
    }
    __syncthreads();
}
__device__ __forceinline__ void p0_row_to_fp8(const float* __restrict__ src, unsigned char* __restrict__ dst, float* __restrict__ inv_scale, int lane) {
    f32x4 v[8];
#pragma unroll
    for (int j = 0; j < 4; ++j) { v[j] = *(const f32x4*)(src + lane * 16 + j * 4); v[4 + j] = *(const f32x4*)(src + 1024 + lane * 16 + j * 4); }
    float am = 0.f;
#pragma unroll
    for (int j = 0; j < 8; ++j) am = fmaxf(am, fmaxf(fmaxf(fabsf(v[j][0]), fabsf(v[j][1])), fmaxf(fabsf(v[j][2]), fabsf(v[j][3]))));
    am = wave_max(am);
    float s = 1.f;
    if (am > 0.f) s = exp2f(floorf(log2f(224.f / am)));
    if (lane == 0) *inv_scale = 1.0f / s;
    v4u o0, o1;
#define PK8(a, b) ({ int _w = 0; _w = __builtin_amdgcn_cvt_pk_fp8_f32((a)[0] * s, (a)[1] * s, _w, false); _w = __builtin_amdgcn_cvt_pk_fp8_f32((a)[2] * s, (a)[3] * s, _w, true); (unsigned)_w; })
    o0.x = PK8(v[0], 0); o0.y = PK8(v[1], 0); o0.z = PK8(v[2], 0); o0.w = PK8(v[3], 0);
    o1.x = PK8(v[4], 0); o1.y = PK8(v[5], 0); o1.z = PK8(v[6], 0); o1.w = PK8(v[7], 0);
#undef PK8
    *(v4u*)(dst + lane * 16) = o0;
    *(v4u*)(dst + 1024 + lane * 16) = o1;
}
template <class LD4>
__device__ __forceinline__ void norm_row_bf16(const float* __restrict__ xr, const float* __restrict__ g, LD4 ldmod, bf16* __restrict__ orow, int lane, float rstd_in, bool have_rstd) {
    f32x4 v[8]; float ss = 0.f;
#pragma unroll
    for (int j = 0; j < 8; ++j) { v[j] = *(const f32x4*)(xr + lane * 4 + 256 * j); ss += (v[j][0] * v[j][0] + v[j][1] * v[j][1]) + (v[j][2] * v[j][2] + v[j][3] * v[j][3]); }
    float rstd = rstd_in;
    if (!have_rstd) rstd = 1.0f / sqrtf(wave_sum(ss) * (1.0f / D) + EPS);
#pragma unroll
    for (int j = 0; j < 8; ++j) {
        const int col = lane * 4 + 256 * j;
        const f32x4 gv = *(const f32x4*)(g + col);
        const f32x4 sh = ldmod(0, col), sc = ldmod(1, col);
        const f32x4 o = v[j] * rstd * gv * (sc + 1.0f) + sh;
        uint2 w; w.x = pk2(o[0], o[1]); w.y = pk2(o[2], o[3]);
        *(uint2*)(orow + col) = w;
    }
}
namespace peer {
using f32x16 = __attribute__((ext_vector_type(16))) float;
using f32x2 = __attribute__((ext_vector_type(2))) float;
__device__ __forceinline__ int crow(int r, int hi) { return (r & 3) + 8 * (r >> 2) + 4 * hi; }
__device__ __forceinline__ float med3(float a, float b, float c) { return __builtin_amdgcn_fmed3f(a, b, c); }
__device__ __forceinline__ void ins16(float (&l)[16], float x) {
#pragma unroll
    for (int i = 15; i >= 1; --i) l[i] = med3(l[i - 1], l[i], x);
    l[0] = fmaxf(l[0], x);
}
__device__ __forceinline__ void merge_pair(float (&l)[16]) {
    float c[16];
#pragma unroll
    for (int i = 0; i < 16; ++i) { const float o = __shfl_xor(l[15 - i], 32); c[i] = fmaxf(l[i], o); }
#pragma unroll
    for (int d = 8; d >= 1; d >>= 1)
#pragma unroll
        for (int i = 0; i < 16; ++i) if ((i & d) == 0) { const float a = c[i], b = c[i + d]; c[i] = fmaxf(a, b); c[i + d] = fminf(a, b); }
#pragma unroll
    for (int i = 0; i < 16; ++i) l[i] = c[i];
}
__device__ __forceinline__ void topk_unit(int t0, int h, const bf16* __restrict__ qp16, const bf16* __restrict__ keys16, const float* __restrict__ su, const float* __restrict__ sv,
                                          int* __restrict__ eidx, float* __restrict__ egsv, float* __restrict__ esu, LAS unsigned char* scr, int lane) {
    const int r32 = lane & 31, hi = lane >> 5;
    float la[16], lb[16];
#pragma unroll
    for (int p = 0; p < 2; ++p) {
        f32x16 acc[4] = {};
        const bf16* qrow = qp16 + (size_t)(t0 + r32) * D + h * 256 + p * 128 + hi * 8;
        const bf16* kbase = keys16 + ((size_t)(h * 2 + p) * PNK + r32) * 128 + hi * 8;
#pragma unroll 2
        for (int ks = 0; ks < 8; ++ks) {
            const bf16x8 qf = *(const bf16x8*)(qrow + ks * 16);
#pragma unroll
            for (int kb = 0; kb < 4; ++kb) {
                const bf16x8 kf = *(const bf16x8*)(kbase + (size_t)kb * 32 * 128 + ks * 16);
                acc[kb] = __builtin_amdgcn_mfma_f32_32x32x16_bf16(kf, qf, acc[kb], 0, 0, 0);
            }
        }
        float l[16];
#pragma unroll
        for (int i = 0; i < 16; ++i) l[i] = -INFINITY;
#pragma unroll
        for (int kb = 0; kb < 4; ++kb)
#pragma unroll
            for (int r = 0; r < 16; ++r) {
                const unsigned k = (unsigned)(32 * kb + crow(r, hi));
                const float x = __uint_as_float((__float_as_uint(acc[kb][r]) & ~0x7Fu) | k);
                ins16(l, x);
            }
        merge_pair(l);
        if (p == 0) {
#pragma unroll
            for (int i = 0; i < 16; ++i) la[i] = l[i];
        } else {
#pragma unroll
            for (int i = 0; i < 16; ++i) lb[i] = l[i];
        }
    }
    {
        unsigned w[4];
#pragma unroll
        for (int q = 0; q < 4; ++q) {
            unsigned x = 0;
#pragma unroll
            for (int e = 0; e < 4; ++e) { float va = la[4 * q + e], vb_ = lb[4 * q + e]; asm volatile("" : "+v"(va), "+v"(vb_)); const float v = hi ? vb_ : va; x |= (__float_as_uint(v) & 0x7Fu) << (8 * e); }
            w[q] = x;
        }
        *(LAS v4u*)(scr + r32 * 32 + hi * 16) = (v4u){w[0], w[1], w[2], w[3]};
    }
    float l[16];
#pragma unroll
    for (int i = 0; i < 16; ++i) l[i] = -INFINITY;
    {
        int n = 0; float pend = 0.f;
#pragma unroll
        for (int i = 0; i < 16; ++i)
#pragma unroll
            for (int j = 0; j < 16; ++j) if ((i + 1) * (j + 1) <= 16) {
                const float s = la[i] + lb[j];
                const float x = __uint_as_float((__float_as_uint(s) & ~0xFFu) | (unsigned)(i * 16 + j));
                if ((n & 1) == 0) pend = x; else ins16(l, hi ? x : pend);
                ++n;
            }
    }
    merge_pair(l);
    asm volatile("s_waitcnt lgkmcnt(0)" ::: "memory");
    float ex[16], sum = 0.f;
#pragma unroll
    for (int i = 0; i < 16; ++i) { ex[i] = __expf(l[i] - l[0]); sum += ex[i]; }
    const float inv = 1.0f / sum;
    const size_t ob = ((size_t)(t0 + r32) * PH + h) * PTOPK + hi * 8;
#pragma unroll
    for (int n = 0; n < 8; ++n) {
        float vlo = l[n], vhi = l[8 + n], elo = ex[n], ehi = ex[8 + n];
        asm volatile("" : "+v"(vlo), "+v"(vhi), "+v"(elo), "+v"(ehi));
        const float v = hi ? vhi : vlo;
        const float g = (hi ? ehi : elo) * inv;
        const unsigned c = __float_as_uint(v) & 0xFFu;
        const unsigned ia = scr[r32 * 32 + (c >> 4)], ib = scr[r32 * 32 + 16 + (c & 15)];
        const int e = (int)(ia * PNK + ib);
        eidx[ob + n] = e; egsv[ob + n] = g * sv[e]; esu[ob + n] = su[e];
    }
}

__device__ __forceinline__ f32x2 cvt8(unsigned w, bool hiw) { return hiw ? __builtin_amdgcn_cvt_pk_f32_fp8((int)w, true) : __builtin_amdgcn_cvt_pk_f32_fp8((int)w, false); }
__device__ __forceinline__ void peer_token(int t, const bf16* __restrict__ f16, const int* __restrict__ eidx, const float* __restrict__ egsv, const float* __restrict__ esu,
                                           const unsigned char* __restrict__ U8, const unsigned char* __restrict__ V8, const float* __restrict__ g2, const float* __restrict__ fg,
                                           float* __restrict__ xio, int lane) {
    f32x2 fr[16], acc[16];
    {
        const bf16* fp = f16 + (size_t)t * D + lane * 16;
        const v4u a0 = *(const v4u*)fp, a1 = *(const v4u*)(fp + 8), b0 = *(const v4u*)(fp + 1024), b1 = *(const v4u*)(fp + 1032);
        const unsigned w[16] = {a0.x, a0.y, a0.z, a0.w, a1.x, a1.y, a1.z, a1.w, b0.x, b0.y, b0.z, b0.w, b1.x, b1.y, b1.z, b1.w};
#pragma unroll
        for (int i = 0; i < 16; ++i) { fr[i] = (f32x2){__uint_as_float(w[i] << 16), __uint_as_float(w[i] & 0xFFFF0000u)}; acc[i] = (f32x2){0.f, 0.f}; }
    }
    const int e_a = eidx[(size_t)t * 128 + lane], e_b = eidx[(size_t)t * 128 + 64 + lane];
    const float g_a = egsv[(size_t)t * 128 + lane], g_b = egsv[(size_t)t * 128 + 64 + lane];
    const float s_a = esu[(size_t)t * 128 + lane], s_b = esu[(size_t)t * 128 + 64 + lane];
    const int k2 = lane >> 4;
    v4u ub[4][2], vb[4][2];
#define LOADROWS(buf, base, grp) do { _Pragma("unroll") for (int k = 0; k < 4; ++k) { \
        const int ee = (grp) < 16 ? __builtin_amdgcn_readlane(e_a, ((grp) & 15) * 4 + k) : __builtin_amdgcn_readlane(e_b, ((grp) & 15) * 4 + k); \
        const unsigned char* rp = (base) + (size_t)ee * D + lane * 16; buf[k][0] = *(const v4u*)rp; buf[k][1] = *(const v4u*)(rp + 1024); } } while (0)
    LOADROWS(ub, U8, 0); LOADROWS(vb, V8, 0);
#pragma unroll 1
    for (int grp = 0; grp < 32; ++grp) {
        float dt[4];
#pragma unroll
        for (int k = 0; k < 4; ++k) {
            f32x2 s = {0.f, 0.f};
#pragma unroll
            for (int hf = 0; hf < 2; ++hf) {
                const unsigned w[4] = {ub[k][hf].x, ub[k][hf].y, ub[k][hf].z, ub[k][hf].w};
#pragma unroll
                for (int q = 0; q < 4; ++q) { s += cvt8(w[q], false) * fr[hf * 8 + q * 2]; s += cvt8(w[q], true) * fr[hf * 8 + q * 2 + 1]; }
            }
            dt[k] = s[0] + s[1];
        }
        if (grp + 1 < 32) LOADROWS(ub, U8, grp + 1);
        {
            auto r0 = __builtin_amdgcn_permlane32_swap(__float_as_uint(dt[0]), __float_as_uint(dt[2]), false, false);
            auto r1 = __builtin_amdgcn_permlane32_swap(__float_as_uint(dt[1]), __float_as_uint(dt[3]), false, false);
            float x0 = __uint_as_float(r0[0]) + __uint_as_float(r0[1]);
            float x1 = __uint_as_float(r1[0]) + __uint_as_float(r1[1]);
            const bool b4 = (lane & 16) != 0;
            const float keep = b4 ? x1 : x0, send = b4 ? x0 : x1;
            float y = keep + __shfl_xor(send, 16);
            y += __shfl_xor(y, 8); y += __shfl_xor(y, 4); y += __shfl_xor(y, 2); y += __shfl_xor(y, 1);
            dt[0] = y;
        }
        const int ent = (grp & 15) * 4 + k2;
        const float gsv = grp < 16 ? __shfl(g_a, ent) : __shfl(g_b, ent);
        const float isu = grp < 16 ? __shfl(s_a, ent) : __shfl(s_b, ent);
        const float dv = dt[0] * isu;
        const float wgt = gsv * 0.5f * dv * (1.f + erff(dv * 0.70710678118654752f));
#pragma unroll
        for (int k = 0; k < 4; ++k) {
            const float wk = __uint_as_float(__builtin_amdgcn_readlane(__float_as_uint(wgt), 16 * k));
            const f32x2 wk2 = {wk, wk};
#pragma unroll
            for (int hf = 0; hf < 2; ++hf) {
                const unsigned w[4] = {vb[k][hf].x, vb[k][hf].y, vb[k][hf].z, vb[k][hf].w};
#pragma unroll
                for (int q = 0; q < 4; ++q) { acc[hf * 8 + q * 2] += cvt8(w[q], false) * wk2; acc[hf * 8 + q * 2 + 1] += cvt8(w[q], true) * wk2; }
            }
        }
        if (grp + 1 < 32) LOADROWS(vb, V8, grp + 1);
    }
#undef LOADROWS
    float* xr = xio + (size_t)t * D + lane * 16;
    const float* gr = g2 + lane * 16; const float* fgr = fg + lane * 16;
    f32x4 xv[8]; float ss = 0.f;
#pragma unroll
    for (int j = 0; j < 8; ++j) {
        const int off = (j >> 2) * 1024 + (j & 3) * 4;
        const f32x4 x1v = *(const f32x4*)(xr + off), gv = *(const f32x4*)(gr + off);
        const f32x4 pv = {acc[2 * j][0], acc[2 * j][1], acc[2 * j + 1][0], acc[2 * j + 1][1]};
        xv[j] = x1v + gv * pv;
        ss += (xv[j][0] * xv[j][0] + xv[j][1] * xv[j][1]) + (xv[j][2] * xv[j][2] + xv[j][3] * xv[j][3]);
    }
    ss = wave_sum(ss);
    const float rstd = 1.0f / sqrtf(ss * (1.0f / D) + EPS);
#pragma unroll
    for (int j = 0; j < 8; ++j) { const int off = (j >> 2) * 1024 + (j & 3) * 4; *(f32x4*)(xr + off) = xv[j] * rstd * *(const f32x4*)(fgr + off); }
}
}
__device__ __forceinline__ void p0_transpose_item(const float* W, int K, int N, bf16* WT, int row_off, LAS float* scr, int item, int lane) {
    const int nblk = N / 32, kb = item / nblk, nb = item % nblk, k0 = 64 * kb, n0 = 32 * nb;
#pragma unroll 8
    for (int i = 0; i < 32; ++i) { const int kk = 2 * i + (lane >> 5); scr[kk * 33 + (lane & 31)] = W[(size_t)(k0 + kk) * N + n0 + (lane & 31)]; }
    LDS_WAIT(); asm volatile("" ::: "memory");
    const int c = lane & 7;
#pragma unroll
    for (int j = 0; j < 4; ++j) { const int n = (lane >> 3) + 8 * j; const LAS float* s = scr + (8 * c) * 33 + n;
        v4u o; o.x = pk2(s[0 * 33], s[1 * 33]); o.y = pk2(s[2 * 33], s[3 * 33]); o.z = pk2(s[4 * 33], s[5 * 33]); o.w = pk2(s[6 * 33], s[7 * 33]);
        *(GAS v4u*)(WT + (size_t)(row_off + n0 + n) * K + k0 + 8 * c) = o; }
    LDS_WAIT(); asm volatile("" ::: "memory");
}

struct Args { const float* in[20]; float* out; unsigned char* ws; int ph_lo, ph_hi, li, pad; };
__device__ __forceinline__ const float* karg_ptr(int off) {
    const __attribute__((address_space(4))) char* kp = (const __attribute__((address_space(4))) char*)__builtin_amdgcn_kernarg_segment_ptr();
    asm volatile("" : "+s"(off));
    return *(const float* const __attribute__((address_space(4)))*)(kp + off);
}

__global__ void __launch_bounds__(NWAVES * 64, 2) mega(Args args) {
    extern __shared__ __attribute__((aligned(16))) unsigned char lds[];
    LAS unsigned char* ldsl = (LAS unsigned char*)lds;
    volatile LAS unsigned* MISC = (volatile LAS unsigned*)(ldsl + MISC_OFF);
    const int G = gridDim.x;
#define PHASE_IDS() int tid = threadIdx.x; asm volatile("" : "+v"(tid)); const int lane = tid & 63, wave = __builtin_amdgcn_readfirstlane(tid >> 6); \
    const int gw = blockIdx.x * NWAVES + wave, NGW = G * NWAVES, gtid = blockIdx.x * (NWAVES * 64) + tid, gthreads = G * NWAVES * 64; (void)lane; (void)gw; (void)NGW; (void)gtid; (void)gthreads
    unsigned char* ws = args.ws;
    gu32* ctl = (gu32*)(ws + WS_CTL);
    for (int u = threadIdx.x; u < (LDS_BYTES - LDSCTL_OFF) / 4; u += NWAVES * 64) ((LAS unsigned*)(ldsl + LDSCTL_OFF))[u] = 0u;
    __syncthreads();
    XcdBarrier bar = xcd_barrier_post((unsigned*)(ctl + CW_BAR) + args.li * XCD_BAR_WORDS, MISC + 8);
    const int lo = args.ph_lo, hi = args.ph_hi;
#define IN(k) (lo <= (k) && (k) < hi)
#define SEAM(k) do { if (IN(k) && (k) + 1 < hi) xcd_barrier(bar); } while (0)

#define ARGP(i) karg_ptr((i) * 8)
#define ARG_OUT ((float*)karg_ptr(160))
#define Wt_in ((bf16*)(ws + WS_WIN))
#define Wt_out ((bf16*)(ws + WS_WOUT))
#define Wt_q ((bf16*)(ws + WS_WQ))
#define pwT16 ((bf16*)(ws + WS_PWT16))
#define mod ((float*)(ws + WS_MOD))
#define rope ((float*)(ws + WS_ROPE))
#define adap ((float*)(ws + WS_ADAP))
#define ssq ((float*)(ws + WS_SSQ))

    if (IN(0)) {
        PHASE_IDS();
        LAS float* scr = (LAS float*)(ldsl + RING_OFF + wave * 16384);
        const float* w_in = ARGP(7); const float* w_out = ARGP(13); const float* peer_wq = ARGP(15); const float* pool_w = ARGP(8);
        constexpr int I_IN = (D / 64) * (INW / 32), I_O = (D / 64) * (D / 32);
        for (int it = gw; it < I_IN + 2 * I_O + 32; it += NGW) {
            int r = it;
            if (r < I_IN) { p0_transpose_item(w_in, D, INW, Wt_in, 0, scr, r, lane); continue; } r -= I_IN;
            if (r < I_O) { p0_transpose_item(w_out, D, D, Wt_out, 0, scr, r, lane); continue; } r -= I_O;
            if (r < I_O) { p0_transpose_item(peer_wq, D, D, Wt_q, 0, scr, r, lane); continue; } r -= I_O;
            p0_transpose_item(pool_w + (size_t)(r >> 3) * 16384, 128, 128, pwT16 + (size_t)(r >> 3) * 16384, 0, scr, r & 7, lane);
        }
        { const float* keys = ARGP(16); bf16* keys16 = (bf16*)(ws + WS_KEYS16);
          for (int i = gtid; i < 2 * PH * PNK * 128 / 4; i += gthreads) { const f32x4 v = *(const f32x4*)(keys + (size_t)i * 4); uint2 o; o.x = pk2(v[0], v[1]); o.y = pk2(v[2], v[3]); *(uint2*)(keys16 + (size_t)i * 4) = o; } }
        p0_lam_rope(ARGP(11), (float*)(ws + WS_LAM), rope, gtid, gthreads);
        __syncthreads();
        { LAS float* sv = (LAS float*)(ldsl + RING_OFF); LAS float* red = sv + 5 * D;
          const float* cvec = ARGP(1); const float* cctx = ARGP(3); const float* ada_w = ARGP(4);
          for (int i = tid; i < 5 * D; i += NWAVES * 64) { const int r = i / D, k = i % D; const float xv = r < 4 ? cvec[r * D + k] : cctx[k]; sv[i] = xv / (1.f + expf(-xv)); }
          __syncthreads();
          for (int unit = blockIdx.x; unit < 768; unit += G) p0_ada_unit(unit, ada_w, adap, sv, red, wave, lane, tid); }
        { const float* pu = ARGP(17); const float* pv = ARGP(18);
          unsigned char* U8 = ws + WS_U8; unsigned char* V8 = ws + WS_V8; float* su = (float*)(ws + WS_SU); float* svs = (float*)(ws + WS_SV);
          for (int row = gw; row < 2 * NEXP; row += NGW) {
              if (row < NEXP) p0_row_to_fp8(pu + (size_t)row * D, U8 + (size_t)row * D, su + row, lane);
              else p0_row_to_fp8(pv + (size_t)(row - NEXP) * D, V8 + (size_t)(row - NEXP) * D, svs + (row - NEXP), lane);
          } }
    }
    SEAM(0);
    if (IN(1)) {
        PHASE_IDS();
        const float* ada_b = ARGP(5); const float* norm1_g = ARGP(6); const float* ctxp = ARGP(2); const float* x = ARGP(0);
        bf16* h16 = (bf16*)(ws + WS_H16);
        if (tid < 240) { const int idx = blockIdx.x * 240 + tid; const int r = idx / (6 * D), col = idx % (6 * D);
            float s = ada_b[col];
#pragma unroll
            for (int ks = 0; ks < 16; ++ks) s += adap[((size_t)ks * 5 + r) * (6 * D) + col];
            mod[(size_t)r * (6 * D) + col] = s; }
        LAS float* modl = (LAS float*)(ldsl + RING_OFF);
        const int bb = blockIdx.x >> 6;
        for (int i = tid; i < 8192; i += NWAVES * 64) { const int r = i < 4096 ? bb : 4, col = i & 4095;
            float s = ada_b[col];
#pragma unroll
            for (int ks = 0; ks < 16; ++ks) s += adap[((size_t)ks * 5 + r) * (6 * D) + col];
            modl[i] = s; }
        __syncthreads();
#pragma unroll 1
        for (int j = 0; j < 4; ++j) { const int row = blockIdx.x * 32 + wave * 4 + j;
            norm_row_bf16(x + (size_t)row * D, norm1_g, [=](int which, int col) { return *(const LAS f32x4*)(modl + which * 2048 + col); }, h16 + (size_t)row * D, lane, 0.f, false); }
        if (wave < 4) { const int r = blockIdx.x * 4 + wave;
            norm_row_bf16(ctxp + (size_t)r * D, norm1_g, [=](int which, int col) { return *(const LAS f32x4*)(modl + 4096 + which * 2048 + col); }, h16 + (size_t)(NLAT + r) * D, lane, 0.f, false); }
    }
    SEAM(1);
    if (IN(2)) {
        pg8::Gemm g{(const bf16*)(ws + WS_H16), Wt_in, NTOK, INW, D};
        pg8::InProjOrder S; S.init(G, (int)blockIdx.x);
        pg8::EpiInProj E{(bf16*)(ws + WS_ZP16), (bf16*)(ws + WS_Q16), (bf16*)(ws + WS_K16), (bf16*)(ws + WS_V16), rope};
        pg8::gemm_phase<pg8::EpiInProj, pg8::InProjOrder, true, true>(ldsl + RING_OFF, g, S, E);
    }
    SEAM(2);
    if (IN(3)) {
        PHASE_IDS();
        bf16* mix16 = (bf16*)(ws + WS_MIX16);
        const float* pool_b = ARGP(9); const float* pool_scale = ARGP(10); const float* subln_g = ARGP(12);
        if (wave < 4) for (int tile = blockIdx.x; tile < NLAT / 32; tile += G) att::pool_item(tile, wave, (const bf16*)(ws + WS_ZP16), pwT16, pool_b, pool_scale, mix16, lane);
        const float lam = *(const float*)(ws + WS_LAM);
        for (int u = blockIdx.x; u < 768; u += G) {
            int bh, qb;
            if (G == 256) { const int i = u >> 8, c = u & 255, xcd = c & 7, j = c >> 3; bh = i * 16 + xcd * 2 + (j >> 4); qb = j & 15; }
            else { bh = u >> 4; qb = u & 15; }
            att::attn_unit(bh / NH, bh % NH, qb, (const bf16*)(ws + WS_Q16), (const bf16*)(ws + WS_K16), (const bf16*)(ws + WS_V16), mix16, lam, subln_g, (char*)lds + RING_OFF);
        }
    }
    SEAM(3);
    if (IN(4)) {
        pg8::Gemm g{(const bf16*)(ws + WS_MIX16), Wt_out, NLAT, D, D};
        pg8::StaticOrder S; S.init(NLAT, D, G, (int)blockIdx.x);
        pg8::EpiOutProj E{ARGP(0), mod, ARG_OUT, (float*)(ws + WS_SSQ)};
        pg8::gemm_phase<pg8::EpiOutProj, pg8::StaticOrder, true, true>(ldsl + RING_OFF, g, S, E);
    }
    SEAM(4);
    if (IN(5)) {
        PHASE_IDS();
        const float* norm2_g = ARGP(14); float* xo = ARG_OUT; bf16* f16 = (bf16*)(ws + WS_F16);
        const float* sh2 = mod + (size_t)(blockIdx.x >> 6) * (6 * D) + 3 * D; const float* sc2 = sh2 + D;
#pragma unroll 1
        for (int j = 0; j < 4; ++j) { const int row = blockIdx.x * 32 + wave * 4 + j;
            const float p = lane < 32 ? ssq[(size_t)row * 32 + lane] : 0.f;
            const float rstd = 1.0f / sqrtf(wave_sum(p) * (1.0f / D) + EPS);
            norm_row_bf16(xo + (size_t)row * D, norm2_g, [=](int which, int col) { return *(const f32x4*)((which ? sc2 : sh2) + col); }, f16 + (size_t)row * D, lane, rstd, true); }
    }
    SEAM(5);
    if (IN(6)) {
        pg8::Gemm g{(const bf16*)(ws + WS_F16), Wt_q, NLAT, D, D};
        pg8::StaticOrder S; S.init(NLAT, D, G, (int)blockIdx.x);
        pg8::EpiBf16Plain E{(bf16*)(ws + WS_QP16), D};
        pg8::gemm_phase<pg8::EpiBf16Plain, pg8::StaticOrder, true, true>(ldsl + RING_OFF, g, S, E);
    }
    SEAM(6);
    if (IN(7)) {
        PHASE_IDS();
        for (int unit = gw; unit < (NLAT / 32) * PH; unit += NGW)
            peer::topk_unit((unit >> 3) * 32, unit & 7, (const bf16*)(ws + WS_QP16), (const bf16*)(ws + WS_KEYS16), (const float*)(ws + WS_SU), (const float*)(ws + WS_SV),
                            (int*)(ws + WS_EIDX), (float*)(ws + WS_EGATE), (float*)(ws + WS_ESU), ldsl + RING_OFF + wave * 1024, lane);
    }
    SEAM(7);
    if (IN(8)) {
        PHASE_IDS();
        const float* fgp = ARGP(19); float* xo = ARG_OUT;
        for (int t = gw; t < NLAT; t += NGW)
            peer::peer_token(t, (const bf16*)(ws + WS_F16), (const int*)(ws + WS_EIDX), (const float*)(ws + WS_EGATE), (const float*)(ws + WS_ESU),
                             ws + WS_U8, ws + WS_V8, mod + (size_t)(t >> 11) * (6 * D) + 5 * D, fgp, xo, lane);
    }
#undef IN
#undef SEAM
#undef mod
#undef rope
#undef adap
#undef ssq
#undef Wt_in
#undef Wt_out
#undef Wt_q
#undef pwT16
}
__global__ void k_prep(const float* __restrict__ dl, float* __restrict__ lam_out, float* __restrict__ rope  ) {
    int gid = blockIdx.x * blockDim.x + threadIdx.x;
    if (gid == 0) {
        double s01 = 0, s23 = 0;
        for (int i = 0; i < 64; ++i) { s01 += (double)dl[i] * dl[64 + i]; s23 += (double)dl[128 + i] * dl[192 + i]; }
        lam_out[0] = (float)(exp(s01) - exp(s23) + 0.2);
    }
    if (gid < L * 32) {
        int t = gid / 32, a = (gid / 16) & 1, i = gid & 15;
        double pos = a == 0 ? (double)(t / 64) : (double)(t % 64);
        double invf = pow(10000.0, -(double)i / 16.0);
        double ang = pos * invf;
        rope[gid * 2 + 0] = (float)cos(ang);
        rope[gid * 2 + 1] = (float)sin(ang);
    }
}

__global__ void k_ada(const float* __restrict__ c, const float* __restrict__ cctx, const float* __restrict__ w, const float* __restrict__ bvec, float* __restrict__ mod) {
    __shared__ float sv[5][D];
    for (int i = threadIdx.x; i < 5 * D; i += blockDim.x) {
        int r = i / D, k = i % D;
        float x = r < 4 ? c[r * D + k] : cctx[k];
        sv[r][k] = x / (1.f + expf(-x));
    }
    __syncthreads();
    int j = blockIdx.x * blockDim.x + threadIdx.x;
    float a0 = 0, a1 = 0, a2 = 0, a3 = 0, a4 = 0;
#pragma unroll 8
    for (int k = 0; k < D; ++k) {
        float wv = w[(size_t)k * (6 * D) + j];
        a0 += sv[0][k] * wv; a1 += sv[1][k] * wv; a2 += sv[2][k] * wv; a3 += sv[3][k] * wv; a4 += sv[4][k] * wv;
    }
    float bb = bvec[j];
    mod[0 * 6 * D + j] = a0 + bb; mod[1 * 6 * D + j] = a1 + bb; mod[2 * 6 * D + j] = a2 + bb; mod[3 * 6 * D + j] = a3 + bb; mod[4 * 6 * D + j] = a4 + bb;
}

__global__ void k_norm_mod(const float* __restrict__ xlat, const float* __restrict__ xctx, int nlat, const float* __restrict__ g,
                           const float* __restrict__ mod, int sh_off, int sc_off, float* __restrict__ out) {
    int row = blockIdx.x, tid = threadIdx.x;
    const float* xr = row < nlat ? xlat + (size_t)row * D : xctx + (size_t)(row - nlat) * D;
    int mr = row < nlat ? row / L : 4;
    float v[8]; float ss = 0;
#pragma unroll
    for (int i = 0; i < 8; ++i) { v[i] = xr[tid + 256 * i]; ss += v[i] * v[i]; }
    __shared__ float red[256];
    red[tid] = ss; __syncthreads();
    for (int s = 128; s > 0; s >>= 1) { if (tid < s) red[tid] += red[tid + s]; __syncthreads(); }
    float rstd = 1.0f / sqrtf(red[0] / (float)D + EPS);
    const float* mrow = mod + (size_t)mr * 6 * D;
#pragma unroll
    for (int i = 0; i < 8; ++i) {
        int col = tid + 256 * i;
        out[(size_t)row * D + col] = v[i] * rstd * g[col] * (1.f + mrow[sc_off + col]) + mrow[sh_off + col];
    }
}

__global__ void __launch_bounds__(256) k_gemm(const float* __restrict__ A, int lda, const float* __restrict__ Bm, int ldb, float* __restrict__ Cm, int ldc, int K,
                                              const float* __restrict__ resid, const float* __restrict__ gate, int gate_stride) {
    __shared__ float As[16][128 + 4];
    __shared__ float Bs[16][128 + 4];
    int tid = threadIdx.x, tx = tid & 15, ty = tid >> 4;
    int m0 = blockIdx.y * 128, n0 = blockIdx.x * 128;
    float acc[8][8];
#pragma unroll
    for (int i = 0; i < 8; ++i)
#pragma unroll
        for (int j = 0; j < 8; ++j) acc[i][j] = 0.f;
    for (int k0 = 0; k0 < K; k0 += 16) {
#pragma unroll
        for (int p = 0; p < 2; ++p) {
            int r = (tid >> 2) + 64 * p, kk = (tid & 3) * 4;
            float4 a = *(const float4*)&A[(size_t)(m0 + r) * lda + k0 + kk];
            As[kk + 0][r] = a.x; As[kk + 1][r] = a.y; As[kk + 2][r] = a.z; As[kk + 3][r] = a.w;
            int kb = (tid >> 5) + 8 * p, nn = (tid & 31) * 4;
            float4 b = *(const float4*)&Bm[(size_t)(k0 + kb) * ldb + n0 + nn];
            *(float4*)&Bs[kb][nn] = b;
        }
        __syncthreads();
#pragma unroll
        for (int kk = 0; kk < 16; ++kk) {
            float4 a0 = *(const float4*)&As[kk][ty * 4], a1 = *(const float4*)&As[kk][64 + ty * 4];
            float4 b0 = *(const float4*)&Bs[kk][tx * 4], b1 = *(const float4*)&Bs[kk][64 + tx * 4];
            float av[8] = {a0.x, a0.y, a0.z, a0.w, a1.x, a1.y, a1.z, a1.w};
            float bv[8] = {b0.x, b0.y, b0.z, b0.w, b1.x, b1.y, b1.z, b1.w};
#pragma unroll
            for (int i = 0; i < 8; ++i)
#pragma unroll
                for (int j = 0; j < 8; ++j) acc[i][j] += av[i] * bv[j];
        }
        __syncthreads();
    }
#pragma unroll
    for (int i = 0; i < 8; ++i) {
        int row = m0 + (i < 4 ? ty * 4 + i : 64 + ty * 4 + (i - 4));
#pragma unroll
        for (int jh = 0; jh < 2; ++jh) {
            int col = n0 + jh * 64 + tx * 4;
            float4 o = make_float4(acc[i][jh * 4 + 0], acc[i][jh * 4 + 1], acc[i][jh * 4 + 2], acc[i][jh * 4 + 3]);
            if (resid) {
                float4 r = *(const float4*)&resid[(size_t)row * ldc + col];
                float4 gv = *(const float4*)&gate[(size_t)(row / L) * gate_stride + col];
                o.x = r.x + gv.x * o.x; o.y = r.y + gv.y * o.y; o.z = r.z + gv.z * o.z; o.w = r.w + gv.w * o.w;
            }
            *(float4*)&Cm[(size_t)row * ldc + col] = o;
        }
    }
}

__global__ void k_rope(float* __restrict__ z, const float* __restrict__ rope) {
    size_t gid = (size_t)blockIdx.x * blockDim.x + threadIdx.x;
    if (gid >= (size_t)NLAT * 1536) return;
    int row = (int)(gid / 1536), r = (int)(gid % 1536);
    int kind = r / 768, rr = r % 768, h = rr / 64, r2 = rr % 64, m = r2 / 32, a = (r2 / 16) & 1, i = r2 & 15;
    int t = row % L;
    float cs = rope[((t * 2 + a) * 16 + i) * 2 + 0], sn = rope[((t * 2 + a) * 16 + i) * 2 + 1];
    size_t base = (size_t)row * INW + (kind == 0 ? QOFF : KOFF) + h * 128 + m * 64 + a * 32 + i;
    float x1 = z[base], x2 = z[base + 16];
    z[base] = x1 * cs - x2 * sn;
    z[base + 16] = x1 * sn + x2 * cs;
}

constexpr int AQR = 4;
__global__ void __launch_bounds__(256) k_attn(const float* __restrict__ z, const float* __restrict__ lamp, const float* __restrict__ subg, float* __restrict__ mix) {
    extern __shared__ float sm[];
    float* sa = sm;
    float* ss = sm + AQR * LK;
    float* qs = ss + AQR * LK;
    float* red = qs + AQR * 64;
    float* po = red + 256;
    const int tid = threadIdx.x;
    const int qt = blockIdx.x, h = blockIdx.y, b = blockIdx.z;
    const int q0 = qt * AQR;
    const float lam = lamp[0];
    for (int m = 0; m < 2; ++m) {
        __syncthreads();
        for (int i = tid; i < AQR * 64; i += 256) { int r = i / 64, d = i % 64; qs[i] = z[(size_t)(b * L + q0 + r) * INW + QOFF + h * 128 + m * 64 + d]; }
        __syncthreads();
        for (int k = tid; k < LK; k += 256) {
            int krow = k < CT ? NLAT + b * CT + k : b * L + (k - CT);
            const float* kp = z + (size_t)krow * INW + KOFF + h * 128 + m * 64;
            float acc[AQR];
#pragma unroll
            for (int r = 0; r < AQR; ++r) acc[r] = 0.f;
            for (int d = 0; d < 64; d += 4) {
                float4 kv = *(const float4*)(kp + d);
#pragma unroll
                for (int r = 0; r < AQR; ++r) acc[r] += kv.x * qs[r * 64 + d] + kv.y * qs[r * 64 + d + 1] + kv.z * qs[r * 64 + d + 2] + kv.w * qs[r * 64 + d + 3];
            }
#pragma unroll
            for (int r = 0; r < AQR; ++r) ss[r * LK + k] = acc[r] * 0.125f;
        }
        __syncthreads();
        for (int r = 0; r < AQR; ++r) {
            float mx = -INFINITY;
            for (int k = tid; k < LK; k += 256) mx = fmaxf(mx, ss[r * LK + k]);
            red[tid] = mx; __syncthreads();
            for (int s = 128; s > 0; s >>= 1) { if (tid < s) red[tid] = fmaxf(red[tid], red[tid + s]); __syncthreads(); }
            mx = red[0]; __syncthreads();
            float sum = 0.f;
            for (int k = tid; k < LK; k += 256) { float e = expf(ss[r * LK + k] - mx); ss[r * LK + k] = e; sum += e; }
            red[tid] = sum; __syncthreads();
            for (int s = 128; s > 0; s >>= 1) { if (tid < s) red[tid] += red[tid + s]; __syncthreads(); }
            float inv = 1.f / red[0]; __syncthreads();
            for (int k = tid; k < LK; k += 256) {
                float p = ss[r * LK + k] * inv;
                if (m == 0) sa[r * LK + k] = p; else sa[r * LK + k] -= lam * p;
            }
        }
    }
    __syncthreads();
    {
        int d = tid & 127, par = tid >> 7;
        float acc[AQR];
#pragma unroll
        for (int r = 0; r < AQR; ++r) acc[r] = 0.f;
        for (int k = par; k < LK; k += 2) {
            int krow = k < CT ? NLAT + b * CT + k : b * L + (k - CT);
            float vv = z[(size_t)krow * INW + VOFF + h * 128 + d];
#pragma unroll
            for (int r = 0; r < AQR; ++r) acc[r] += sa[r * LK + k] * vv;
        }
#pragma unroll
        for (int r = 0; r < AQR; ++r) po[(par * AQR + r) * 128 + d] = acc[r];
    }
    __syncthreads();
    {
        int r = tid >> 6, ln = tid & 63;
        float o0 = po[(0 * AQR + r) * 128 + ln] + po[(1 * AQR + r) * 128 + ln];
        float o1 = po[(0 * AQR + r) * 128 + 64 + ln] + po[(1 * AQR + r) * 128 + 64 + ln];
        float s2 = o0 * o0 + o1 * o1;
        for (int o = 32; o > 0; o >>= 1) s2 += __shfl_xor(s2, o);
        float rstd = 1.0f / sqrtf(s2 / 128.f + EPS);
        size_t ob = (size_t)(b * L + q0 + r) * D + POOLW + h * 128;
        mix[ob + ln] = o0 * rstd * subg[ln] * 0.8f;
        mix[ob + 64 + ln] = o1 * rstd * subg[64 + ln] * 0.8f;
    }
}

__global__ void k_pool(const float* __restrict__ z, const float* __restrict__ pw, const float* __restrict__ pb, const float* __restrict__ psc, float* __restrict__ mix) {
    __shared__ float y[128];
    int row = blockIdx.x, g = blockIdx.y, c = threadIdx.x;
    int b = row / L, t = row % L;
    int w = 2 << g;
    int lo = t - w / 2; if (lo < 0) lo = 0;
    int hi = t + w / 2; if (hi > L) hi = L;
    float s = 0.f;
    for (int tt = lo; tt < hi; ++tt) s += z[(size_t)(b * L + tt) * INW + g * 128 + c];
    y[c] = s / (float)(hi - lo) - z[(size_t)row * INW + g * 128 + c];
    __syncthreads();
    float acc = 0.f;
    for (int cc = 0; cc < 128; ++cc) acc += y[cc] * pw[((size_t)g * 128 + cc) * 128 + c];
    mix[(size_t)row * D + g * 128 + c] = (acc + pb[g * 128 + c]) * psc[g * 128 + c];
}

__global__ void __launch_bounds__(64) k_peer_topk(const float* __restrict__ qp, const float* __restrict__ keys, int* __restrict__ eidx, float* __restrict__ egate) {
    __shared__ float sc[64][129];
    __shared__ float tv[64][17];
    __shared__ int ti[64][17];
    int tid = threadIdx.x, tl = tid >> 1, p = tid & 1;
    int h = blockIdx.y, t = blockIdx.x * 32 + tl;
    const float* qr = qp + (size_t)t * D + h * 256 + p * 128;
    const float* kb = keys + ((size_t)(h * 2 + p) * PNK) * 128;
    for (int k = 0; k < PNK; ++k) {
        float s = 0.f;
        for (int c = 0; c < 128; c += 4) {
            float4 qv = *(const float4*)(qr + c); float4 kv = *(const float4*)(kb + (size_t)k * 128 + c);
            s += qv.x * kv.x + qv.y * kv.y + qv.z * kv.z + qv.w * kv.w;
        }
        sc[tid][k] = s;
    }
    float pv = INFINITY; int pi = -1;
    for (int j = 0; j < PTOPK; ++j) {
        float bv = -INFINITY; int bi = PNK;
        for (int k = 0; k < PNK; ++k) {
            float v = sc[tid][k];
            bool elig = (v < pv) || (v == pv && k > pi);
            if (elig && (v > bv)) { bv = v; bi = k; }
        }
        tv[tid][j] = bv; ti[tid][j] = bi; pv = bv; pi = bi;
    }
    __syncthreads();
    if (p == 0) {
        int ta = tid, tb = tid + 1;
        float sv[PTOPK]; int si[PTOPK];
        float pv2 = INFINITY; int pi2 = -1;
        float mx = 0.f;
#pragma unroll
        for (int j = 0; j < PTOPK; ++j) {
            float bv = -INFINITY; int bi = 256;
            for (int c = 0; c < 256; ++c) {
                float v = tv[ta][c >> 4] + tv[tb][c & 15];
                bool elig = (v < pv2) || (v == pv2 && c > pi2);
                if (elig && (v > bv)) { bv = v; bi = c; }
            }
            sv[j] = bv; si[j] = bi; pv2 = bv; pi2 = bi;
            if (j == 0) mx = bv;
        }
        float sum = 0.f;
#pragma unroll
        for (int j = 0; j < PTOPK; ++j) { sv[j] = expf(sv[j] - mx); sum += sv[j]; }
        float inv = 1.f / sum;
#pragma unroll
        for (int j = 0; j < PTOPK; ++j) {
            int c = si[j];
            eidx[((size_t)t * PH + h) * PTOPK + j] = ti[ta][c >> 4] * PNK + ti[tb][c & 15];
            egate[((size_t)t * PH + h) * PTOPK + j] = sv[j] * inv;
        }
    }
}

__global__ void __launch_bounds__(512) k_peer_main(const float* __restrict__ f, const int* __restrict__ eidx, const float* __restrict__ egate,
                                                   const float* __restrict__ pu, const float* __restrict__ pv, const float* __restrict__ mod,
                                                   const float* __restrict__ fg, float* __restrict__ xio  ) {
    __shared__ float part[PH][D];
    __shared__ float red[8];
    int t = blockIdx.x, tid = threadIdx.x, wv = tid >> 6, ln = tid & 63;
    float fr[32], acc[32];
#pragma unroll
    for (int i = 0; i < 32; ++i) { fr[i] = f[(size_t)t * D + ln + 64 * i]; acc[i] = 0.f; }
    for (int k = 0; k < PTOPK; ++k) {
        int e = eidx[((size_t)t * PH + wv) * PTOPK + k];
        float gt = egate[((size_t)t * PH + wv) * PTOPK + k];
        const float* ur = pu + (size_t)e * D;
        float dsum = 0.f;
#pragma unroll
        for (int i = 0; i < 32; ++i) dsum += ur[ln + 64 * i] * fr[i];
        for (int o = 32; o > 0; o >>= 1) dsum += __shfl_xor(dsum, o);
        float act = 0.5f * dsum * (1.f + erff(dsum * 0.70710678118654752f));
        float wgt = gt * act;
        const float* vr = pv + (size_t)e * D;
#pragma unroll
        for (int i = 0; i < 32; ++i) acc[i] += wgt * vr[ln + 64 * i];
    }
#pragma unroll
    for (int i = 0; i < 32; ++i) part[wv][ln + 64 * i] = acc[i];
    __syncthreads();
    const float* g2 = mod + (size_t)(t / L) * 6 * D + 5 * D;
    float v[4]; float ss = 0.f;
#pragma unroll
    for (int i = 0; i < 4; ++i) {
        int col = tid + 512 * i;
        float s = 0.f;
#pragma unroll
        for (int hh = 0; hh < PH; ++hh) s += part[hh][col];
        v[i] = xio[(size_t)t * D + col] + g2[col] * s;
        ss += v[i] * v[i];
    }
    for (int o = 32; o > 0; o >>= 1) ss += __shfl_xor(ss, o);
    if (ln == 0) red[wv] = ss;
    __syncthreads();
    float tot = 0.f;
#pragma unroll
    for (int i = 0; i < 8; ++i) tot += red[i];
    float rstd = 1.0f / sqrtf(tot / (float)D + EPS);
#pragma unroll
    for (int i = 0; i < 4; ++i) { int col = tid + 512 * i; xio[(size_t)t * D + col] = v[i] * rstd * fg[col]; }
}
__global__ void k_cvt_f32_bf16(const float* __restrict__ in, bf16* __restrict__ out, size_t n4) {
    for (size_t i = (size_t)blockIdx.x * blockDim.x + threadIdx.x; i < n4; i += (size_t)gridDim.x * blockDim.x) {
        const float4 v = ((const float4*)in)[i];
        uint2 o; o.x = pk2(v.x, v.y); o.y = pk2(v.z, v.w);
        ((uint2*)out)[i] = o;
    }
}
__global__ void k_cvt_bf16_f32(const bf16* __restrict__ in, float* __restrict__ out, size_t n) {
    for (size_t i = (size_t)blockIdx.x * blockDim.x + threadIdx.x; i < n; i += (size_t)gridDim.x * blockDim.x)
        out[i] = __uint_as_float((unsigned)in[i] << 16);
}
__global__ void k_expand_z(const bf16* __restrict__ ZP, const bf16* __restrict__ Q, const bf16* __restrict__ K, const bf16* __restrict__ V, float* __restrict__ z) {
    const int row = blockIdx.x;
    for (int col = threadIdx.x; col < INW; col += blockDim.x) {
        float v = 0.f;
        if (row < NLAT) {
            const int kr = (row >> 11) * LK + CT + (row & 2047);
            unsigned short h;
            if (col < QOFF) h = ZP[(size_t)row * 512 + col];
            else if (col < KOFF) h = Q[(size_t)row * 1536 + (col - QOFF)];
            else if (col < VOFF) h = K[(size_t)kr * 1536 + (col - KOFF)];
            else h = V[(size_t)kr * 1536 + (col - VOFF)];
            v = __uint_as_float((unsigned)h << 16);
        } else {
            const int r = row - NLAT, kr = (r >> 8) * LK + (r & 255);
            if (col >= KOFF) { const unsigned short h = col < VOFF ? K[(size_t)kr * 1536 + (col - KOFF)] : V[(size_t)kr * 1536 + (col - VOFF)]; v = __uint_as_float((unsigned)h << 16); }
        }
        z[(size_t)row * INW + col] = v;
    }
}

__global__ void k_fix_gates(const int* __restrict__ eidx, float* __restrict__ egate, float* __restrict__ esu, const float* __restrict__ su, const float* __restrict__ sv, int n) {
    int i = blockIdx.x * blockDim.x + threadIdx.x;
    if (i < n) { int e = eidx[i]; egate[i] *= sv[e]; esu[i] = su[e]; }
}
extern "C" void kernel_launch(void* const* d_in, const int* in_sizes, int n_in, void* d_out, int out_size, void* d_ws, size_t ws_size, hipStream_t stream) {
    static int grid = 0;
    if (grid == 0) {
        if (n_in != 20 || out_size != NLAT * D || ws_size < WS_END) { fprintf(stderr, "kernel_launch: unexpected shapes (n_in %d out %d ws %zu)\n", n_in, out_size, ws_size); grid = -1; return; }
        int dev = 0, cus = 0, per_cu = 0;
        if (hipGetDevice(&dev) != hipSuccess || hipDeviceGetAttribute(&cus, hipDeviceAttributeMultiprocessorCount, dev) != hipSuccess) { grid = -1; return; }
        if (hipFuncSetAttribute((const void*)mega, hipFuncAttributeMaxDynamicSharedMemorySize, LDS_BYTES) != hipSuccess) { fprintf(stderr, "kernel_launch: hipFuncSetAttribute failed\n"); grid = -1; return; }
        if (hipOccupancyMaxActiveBlocksPerMultiprocessor(&per_cu, (const void*)mega, NWAVES * 64, LDS_BYTES) != hipSuccess || per_cu < 1) { fprintf(stderr, "kernel_launch: occupancy query says %d blocks per CU\n", per_cu); per_cu = 1; }
        (void)hipGetLastError();
        grid = 256; if (cus < 256) { fprintf(stderr, "kernel_launch: needs 256 CUs, device has %d\n", cus); grid = -1; return; }
        size_t shm = (size_t)(2 * AQR * LK + AQR * 64 + 256 + 2 * AQR * 128) * 4;
        (void)hipFuncSetAttribute((const void*)k_attn, hipFuncAttributeMaxDynamicSharedMemorySize, (int)shm);
    }
    if (grid < 0) return;
    const float* x = (const float*)d_in[0];
    const float* c = (const float*)d_in[1];
    const float* ctx = (const float*)d_in[2];
    const float* cctx = (const float*)d_in[3];
    const float* ada_w = (const float*)d_in[4];
    const float* ada_b = (const float*)d_in[5];
    const float* norm1_g = (const float*)d_in[6];
    const float* pool_w = (const float*)d_in[8];
    const float* pool_b = (const float*)d_in[9];
    const float* pool_scale = (const float*)d_in[10];
    const float* diff_lambda = (const float*)d_in[11];
    const float* subln_g = (const float*)d_in[12];
    const float* norm2_g = (const float*)d_in[14];
    const float* peer_keys = (const float*)d_in[16];
    const float* peer_u = (const float*)d_in[17];
    const float* peer_v = (const float*)d_in[18];
    const float* final_g = (const float*)d_in[19];
    float* out = (float*)d_out;
    unsigned char* ws = (unsigned char*)d_ws;
    float* lam = (float*)(ws + WS_LAM); float* rope = (float*)(ws + WS_ROPE); float* mod = (float*)(ws + WS_MOD);
    int* eidx = (int*)(ws + WS_EIDX); float* egate = (float*)(ws + WS_EGATE);
    float* hbuf = (float*)(ws + WS_HF); float* zbuf = (float*)(ws + WS_ZF); float* mixf = (float*)(ws + WS_MIXF);
    float* fbuf = hbuf; float* qpbuf = zbuf; float* x1 = out;

    (void)hipMemsetAsync(ws + WS_CTL, 0, CTL_ZERO_BYTES, stream);
    Args a{};
    for (int i = 0; i < 20; ++i) a.in[i] = (const float*)d_in[i];
    a.out = out; a.ws = ws;

    a.ph_lo = 0; a.ph_hi = 9; a.li = 0;
    hipLaunchKernelGGL(mega, dim3(grid), dim3(NWAVES * 64), LDS_BYTES, stream, a);
}
```

```cpp
#include <hip/hip_runtime.h>
#include <math.h>
#include <stdint.h>
#include <cstdio>

constexpr int D = 2048, NB = 4, L = 2048, CT = 256;
constexpr int NLAT = NB * L;
constexpr int NCTX = NB * CT;
constexpr int NTOK = NLAT + NCTX;
constexpr int INW = 5120, POOLW = 512, ATTW = 1536, NH = 12, DV = 128, DQK = 64;
constexpr int QOFF = POOLW, KOFF = POOLW + ATTW, VOFF = POOLW + 2 * ATTW;
constexpr int LK = CT + L;
constexpr int PH = 8, PNK = 128, PTOPK = 16, NEXP = PNK * PNK;
constexpr float EPS = 1e-6f;
namespace pg8 {
#define PG8_LAS __attribute__((address_space(3)))
typedef unsigned short bf16_t;
typedef short bf16x8 __attribute__((ext_vector_type(8)));
typedef float f32x4 __attribute__((ext_vector_type(4)));
typedef unsigned u32x4 __attribute__((ext_vector_type(4)));
constexpr int BM = 256, BK = 64, HALF = 128, HTB = HALF * BK * 2  , STAGE_BYTES = 8 * HTB, NXCD = 8, WGM = 8;

__host__ __device__ __forceinline__ int lds_byte(int r, int c) { const int st = (r >> 4) * 2 + (c >> 5), rr = r & 15, cc = c & 31, ob = rr * 64 + cc * 2; return st * 1024 + (ob ^ (((ob >> 9) & 1) << 5)); }
__host__ __device__ __forceinline__ void stage_rc(int b, int& R, int& C) { const int st = b / 1024, sb = b % 1024, swz = sb ^ (((sb >> 9) & 1) << 5); R = (st >> 1) * 16 + swz / 64; C = (st & 1) * 32 + (swz % 64) / 2; }
__host__ __device__ __forceinline__ int perm32(int rho) { const int n = rho >> 4, i = rho & 15; return 8 * (i >> 2) + 4 * n + (i & 3); }

struct Unit { int pm, pn; };
struct Gemm { const bf16_t* A; const bf16_t* Bt; int M, N, K; };

struct StaticOrder {
    int nM, nN, nwg, G, c;
    __host__ __device__ void init(int M, int N, int G_, int c_) { nM = M / BM; nN = N / BM; nwg = nM * nN; G = G_; c = c_; }
    __host__ __device__ bool next(int i, Unit& u) const {
        const long L = (long)i * G + c; if (L >= nwg) return false;
        int wgid = (int)L; { const int q = nwg / NXCD, r = nwg % NXCD, xcd = wgid % NXCD, off = wgid / NXCD; wgid = (xcd < r ? xcd * (q + 1) : r * (q + 1) + (xcd - r) * q) + off; }
        const int nig = WGM * nN, gid = wgid / nig, fm = gid * WGM, gsz = (nM - fm) < WGM ? (nM - fm) : WGM;
        u.pm = fm + ((wgid % nig) % gsz); u.pn = (wgid % nig) / gsz; return true;
    }
    __device__ __forceinline__ void a_ready(const Unit&) const {}
    __device__ __forceinline__ void done(const Unit&) const {}
};

__device__ __forceinline__ unsigned cvt_pk_bf16(float lo, float hi) { unsigned r; asm volatile("v_cvt_pk_bf16_f32 %0, %1, %2" : "=v"(r) : "v"(lo), "v"(hi)); return r; }
typedef unsigned u32x2 __attribute__((ext_vector_type(2)));

struct InProjOrder {
    StaticOrder lat; int G, c;
    __device__ void init(int G_, int c_) { lat.init(8192, 5120, G_, c_); G = G_; c = c_; }
    __device__ bool next(int i, Unit& u) const {
        const int Lx = i * G + c;
        if (Lx < 640) return lat.next(i, u);
        const int j = Lx - 640; if (j >= 48) return false;
        u.pm = 32 + j / 12; u.pn = 8 + j % 12; return true;
    }
    __device__ __forceinline__ void a_ready(const Unit&) const {}
    __device__ __forceinline__ void done(const Unit&) const {}
};

struct EpiInProj {
    static constexpr bool PERM = false, AFTER_DRAIN = false;
    bf16_t *ZP, *Q, *Kb, *Vb; const float* rope;
    __device__ __forceinline__ void operator()(const f32x4 (&acc)[2][2][4][2], const Unit& u, int wr, int wc, int fr, int fq) const {
        const bool isctx = u.pm >= 32;
        const int kind = u.pn < 2 ? 0 : (u.pn < 8 ? 1 : (u.pn < 14 ? 2 : 3));
        const int pnl = kind == 0 ? u.pn : (kind == 1 ? u.pn - 2 : (kind == 2 ? u.pn - 8 : u.pn - 14));
        const int colt = pnl * 256 + wc * 32 + 4 * fq;
        bf16_t* dst = kind == 0 ? ZP : (kind == 1 ? Q : (kind == 2 ? Kb : Vb));
        const int ld = kind == 0 ? 512 : 1536;
        const bool dorope = (kind == 1 || kind == 2) && !isctx;
        const int ax = wc & 1;
#pragma unroll
        for (int ai = 0; ai < 2; ++ai)
#pragma unroll
            for (int m = 0; m < 4; ++m) {
                const int rl = ai * 128 + wr * 64 + m * 16 + fr;
                int orow, t = 0;
                if (!isctx) { const int g = u.pm * 256 + rl; t = g & 2047; orow = (kind >= 2) ? (g >> 11) * 2304 + 256 + t : g; }
                else orow = (u.pm - 32) * 2304 + rl;
                f32x4 cs0 = {1.f, 0.f, 1.f, 0.f}, cs1 = {1.f, 0.f, 1.f, 0.f};
                if (dorope) { const float* rp = rope + ((t * 2 + ax) * 16 + 4 * fq) * 2; cs0 = *(const f32x4*)rp; cs1 = *(const f32x4*)(rp + 4); }
#pragma unroll
                for (int bj = 0; bj < 2; ++bj) {
                    f32x4 v0 = acc[ai][bj][m][0], v1 = acc[ai][bj][m][1];
                    if (dorope) {
                        f32x4 o0, o1;
                        o0[0] = v0[0] * cs0[0] - v1[0] * cs0[1]; o1[0] = v0[0] * cs0[1] + v1[0] * cs0[0];
                        o0[1] = v0[1] * cs0[2] - v1[1] * cs0[3]; o1[1] = v0[1] * cs0[3] + v1[1] * cs0[2];
                        o0[2] = v0[2] * cs1[0] - v1[2] * cs1[1]; o1[2] = v0[2] * cs1[1] + v1[2] * cs1[0];
                        o0[3] = v0[3] * cs1[2] - v1[3] * cs1[3]; o1[3] = v0[3] * cs1[3] + v1[3] * cs1[2];
                        v0 = o0; v1 = o1;
                    }
                    bf16_t* p = dst + (size_t)orow * ld + colt + bj * 128;
                    u32x2 w0, w1; w0.x = cvt_pk_bf16(v0[0], v0[1]); w0.y = cvt_pk_bf16(v0[2], v0[3]); w1.x = cvt_pk_bf16(v1[0], v1[1]); w1.y = cvt_pk_bf16(v1[2], v1[3]);
                    *(u32x2*)p = w0; *(u32x2*)(p + 16) = w1;
                }
            }
    }
};

struct EpiOutProj {
    static constexpr bool PERM = false, AFTER_DRAIN = false;
    const float* x; const float* mod; float* x1; float* ssq;
    __device__ __forceinline__ void operator()(const f32x4 (&acc)[2][2][4][2], const Unit& u, int wr, int wc, int fr, int fq) const {
        const float* g1 = mod + (size_t)(u.pm >> 3) * (6 * 2048) + 2 * 2048;
        const int col0 = u.pn * 256 + wc * 32 + 4 * fq;
        f32x4 gv[2][2];
#pragma unroll
        for (int bj = 0; bj < 2; ++bj)
#pragma unroll
            for (int n = 0; n < 2; ++n) gv[bj][n] = *(const f32x4*)(g1 + col0 + bj * 128 + n * 16);
#pragma unroll
        for (int ai = 0; ai < 2; ++ai)
#pragma unroll
            for (int m = 0; m < 4; ++m) {
                const int row = u.pm * 256 + ai * 128 + wr * 64 + m * 16 + fr;
                float s = 0.f;
#pragma unroll
                for (int bj = 0; bj < 2; ++bj)
#pragma unroll
                    for (int n = 0; n < 2; ++n) {
                        const size_t off = (size_t)row * 2048 + col0 + bj * 128 + n * 16;
                        const f32x4 xv = *(const f32x4*)(x + off);
                        const f32x4 o = xv + gv[bj][n] * acc[ai][bj][m][n];
                        *(f32x4*)(x1 + off) = o;
                        s += (o[0] * o[0] + o[1] * o[1]) + (o[2] * o[2] + o[3] * o[3]);
                    }
                s += __shfl_xor(s, 16); s += __shfl_xor(s, 32);
                if (fq == 0) ssq[(size_t)row * 32 + u.pn * 4 + wc] = s;
            }
    }
};

struct EpiBf16Plain {
    static constexpr bool PERM = true, AFTER_DRAIN = false;
    bf16_t* O; int ldc;
    __device__ __forceinline__ void operator()(const f32x4 (&acc)[2][2][4][2], const Unit& u, int wr, int wc, int fr, int fq) const {
        const int row0 = u.pm * BM + wr * 64 + fr, col0 = u.pn * BM + wc * 32 + 8 * fq;
#pragma unroll
        for (int ai = 0; ai < 2; ++ai)
#pragma unroll
            for (int m = 0; m < 4; ++m) { bf16_t* rowp = O + (size_t)(row0 + ai * HALF + m * 16) * ldc + col0;
#pragma unroll
                for (int bj = 0; bj < 2; ++bj) { const f32x4 v0 = acc[ai][bj][m][0], v1 = acc[ai][bj][m][1];
                    u32x4 w; w.x = cvt_pk_bf16(v0[0], v0[1]); w.y = cvt_pk_bf16(v0[2], v0[3]); w.z = cvt_pk_bf16(v1[0], v1[1]); w.w = cvt_pk_bf16(v1[2], v1[3]);
                    *(u32x4*)(rowp + bj * HALF) = w; } }
    }
};

template <class Epi, class Sched, bool ALIGN_EPI = false, bool SP2 = false>
__device__ __forceinline__ void gemm_phase(PG8_LAS unsigned char* lds, const Gemm g, const Sched& S, const Epi& E) {
    const int tid = threadIdx.x, wid = __builtin_amdgcn_readfirstlane(tid >> 6), lane = tid & 63, wr = wid >> 2, wc = wid & 3, fr = lane & 15, fq = lane >> 4;
    const int K = g.K, nt = K / BK;
    unsigned voffA[2], voffB[2];
#pragma unroll
    for (int i = 0; i < 2; ++i) { int R, C; stage_rc(tid * 16 + i * 8192, R, C); const int Rb = Epi::PERM ? ((R & ~31) + perm32(R & 31)) : R;
        voffA[i] = (unsigned)(R * K + C) * 2u; voffB[i] = (unsigned)(Rb * K + C) * 2u; }
    const size_t kstep = (size_t)(BK * 2);
    const size_t hstep = (size_t)HALF * K * 2;
    const size_t tstep = 2 * hstep;
    const unsigned ldsw = (unsigned)wid * 1024u;
    const int aoff = lds_byte(wr * 64 + fr, fq * 8), boff = lds_byte(wc * 32 + fr, fq * 8);
#define PG8_SA(b, h) (((b) * 2 + (h)) * HTB)
#define PG8_SB(b, h) ((4 + (b) * 2 + (h)) * HTB)
#define PG8_STAGE(bufoff, gbase, voff) do { _Pragma("unroll") for (int _i = 0; _i < 2; ++_i) \
        __builtin_amdgcn_global_load_lds((const unsigned*)((const char*)(gbase) + (voff)[_i]), (PG8_LAS unsigned*)(lds + (bufoff) + ldsw + _i * 8192), 16, 0, 0); } while (0)
#define PG8_LDA(dst, b, h) do { _Pragma("unroll") for (int m = 0; m < 4; ++m) _Pragma("unroll") for (int k = 0; k < 2; ++k) dst[m][k] = *(const PG8_LAS bf16x8*)(lds + PG8_SA(b, h) + aoff + m * 2048 + k * 1024); } while (0)
#define PG8_LDB(dst, b, h) do { _Pragma("unroll") for (int n = 0; n < 2; ++n) _Pragma("unroll") for (int k = 0; k < 2; ++k) dst[n][k] = *(const PG8_LAS bf16x8*)(lds + PG8_SB(b, h) + boff + n * 2048 + k * 1024); } while (0)
#define PG8_MMA(ai, bj, At, Bt) do { __builtin_amdgcn_s_setprio(1); _Pragma("unroll") for (int m = 0; m < 4; ++m) _Pragma("unroll") for (int n = 0; n < 2; ++n) _Pragma("unroll") for (int k = 0; k < 2; ++k) \
        acc[ai][bj][m][n] = __builtin_amdgcn_mfma_f32_16x16x32_bf16(Bt[n][k], At[m][k], acc[ai][bj][m][n], 0, 0, 0); __builtin_amdgcn_s_setprio(0); } while (0)
#define PG8_WAIT_V(n) asm volatile("s_waitcnt vmcnt(" #n ")" ::: "memory")
#define PG8_WAIT_L(n) asm volatile("s_waitcnt lgkmcnt(" #n ")" ::: "memory")
#define PG8_BAR __builtin_amdgcn_s_barrier()
#define PG8_SCHED __builtin_amdgcn_sched_barrier(0)
    Unit cur, nxt; int ui = 0;
    if (!S.next(0, cur)) return;
    f32x4 acc[2][2][4][2];
#pragma unroll
    for (int a = 0; a < 2; ++a)
#pragma unroll
        for (int b = 0; b < 2; ++b)
#pragma unroll
            for (int m = 0; m < 4; ++m)
#pragma unroll
                for (int n = 0; n < 2; ++n) acc[a][b][m][n] = (f32x4){0.f, 0.f, 0.f, 0.f};
    bf16x8 At[4][2], B0[2][2], B1[2][2];
    const char* cA = (const char*)g.A + (size_t)cur.pm * tstep; const char* cB = (const char*)g.Bt + (size_t)cur.pn * tstep;
    S.a_ready(cur);
    if constexpr (SP2) {
        PG8_STAGE(PG8_SB(0, 0), cB, voffB); PG8_STAGE(PG8_SB(0, 1), cB + hstep, voffB); PG8_STAGE(PG8_SA(0, 0), cA, voffA); PG8_STAGE(PG8_SA(0, 1), cA + hstep, voffA);
        if (wr == 1) PG8_BAR;
        PG8_WAIT_V(2); PG8_BAR;
        PG8_STAGE(PG8_SB(1, 0), cB + kstep, voffB); PG8_STAGE(PG8_SA(1, 0), cA + kstep, voffA); PG8_STAGE(PG8_SB(1, 1), cB + hstep + kstep, voffB);
        PG8_WAIT_V(6); PG8_BAR;
    } else {
        PG8_STAGE(PG8_SB(0, 0), cB, voffB); PG8_STAGE(PG8_SA(0, 0), cA, voffA); PG8_STAGE(PG8_SB(0, 1), cB + hstep, voffB); PG8_STAGE(PG8_SA(0, 1), cA + hstep, voffA);
        if (wr == 1) PG8_BAR;
        PG8_WAIT_V(4); PG8_BAR;
        PG8_STAGE(PG8_SB(1, 0), cB + kstep, voffB); PG8_STAGE(PG8_SA(1, 0), cA + kstep, voffA); PG8_STAGE(PG8_SB(1, 1), cB + hstep + kstep, voffB);
        PG8_WAIT_V(6); PG8_BAR;
    }
    for (;;) {
        const bool has_next = S.next(ui + 1, nxt);
        const char* nA = has_next ? (const char*)g.A + (size_t)nxt.pm * tstep : cA; const char* nB = has_next ? (const char*)g.Bt + (size_t)nxt.pn * tstep : cB;
        for (int t = 0; t < nt; t += 2) {
            const bool last = (t == nt - 2);
            const char* a1 = cA + (size_t)(t + 1) * kstep;
            const char* a2 = last ? nA : cA + (size_t)(t + 2) * kstep; const char* b2 = last ? nB : cB + (size_t)(t + 2) * kstep;
            const char* a3 = a2 + kstep; const char* b3 = b2 + kstep;
            if (last && has_next) S.a_ready(nxt);
            if constexpr (SP2) {
            PG8_LDB(B0, 0, 0); PG8_LDB(B1, 0, 1); PG8_SCHED; PG8_LDA(At, 0, 0); PG8_STAGE(PG8_SA(1, 1), a1 + hstep, voffA);
            PG8_WAIT_V(8); PG8_WAIT_L(0); PG8_BAR; PG8_MMA(0, 0, At, B0); PG8_MMA(0, 1, At, B1); PG8_BAR; PG8_SCHED;
            PG8_LDA(At, 0, 1); PG8_STAGE(PG8_SB(0, 0), b2, voffB); PG8_STAGE(PG8_SB(0, 1), b2 + hstep, voffB); PG8_STAGE(PG8_SA(0, 0), a2, voffA);
            PG8_WAIT_V(8); PG8_WAIT_L(0); PG8_BAR; PG8_MMA(1, 0, At, B0); PG8_MMA(1, 1, At, B1); PG8_BAR; PG8_SCHED;
            PG8_LDB(B0, 1, 0); PG8_LDB(B1, 1, 1); PG8_SCHED; PG8_LDA(At, 1, 0); PG8_STAGE(PG8_SA(0, 1), a2 + hstep, voffA);
            PG8_WAIT_V(8); PG8_WAIT_L(0); PG8_BAR; PG8_MMA(0, 0, At, B0); PG8_MMA(0, 1, At, B1); PG8_BAR; PG8_SCHED;
            PG8_LDA(At, 1, 1); PG8_STAGE(PG8_SB(1, 0), b3, voffB); PG8_STAGE(PG8_SB(1, 1), b3 + hstep, voffB); PG8_STAGE(PG8_SA(1, 0), a3, voffA);
            PG8_WAIT_V(8); PG8_WAIT_L(0); PG8_BAR; PG8_MMA(1, 0, At, B0); PG8_MMA(1, 1, At, B1); PG8_BAR; PG8_SCHED;
            } else {
            PG8_LDB(B0, 0, 0); PG8_SCHED; PG8_LDA(At, 0, 0); PG8_STAGE(PG8_SA(1, 1), a1 + hstep, voffA);
            PG8_WAIT_L(8); PG8_BAR; PG8_WAIT_L(0); PG8_MMA(0, 0, At, B0); PG8_BAR; PG8_SCHED;
            PG8_LDB(B1, 0, 1); PG8_STAGE(PG8_SB(0, 0), b2, voffB);
            PG8_BAR; PG8_WAIT_L(0); PG8_MMA(0, 1, At, B1); PG8_BAR;
            PG8_LDA(At, 0, 1); PG8_STAGE(PG8_SA(0, 0), a2, voffA);
            PG8_BAR; PG8_WAIT_L(0); PG8_MMA(1, 0, At, B0); PG8_BAR; PG8_SCHED;
            PG8_STAGE(PG8_SB(0, 1), b2 + hstep, voffB);
            PG8_WAIT_V(6); PG8_BAR; PG8_MMA(1, 1, At, B1); PG8_BAR;
            PG8_LDB(B0, 1, 0); PG8_SCHED; PG8_LDA(At, 1, 0); PG8_STAGE(PG8_SA(0, 1), a2 + hstep, voffA);
            PG8_WAIT_L(8); PG8_BAR; PG8_WAIT_L(0); PG8_MMA(0, 0, At, B0); PG8_BAR; PG8_SCHED;
            PG8_LDB(B1, 1, 1); PG8_STAGE(PG8_SB(1, 0), b3, voffB);
            PG8_BAR; PG8_WAIT_L(0); PG8_MMA(0, 1, At, B1); PG8_BAR;
            PG8_LDA(At, 1, 1); PG8_STAGE(PG8_SA(1, 0), a3, voffA);
            PG8_BAR; PG8_WAIT_L(0); PG8_MMA(1, 0, At, B0); PG8_BAR; PG8_SCHED;
            PG8_STAGE(PG8_SB(1, 1), b3 + hstep, voffB);
            PG8_WAIT_V(6); PG8_BAR; PG8_MMA(1, 1, At, B1); PG8_BAR;
            }
        }
        if constexpr (ALIGN_EPI) { if (wr == 0) PG8_BAR; }
        if constexpr (!Epi::AFTER_DRAIN) { E(acc, cur, wr, wc, fr, fq); S.done(cur); }
        if (!has_next) break;
#pragma unroll
        for (int a = 0; a < 2; ++a)
#pragma unroll
            for (int b = 0; b < 2; ++b)
#pragma unroll
                for (int m = 0; m < 4; ++m)
#pragma unroll
                    for (int n = 0; n < 2; ++n) acc[a][b][m][n] = (f32x4){0.f, 0.f, 0.f, 0.f};
        cur = nxt; cA = nA; cB = nB; ++ui;
        if constexpr (ALIGN_EPI) { if (wr == 1) PG8_BAR; }
    }
    PG8_WAIT_V(0);
    if constexpr (!ALIGN_EPI) { if (wr == 0) PG8_BAR; }
    PG8_BAR;
    if constexpr (Epi::AFTER_DRAIN) { E.fused(acc, cur, wr, wc, fr, fq, lds, wid, lane); S.done(cur); }
#undef PG8_SA
#undef PG8_SB
#undef PG8_STAGE
#undef PG8_LDA
#undef PG8_LDB
#undef PG8_MMA
#undef PG8_WAIT_V
#undef PG8_WAIT_L
#undef PG8_BAR
#undef PG8_SCHED
}
}
constexpr size_t MiB = 1u << 20, KiB = 1u << 10;
constexpr size_t WS_CTL = 0, CTL_ZERO_BYTES = 1 * MiB;
constexpr size_t WS_LAM = 1 * MiB;
constexpr size_t WS_ROPE = 1 * MiB + 64 * KiB;
constexpr size_t WS_MOD = 1 * MiB + 640 * KiB;
constexpr size_t WS_ADAP = 2 * MiB;
constexpr size_t WS_SSQ = 6 * MiB;
constexpr size_t WS_SU = 7 * MiB, WS_SV = 7 * MiB + 64 * KiB;
constexpr size_t WS_EIDX = 8 * MiB, WS_EGATE = 12 * MiB;
constexpr size_t WS_KEYS16 = 16 * MiB, WS_PWT16 = 16 * MiB + 512 * KiB;
constexpr size_t WS_WIN = 18 * MiB, WS_WOUT = 38 * MiB, WS_WQ = 46 * MiB;
constexpr size_t WS_HF = 54 * MiB, WS_ZF = 126 * MiB, WS_MIXF = 306 * MiB;
constexpr size_t WS_H16 = 370 * MiB, WS_Q16 = 406 * MiB, WS_K16 = 430 * MiB, WS_V16 = 457 * MiB, WS_ZP16 = 484 * MiB;
constexpr size_t WS_MIX16 = 370 * MiB, WS_F16 = 406 * MiB, WS_QP16 = 438 * MiB;
constexpr size_t WS_U8 = 192 * MiB, WS_V8 = 224 * MiB;
constexpr size_t WS_ESU = 256 * MiB;
constexpr size_t WS_END = 512 * MiB;
constexpr int CW_BAR = 4096;

constexpr int RING_OFF = 0, RING_BYTES = 131072;
constexpr int LDSCTL_OFF = RING_BYTES, MISC_OFF = LDSCTL_OFF + 320;
constexpr int LDS_BYTES = 147456;
constexpr int NWAVES = 8;
#define GAS __attribute__((address_space(1)))
#define LAS __attribute__((address_space(3)))
typedef unsigned short bf16;
typedef unsigned v4u __attribute__((ext_vector_type(4)));
typedef float f32x4 __attribute__((ext_vector_type(4)));
typedef short bf16x8 __attribute__((ext_vector_type(8)));
typedef GAS unsigned gu32;
typedef GAS unsigned long long gu64;
#define RLX_AGENT __ATOMIC_RELAXED, __HIP_MEMORY_SCOPE_AGENT
#define LDS_WAIT() asm volatile("s_waitcnt lgkmcnt(0)" ::: "memory")
#define VM_WAIT() asm volatile("s_waitcnt vmcnt(0)" ::: "memory")
__device__ __forceinline__ unsigned long long rt() { return __builtin_amdgcn_s_memrealtime(); }
__device__ __forceinline__ unsigned f2bf(float f) { unsigned u = __builtin_bit_cast(unsigned, f); return (u + 0x7fffu + ((u >> 16) & 1u)) >> 16; }
__device__ __forceinline__ unsigned pk2(float lo, float hi) { return f2bf(lo) | (f2bf(hi) << 16); }

#define XB_TMO      128
#define XB_XCNT(j)  (256  + 64 * (j))
#define XB_XSUB(j)  (1280 + 64 * (j))
#define XB_XGEN(j)  (2304 + 64 * (j))
#define XB_TOP      3328
#define XB_TOPGEN   3392
#define XCD_BAR_WORDS 3456
#define XB_SPIN_CAP (1u << 18)

__device__ __forceinline__ unsigned xb_ld(unsigned* p)              { return __hip_atomic_load(p, __ATOMIC_RELAXED, __HIP_MEMORY_SCOPE_AGENT); }
__device__ __forceinline__ unsigned xb_add(unsigned* p, unsigned v) { return __hip_atomic_fetch_add(p, v, __ATOMIC_RELAXED, __HIP_MEMORY_SCOPE_AGENT); }
__device__ __forceinline__ unsigned xb_xcc_id() { return (unsigned)__builtin_amdgcn_s_getreg((3 << 11) | 20) & 0xFu; }
#define XB_SPIN(cond, bar) do { unsigned _sp = 0; while (cond) { __builtin_amdgcn_s_sleep(1); \
    if ((++_sp & 255u) == 0u) { if (xb_ld(&(bar)[XB_TMO])) break; if (_sp > XB_SPIN_CAP) { atomicAdd(&(bar)[XB_TMO], 1u); break; } } } } while (0)

struct XcdBarrier {
    unsigned* bar; unsigned x;
    volatile LAS unsigned* st;
};

__device__ __forceinline__ XcdBarrier xcd_barrier_post(unsigned* bar, volatile LAS unsigned* st) {
    XcdBarrier b; b.bar = bar; b.x = xb_xcc_id(); b.st = st;
    if (threadIdx.x == 0) (void)xb_add(&bar[XB_XCNT(b.x)], 1u);
    return b;
}
__device__ __forceinline__ void xcd_barrier_complete(unsigned* bar, unsigned x, unsigned& nloc, unsigned& nx) {
    const unsigned G = gridDim.x * gridDim.y * gridDim.z;
    unsigned sum, cnt, mine, sp = 0u;
    for (;;) {
        sum = 0u; cnt = 0u; mine = 0u;
#pragma unroll
        for (unsigned j = 0; j < 16; ++j) { const unsigned c = xb_ld(&bar[XB_XCNT(j)]); sum += c; cnt += (c > 0u) ? 1u : 0u; mine = (j == x) ? c : mine; }
        if (sum == G) break;
        __builtin_amdgcn_s_sleep(1);
        if ((++sp & 255u) == 0u) { if (xb_ld(&bar[XB_TMO])) break; if (sp > XB_SPIN_CAP) { atomicAdd(&bar[XB_TMO], 1u); break; } }
    }
    nloc = mine > 0u ? mine : 1u; nx = cnt > 0u ? cnt : 1u;
}

__device__ __forceinline__ void xcd_barrier(const XcdBarrier& b) {
    asm volatile("s_waitcnt vmcnt(0)" ::: "memory");
    __syncthreads();
    if (threadIdx.x == 0) {
        unsigned* bar = b.bar;
        __builtin_amdgcn_s_waitcnt(0);
        unsigned nloc = b.st[0], nx = b.st[1];
        if (nloc == 0u) { xcd_barrier_complete(bar, b.x, nloc, nx); b.st[0] = nloc; b.st[1] = nx; }
        const unsigned old = xb_add(&bar[XB_XSUB(b.x)], 1u);
        const unsigned gen = old / nloc;
        if (old + 1u == (gen + 1u) * nloc) {
            __builtin_amdgcn_fence(__ATOMIC_RELEASE, "agent");
            asm volatile("s_waitcnt vmcnt(0)" ::: "memory");
            const unsigned og = xb_add(&bar[XB_TOP], 1u);
            const unsigned tg = og / nx;
            if (og + 1u == (tg + 1u) * nx) xb_add(&bar[XB_TOPGEN], 1u);
            else XB_SPIN(xb_ld(&bar[XB_TOPGEN]) == tg, bar);
            __builtin_amdgcn_fence(__ATOMIC_ACQUIRE, "agent");
            xb_add(&bar[XB_XGEN(b.x)], 1u);
            asm volatile("s_waitcnt vmcnt(0)" ::: "memory");
        } else {
            XB_SPIN(xb_ld(&bar[XB_XGEN(b.x)]) == gen, bar);
            __builtin_amdgcn_fence(__ATOMIC_ACQUIRE, "agent");
            asm volatile("s_waitcnt vmcnt(0)" ::: "memory");
        }
    }
    __syncthreads();
}
namespace att {
using s16x4  = __attribute__((ext_vector_type(4))) short;
using f32x16 = __attribute__((ext_vector_type(16))) float;
constexpr int NW = 8, QBLK = 32, KVBLK = 64, LDQ = 1536, LDK = 1536;
constexpr float SCALE = 0.125f, THR = 8.f;
constexpr int SHM_V = KVBLK * 128 * 2, SHM_K = KVBLK * 128 * 2;
#define KSWZ(row, colB) ((row) * 256 + ((colB) ^ (((row) & 7) << 4)))
#define SBAR() __builtin_amdgcn_sched_barrier(0)
__device__ __forceinline__ int crow(int r, int hi) { return (r & 3) + 8 * (r >> 2) + 4 * hi; }
__device__ __forceinline__ unsigned cvtpk(float lo, float hi) { unsigned r; asm volatile("v_cvt_pk_bf16_f32 %0, %1, %2" : "=v"(r) : "v"(lo), "v"(hi)); return r; }

__device__ __forceinline__ void partialSM(f32x16& p0, f32x16& p1, float& m_reg, float& mn, float& alpha) {
  constexpr float C = SCALE * 1.4426950408889634f;
  float pmax = p0[0]; for (int r = 1; r < 16; ++r) pmax = fmaxf(pmax, p0[r]); for (int r = 0; r < 16; ++r) pmax = fmaxf(pmax, p1[r]);
  { auto rr = __builtin_amdgcn_permlane32_swap(__float_as_uint(pmax), __float_as_uint(pmax), false, false);
    pmax = fmaxf(__uint_as_float(rr[0]), __uint_as_float(rr[1])); }
  if (__builtin_expect(__all(pmax - m_reg <= THR / SCALE), 1)) { mn = m_reg; alpha = 1.f; }
  else { mn = fmaxf(m_reg, pmax); alpha = __builtin_amdgcn_exp2f((m_reg - mn) * C); m_reg = mn; }
  float mnC = -mn * C;
  for (int r = 0; r < 16; ++r) p0[r] = fmaf(p0[r], C, mnC); for (int r = 0; r < 16; ++r) p1[r] = fmaf(p1[r], C, mnC);
  for (int r = 0; r < 16; ++r) p0[r] = __builtin_amdgcn_exp2f(p0[r]);
}
__device__ __forceinline__ void finishSM(f32x16& p0, f32x16& p1, float alpha, float& l_reg, bf16x8& pa0, bf16x8& pa1, bf16x8& pa2, bf16x8& pa3) {
  for (int r = 0; r < 16; ++r) p1[r] = __builtin_amdgcn_exp2f(p1[r]);
  float ps = 0; for (int r = 0; r < 16; ++r) ps += p0[r]; for (int r = 0; r < 16; ++r) ps += p1[r];
  { auto rr = __builtin_amdgcn_permlane32_swap(__float_as_uint(ps), __float_as_uint(ps), false, false);
    ps = __uint_as_float(rr[0]) + __uint_as_float(rr[1]); }
  l_reg = l_reg * alpha + ps;
#define PK4(P, BASE, OUT) do { unsigned a0 = cvtpk(P[BASE + 0], P[BASE + 1]), a1 = cvtpk(P[BASE + 2], P[BASE + 3]);   \
    unsigned b0 = cvtpk(P[BASE + 4], P[BASE + 5]), b1 = cvtpk(P[BASE + 6], P[BASE + 7]);                              \
    auto r0 = __builtin_amdgcn_permlane32_swap(a0, b0, false, false); auto r1 = __builtin_amdgcn_permlane32_swap(a1, b1, false, false); \
    v4u w = {r0[0], r1[0], r0[1], r1[1]}; OUT = *reinterpret_cast<bf16x8*>(&w); } while (0)
  PK4(p0, 0, pa0); PK4(p0, 8, pa1); PK4(p1, 0, pa2); PK4(p1, 8, pa3);
#undef PK4
}
__device__ __forceinline__ void qkt(f32x16& p0, f32x16& p1, const bf16* Ks, const bf16x8* qr, int r32, int hi, int mp) {
  p0 = f32x16{}; p1 = f32x16{};
  for (int d0 = 0; d0 < 4; ++d0) { int cb = (mp * 64 + d0 * 16 + hi * 8) * 2;
    bf16x8 b0 = *reinterpret_cast<const bf16x8*>((const char*)Ks + KSWZ(r32, cb));
    bf16x8 b1 = *reinterpret_cast<const bf16x8*>((const char*)Ks + KSWZ(32 + r32, cb));
    p0 = __builtin_amdgcn_mfma_f32_32x32x16_bf16(b0, qr[d0], p0, 0, 0, 0);
    p1 = __builtin_amdgcn_mfma_f32_32x32x16_bf16(b1, qr[d0], p1, 0, 0, 0); }
}
__device__ __forceinline__ int v_st(int k, int c) { const int kk = (k & ~0xC) | ((k & 4) << 1) | ((k & 8) >> 1); return ((kk >> 3) * 4 + (c >> 5)) * 512 + ((kk & 7) * 32 + (c & 31)) * 2; }
__device__ __forceinline__ int v_rd_base(int lane) { return ((lane & 3) << 3) | (((lane >> 2) & 3) << 6) | (((lane >> 4) & 1) << 5) | (((lane >> 5) & 1) << 8); }
constexpr int v_rd_off(int d0, int ks, int half) { return d0 * 512 + ks * 4096 + half * 2048; }
template <int OFF> __device__ __forceinline__ s16x4 tr_read(int vb) {
  s16x4 r; asm volatile("ds_read_b64_tr_b16 %0, %1 offset:%2" : "=&v"(r) : "v"(vb), "i"(OFF) : "memory"); return r;
}
template <int D0> __device__ __forceinline__ void pv_one(f32x16& od, int vb, bf16x8 pa0, bf16x8 pa1, bf16x8 pa2, bf16x8 pa3) {
  const s16x4 l0 = tr_read<v_rd_off(D0, 0, 0)>(vb), h0 = tr_read<v_rd_off(D0, 0, 1)>(vb), l1 = tr_read<v_rd_off(D0, 1, 0)>(vb), h1 = tr_read<v_rd_off(D0, 1, 1)>(vb);
  const s16x4 l2 = tr_read<v_rd_off(D0, 2, 0)>(vb), h2 = tr_read<v_rd_off(D0, 2, 1)>(vb), l3 = tr_read<v_rd_off(D0, 3, 0)>(vb), h3 = tr_read<v_rd_off(D0, 3, 1)>(vb);
  asm volatile("s_waitcnt lgkmcnt(0)" ::: "memory"); SBAR();
#define PK(L, H) (bf16x8){L[0], L[1], L[2], L[3], H[0], H[1], H[2], H[3]}
  od = __builtin_amdgcn_mfma_f32_32x32x16_bf16(pa0, PK(l0, h0), od, 0, 0, 0);
  od = __builtin_amdgcn_mfma_f32_32x32x16_bf16(pa1, PK(l1, h1), od, 0, 0, 0);
  od = __builtin_amdgcn_mfma_f32_32x32x16_bf16(pa2, PK(l2, h2), od, 0, 0, 0);
  od = __builtin_amdgcn_mfma_f32_32x32x16_bf16(pa3, PK(l3, h3), od, 0, 0, 0);
#undef PK
}
__device__ __forceinline__ void pv_d0(f32x16* o, int vb, bf16x8 pa0, bf16x8 pa1, bf16x8 pa2, bf16x8 pa3) {
  pv_one<0>(o[0], vb, pa0, pa1, pa2, pa3); pv_one<1>(o[1], vb, pa0, pa1, pa2, pa3); pv_one<2>(o[2], vb, pa0, pa1, pa2, pa3); pv_one<3>(o[3], vb, pa0, pa1, pa2, pa3);
}

__device__ __forceinline__ void attn_unit(int b, int h, int qb, const bf16* __restrict__ Q16, const bf16* __restrict__ K16, const bf16* __restrict__ V16,
                                          bf16* __restrict__ mix16, float lam, const float* __restrict__ subg, char* lds) {
  const int tid = threadIdx.x, wid = tid >> 6, lane = tid & 63, r32 = lane & 31, hi = lane >> 5, mp = wid >> 2, qs = wid & 3;
  bf16* V_lds = (bf16*)lds; bf16* K_lds = (bf16*)(lds + 2 * SHM_V);
  float* wsx = (float*)(lds + 2 * SHM_V + 2 * SHM_K) + wid * 64; float* li_l = wsx; float* al_l = wsx + 32;
  float m_reg = -1e30f, l_reg = 0; f32x16 o[4] = {}; bf16x8 qr[4];
  const bf16* Qw = Q16 + (size_t)(b * L + qb * 128 + qs * 32 + r32) * LDQ + h * 128 + mp * 64 + hi * 8;
#pragma unroll
  for (int d0 = 0; d0 < 4; ++d0) qr[d0] = *reinterpret_cast<const bf16x8*>(Qw + d0 * 16);
  const bf16* Kh = K16 + (size_t)(b * LK) * LDK + h * 128;
  const bf16* Vh = V16 + (size_t)(b * LK) * LDK + h * 128;
  const int sr = tid >> 4, sc = (tid & 15) * 8, vst0 = v_st(sr, sc), vst1 = v_st(32 + sr, sc);
  const int vb0 = (int)(uintptr_t)V_lds + v_rd_base(lane);
  struct { bf16x8 vs0, vs1, ks0, ks1; } sr_[2];
#define SLOAD(i, k0) do { sr_[i].vs0 = *(const bf16x8*)(&Vh[(size_t)((k0) + sr) * LDK + sc]); sr_[i].vs1 = *(const bf16x8*)(&Vh[(size_t)((k0) + 32 + sr) * LDK + sc]); \
    sr_[i].ks0 = *(const bf16x8*)(&Kh[(size_t)((k0) + sr) * LDK + sc]); sr_[i].ks1 = *(const bf16x8*)(&Kh[(size_t)((k0) + 32 + sr) * LDK + sc]); } while (0)
#define SWRITE(bb, i) do { *(bf16x8*)((char*)V_lds + (bb) * SHM_V + vst0) = sr_[i].vs0;          \
    *(bf16x8*)((char*)V_lds + (bb) * SHM_V + vst1) = sr_[i].vs1; int kc = sc * 2;               \
    *(bf16x8*)((char*)K_lds + (bb) * SHM_K + KSWZ(sr, kc)) = sr_[i].ks0;                       \
    *(bf16x8*)((char*)K_lds + (bb) * SHM_K + KSWZ(32 + sr, kc)) = sr_[i].ks1; } while (0)
#define SWAIT() asm volatile("s_waitcnt vmcnt(4)" ::: "memory")
#define RESC(a) do { if (__any((a) < 1.f)) { if (hi == 0) al_l[r32] = (a); asm volatile("s_waitcnt lgkmcnt(0)" ::: "memory"); \
    for (int d = 0; d < 4; ++d) for (int r = 0; r < 16; ++r) o[d][r] *= al_l[crow(r, hi)]; } } while (0)
  f32x16 pA0, pA1, pB0, pB1; float mnA, mnB, alA, alB; bf16x8 pa0, pa1, pa2, pa3; constexpr int NT = LK / KVBLK;
  constexpr int SE = 0, SO = 1;
  SLOAD(SE, 0); asm volatile("s_waitcnt vmcnt(0)" ::: "memory"); SWRITE(0, SE); __syncthreads();
  qkt(pA0, pA1, K_lds, qr, r32, hi, mp); partialSM(pA0, pA1, m_reg, mnA, alA);
  SLOAD(SO, KVBLK); SLOAD(SE, 2 * KVBLK);
  SWAIT(); SWRITE(1, SO); __syncthreads();
  for (int j = 1; j + 1 < NT; j += 2) {
    SBAR(); qkt(pB0, pB1, (bf16*)((char*)K_lds + SHM_K), qr, r32, hi, mp);
    finishSM(pA0, pA1, alA, l_reg, pa0, pa1, pa2, pa3); SBAR();
    SLOAD(SO, (j + 2) * KVBLK); SBAR();
    pv_d0(o, vb0, pa0, pa1, pa2, pa3); partialSM(pB0, pB1, m_reg, mnB, alB);
    __syncthreads(); SWAIT(); SWRITE(0, SE);
    RESC(alB); __syncthreads();
    SBAR(); qkt(pA0, pA1, K_lds, qr, r32, hi, mp);
    finishSM(pB0, pB1, alB, l_reg, pa0, pa1, pa2, pa3); SBAR();
    if (j + 3 < NT) SLOAD(SE, (j + 3) * KVBLK); SBAR();
    pv_d0(o, vb0 + SHM_V, pa0, pa1, pa2, pa3); partialSM(pA0, pA1, m_reg, mnA, alA);
    __syncthreads(); SWAIT(); SWRITE(1, SO);
    RESC(alA); __syncthreads();
  }
  SBAR(); qkt(pB0, pB1, (bf16*)((char*)K_lds + SHM_K), qr, r32, hi, mp);
  finishSM(pA0, pA1, alA, l_reg, pa0, pa1, pa2, pa3); SBAR();
  pv_d0(o, vb0, pa0, pa1, pa2, pa3); partialSM(pB0, pB1, m_reg, mnB, alB);
  __syncthreads(); RESC(alB);
  finishSM(pB0, pB1, alB, l_reg, pa0, pa1, pa2, pa3); SBAR();
  pv_d0(o, vb0 + SHM_V, pa0, pa1, pa2, pa3);
  if (hi == 0) li_l[r32] = l_reg;
  asm volatile("s_waitcnt lgkmcnt(0)" ::: "memory");
  float rli[16];
#pragma unroll
  for (int r = 0; r < 16; ++r) rli[r] = 1.0f / li_l[crow(r, hi)];
  __syncthreads();
  float* X = (float*)lds + qs * (32 * 128);
  if (mp == 1) {
#pragma unroll
    for (int r = 0; r < 16; ++r)
#pragma unroll
      for (int d0 = 0; d0 < 4; ++d0) X[crow(r, hi) * 128 + d0 * 32 + r32] = lam * o[d0][r] * rli[r];
  }
  __syncthreads();
  if (mp == 0) {
    float ssq[16];
#pragma unroll
    for (int r = 0; r < 16; ++r) { float s = 0.f;
#pragma unroll
      for (int d0 = 0; d0 < 4; ++d0) { const float v = o[d0][r] * rli[r] - X[crow(r, hi) * 128 + d0 * 32 + r32]; o[d0][r] = v; s += v * v; }
      ssq[r] = s; }
#pragma unroll
    for (int r = 0; r < 16; ++r) {
      float s = ssq[r];
      s += __shfl_xor(s, 1); s += __shfl_xor(s, 2); s += __shfl_xor(s, 4); s += __shfl_xor(s, 8); s += __shfl_xor(s, 16);
      ssq[r] = 1.0f / sqrtf(s * (1.0f / 128.f) + EPS);
    }
    float sg[4];
#pragma unroll
    for (int d0 = 0; d0 < 4; ++d0) sg[d0] = subg[d0 * 32 + r32] * 0.8f;
    asm volatile("s_waitcnt lgkmcnt(0)" ::: "memory");
    unsigned short* Y = (unsigned short*)X;
#pragma unroll
    for (int r = 0; r < 16; ++r)
#pragma unroll
      for (int d0 = 0; d0 < 4; ++d0) Y[crow(r, hi) * 128 + d0 * 32 + r32] = (unsigned short)f2bf(o[d0][r] * ssq[r] * sg[d0]);
    asm volatile("s_waitcnt lgkmcnt(0)" ::: "memory");
    bf16* Ob = mix16 + (size_t)(b * L + qb * 128 + qs * 32) * D + POOLW + h * 128;
#pragma unroll
    for (int j = 0; j < 8; ++j) { const int idx = j * 64 + lane, row = idx >> 4, ch = idx & 15;
      const v4u w = *(const v4u*)(Y + row * 128 + ch * 8);
      *(v4u*)(Ob + (size_t)row * D + ch * 8) = w; }
  }
  __syncthreads();
#undef SLOAD
#undef SWRITE
#undef SWAIT
#undef RESC
}

__device__ __forceinline__ void pool_item(int tile, int g, const bf16* __restrict__ ZP16, const bf16* __restrict__ pwT16, const float* __restrict__ pool_b,
                                          const float* __restrict__ pool_scale, bf16* __restrict__ mix16, int lane) {
  const int r32 = lane & 31, hi = lane >> 5;
  const int row0 = tile * 32, t = (row0 & 2047) + r32, rb = row0 & ~2047;
  const int w = 2 << g, hw = w >> 1;
  const int lo = t - hw < 0 ? 0 : t - hw, hi_ = t + hw > L ? L : t + hw;
  const float inv = 1.0f / (float)(hi_ - lo);
  bf16x8 af[8];
#pragma unroll
  for (int ks = 0; ks < 8; ++ks) {
    const int c0 = g * 128 + ks * 16 + hi * 8;
    float s[8];
#pragma unroll
    for (int e = 0; e < 8; ++e) s[e] = 0.f;
    for (int j = 0; j < w; ++j) {
      const int tt = t - hw + j; const bool ok = tt >= 0 && tt < L; const int tc = tt < 0 ? 0 : (tt >= L ? L - 1 : tt);
      const bf16x8 v = *(const bf16x8*)(ZP16 + (size_t)(rb + tc) * 512 + c0);
      const float m = ok ? 1.f : 0.f;
#pragma unroll
      for (int e = 0; e < 8; ++e) s[e] += m * __uint_as_float((unsigned)(unsigned short)v[e] << 16);
    }
    const bf16x8 own = *(const bf16x8*)(ZP16 + (size_t)(rb + t) * 512 + c0);
    v4u pk;
    pk.x = cvtpk(s[0] * inv - __uint_as_float((unsigned)(unsigned short)own[0] << 16), s[1] * inv - __uint_as_float((unsigned)(unsigned short)own[1] << 16));
    pk.y = cvtpk(s[2] * inv - __uint_as_float((unsigned)(unsigned short)own[2] << 16), s[3] * inv - __uint_as_float((unsigned)(unsigned short)own[3] << 16));
    pk.z = cvtpk(s[4] * inv - __uint_as_float((unsigned)(unsigned short)own[4] << 16), s[5] * inv - __uint_as_float((unsigned)(unsigned short)own[5] << 16));
    pk.w = cvtpk(s[6] * inv - __uint_as_float((unsigned)(unsigned short)own[6] << 16), s[7] * inv - __uint_as_float((unsigned)(unsigned short)own[7] << 16));
    af[ks] = *reinterpret_cast<bf16x8*>(&pk);
  }
  f32x16 acc[4] = {};
#pragma unroll
  for (int d0 = 0; d0 < 4; ++d0)
#pragma unroll
    for (int ks = 0; ks < 8; ++ks) {
      const bf16x8 bfr = *(const bf16x8*)(pwT16 + ((size_t)g * 128 + d0 * 32 + r32) * 128 + ks * 16 + hi * 8);
      acc[d0] = __builtin_amdgcn_mfma_f32_32x32x16_bf16(af[ks], bfr, acc[d0], 0, 0, 0);
    }
#pragma unroll
  for (int d0 = 0; d0 < 4; ++d0) {
    const int dcol = g * 128 + d0 * 32 + r32; const float pb = pool_b[dcol], ps = pool_scale[dcol];
#pragma unroll
    for (int r = 0; r < 16; ++r) mix16[(size_t)(row0 + crow(r, hi)) * D + dcol] = (unsigned short)f2bf((acc[d0][r] + pb) * ps);
  }
}
#undef KSWZ
#undef SBAR
}
__device__ __forceinline__ float wave_sum(float v) {
#pragma unroll
    for (int o = 1; o < 64; o <<= 1) v += __shfl_xor(v, o);
    return v;
}
__device__ __forceinline__ float wave_max(float v) {
#pragma unroll
    for (int o = 1; o < 64; o <<= 1) v = fmaxf(v, __shfl_xor(v, o));
    return v;
}
__device__ __forceinline__ void p0_lam_rope(const float* __restrict__ dl, float* __restrict__ lam_out, float* __restrict__ rope, int gtid, int gthreads) {
    if (gtid == 0) {
        double s01 = 0, s23 = 0;
        for (int i = 0; i < 64; ++i) { s01 += (double)dl[i] * dl[64 + i]; s23 += (double)dl[128 + i] * dl[192 + i]; }
        lam_out[0] = (float)(exp(s01) - exp(s23) + 0.2);
    }
    for (int gid = gtid; gid < L * 32; gid += gthreads) {
        const int t = gid / 32, a = (gid / 16) & 1, i = gid & 15;
        const double pos = a == 0 ? (double)(t / 64) : (double)(t % 64);
        const double ang = pos * pow(10000.0, -(double)i / 16.0);
        rope[gid * 2 + 0] = (float)cos(ang);
        rope[gid * 2 + 1] = (float)sin(ang);
    }
}
__device__ __forceinline__ void p0_ada_unit(int unit, const float* __restrict__ ada_w, float* __restrict__ part, LAS float* sv, LAS float* red, int wave, int lane, int tid) {
    const int cc = unit % 48, ks = unit / 48;
    const int col = cc * 256 + lane * 4;
    f32x4 acc[5];
#pragma unroll
    for (int r = 0; r < 5; ++r) acc[r] = (f32x4){0.f, 0.f, 0.f, 0.f};
    const int k0 = ks * 128 + wave * 16;
#pragma unroll 4
    for (int kk = 0; kk < 16; ++kk) {
        const int k = k0 + kk;
        const f32x4 wv = *(const f32x4*)(ada_w + (size_t)k * (6 * D) + col);
#pragma unroll
        for (int r = 0; r < 5; ++r) acc[r] += wv * sv[r * D + k];
    }
#pragma unroll
    for (int r = 0; r < 5; ++r) *(LAS f32x4*)(red + (wave * 5 + r) * 256 + lane * 4) = acc[r];
    __syncthreads();
    for (int idx = tid; idx < 5 * 256; idx += NWAVES * 64) {
        float s = 0.f;
#pragma unroll
        for (int w = 0; w < 8; ++w) s += red[w * 1280 + idx];
        part[((size_t)ks * 5 + idx / 256) * (6 * D) + cc * 256 + (idx & 255)] = s;
    }
    __syncthreads();
}
__device__ __forceinline__ void p0_row_to_fp8(const float* __restrict__ src, unsigned char* __restrict__ dst, float* __restrict__ inv_scale, int lane) {
    f32x4 v[8];
#pragma unroll
    for (int j = 0; j < 4; ++j) { v[j] = *(const f32x4*)(src + lane * 16 + j * 4); v[4 + j] = *(const f32x4*)(src + 1024 + lane * 16 + j * 4); }
    float am = 0.f;
#pragma unroll
    for (int j = 0; j < 8; ++j) am = fmaxf(am, fmaxf(fmaxf(fabsf(v[j][0]), fabsf(v[j][1])), fmaxf(fabsf(v[j][2]), fabsf(v[j][3]))));
    am = wave_max(am);
    float s = 1.f;
    if (am > 0.f) s = exp2f(floorf(log2f(224.f / am)));
    if (lane == 0) *inv_scale = 1.0f / s;
    v4u o0, o1;
#define PK8(a, b) ({ int _w = 0; _w = __builtin_amdgcn_cvt_pk_fp8_f32((a)[0] * s, (a)[1] * s, _w, false); _w = __builtin_amdgcn_cvt_pk_fp8_f32((a)[2] * s, (a)[3] * s, _w, true); (unsigned)_w; })
    o0.x = PK8(v[0], 0); o0.y = PK8(v[1], 0); o0.z = PK8(v[2], 0); o0.w = PK8(v[3], 0);
    o1.x = PK8(v[4], 0); o1.y = PK8(v[5], 0); o1.z = PK8(v[6], 0); o1.w = PK8(v[7], 0);
#undef PK8
    *(v4u*)(dst + lane * 16) = o0;
    *(v4u*)(dst + 1024 + lane * 16) = o1;
}
template <class LD4>
__device__ __forceinline__ void norm_row_bf16(const float* __restrict__ xr, const float* __restrict__ g, LD4 ldmod, bf16* __restrict__ orow, int lane, float rstd_in, bool have_rstd) {
    f32x4 v[8]; float ss = 0.f;
#pragma unroll
    for (int j = 0; j < 8; ++j) { v[j] = *(const f32x4*)(xr + lane * 4 + 256 * j); ss += (v[j][0] * v[j][0] + v[j][1] * v[j][1]) + (v[j][2] * v[j][2] + v[j][3] * v[j][3]); }
    float rstd = rstd_in;
    if (!have_rstd) rstd = 1.0f / sqrtf(wave_sum(ss) * (1.0f / D) + EPS);
#pragma unroll
    for (int j = 0; j < 8; ++j) {
        const int col = lane * 4 + 256 * j;
        const f32x4 gv = *(const f32x4*)(g + col);
        const f32x4 sh = ldmod(0, col), sc = ldmod(1, col);
        const f32x4 o = v[j] * rstd * gv * (sc + 1.0f) + sh;
        uint2 w; w.x = pk2(o[0], o[1]); w.y = pk2(o[2], o[3]);
        *(uint2*)(orow + col) = w;
    }
}
namespace peer {
using f32x16 = __attribute__((ext_vector_type(16))) float;
using f32x2 = __attribute__((ext_vector_type(2))) float;
__device__ __forceinline__ int crow(int r, int hi) { return (r & 3) + 8 * (r >> 2) + 4 * hi; }
__device__ __forceinline__ float med3(float a, float b, float c) { return __builtin_amdgcn_fmed3f(a, b, c); }
__device__ __forceinline__ void ins16(float (&l)[16], float x) {
#pragma unroll
    for (int i = 15; i >= 1; --i) l[i] = med3(l[i - 1], l[i], x);
    l[0] = fmaxf(l[0], x);
}
__device__ __forceinline__ void merge_pair(float (&l)[16]) {
    float c[16];
#pragma unroll
    for (int i = 0; i < 16; ++i) { const float o = __shfl_xor(l[15 - i], 32); c[i] = fmaxf(l[i], o); }
#pragma unroll
    for (int d = 8; d >= 1; d >>= 1)
#pragma unroll
        for (int i = 0; i < 16; ++i) if ((i & d) == 0) { const float a = c[i], b = c[i + d]; c[i] = fmaxf(a, b); c[i + d] = fminf(a, b); }
#pragma unroll
    for (int i = 0; i < 16; ++i) l[i] = c[i];
}
__device__ __forceinline__ void topk_unit(int t0, int h, const bf16* __restrict__ qp16, const bf16* __restrict__ keys16, const float* __restrict__ su, const float* __restrict__ sv,
                                          int* __restrict__ eidx, float* __restrict__ egsv, float* __restrict__ esu, LAS unsigned char* scr, int lane) {
    const int r32 = lane & 31, hi = lane >> 5;
    float la[16], lb[16];
#pragma unroll
    for (int p = 0; p < 2; ++p) {
        f32x16 acc[4] = {};
        const bf16* qrow = qp16 + (size_t)(t0 + r32) * D + h * 256 + p * 128 + hi * 8;
        const bf16* kbase = keys16 + ((size_t)(h * 2 + p) * PNK + r32) * 128 + hi * 8;
#pragma unroll 2
        for (int ks = 0; ks < 8; ++ks) {
            const bf16x8 qf = *(const bf16x8*)(qrow + ks * 16);
#pragma unroll
            for (int kb = 0; kb < 4; ++kb) {
                const bf16x8 kf = *(const bf16x8*)(kbase + (size_t)kb * 32 * 128 + ks * 16);
                acc[kb] = __builtin_amdgcn_mfma_f32_32x32x16_bf16(kf, qf, acc[kb], 0, 0, 0);
            }
        }
        float l[16];
#pragma unroll
        for (int i = 0; i < 16; ++i) l[i] = -INFINITY;
#pragma unroll
        for (int kb = 0; kb < 4; ++kb)
#pragma unroll
            for (int r = 0; r < 16; ++r) {
                const unsigned k = (unsigned)(32 * kb + crow(r, hi));
                const float x = __uint_as_float((__float_as_uint(acc[kb][r]) & ~0x7Fu) | k);
                ins16(l, x);
            }
        merge_pair(l);
        if (p == 0) {
#pragma unroll
            for (int i = 0; i < 16; ++i) la[i] = l[i];
        } else {
#pragma unroll
            for (int i = 0; i < 16; ++i) lb[i] = l[i];
        }
    }
    {
        unsigned w[4];
#pragma unroll
        for (int q = 0; q < 4; ++q) {
            unsigned x = 0;
#pragma unroll
            for (int e = 0; e < 4; ++e) { float va = la[4 * q + e], vb_ = lb[4 * q + e]; asm volatile("" : "+v"(va), "+v"(vb_)); const float v = hi ? vb_ : va; x |= (__float_as_uint(v) & 0x7Fu) << (8 * e); }
            w[q] = x;
        }
        *(LAS v4u*)(scr + r32 * 32 + hi * 16) = (v4u){w[0], w[1], w[2], w[3]};
    }
    float l[16];
#pragma unroll
    for (int i = 0; i < 16; ++i) l[i] = -INFINITY;
    {
        int n = 0; float pend = 0.f;
#pragma unroll
        for (int i = 0; i < 16; ++i)
#pragma unroll
            for (int j = 0; j < 16; ++j) if ((i + 1) * (j + 1) <= 16) {
                const float s = la[i] + lb[j];
                const float x = __uint_as_float((__float_as_uint(s) & ~0xFFu) | (unsigned)(i * 16 + j));
                if ((n & 1) == 0) pend = x; else ins16(l, hi ? x : pend);
                ++n;
            }
    }
    merge_pair(l);
    asm volatile("s_waitcnt lgkmcnt(0)" ::: "memory");
    float ex[16], sum = 0.f;
#pragma unroll
    for (int i = 0; i < 16; ++i) { ex[i] = __expf(l[i] - l[0]); sum += ex[i]; }
    const float inv = 1.0f / sum;
    const size_t ob = ((size_t)(t0 + r32) * PH + h) * PTOPK + hi * 8;
#pragma unroll
    for (int n = 0; n < 8; ++n) {
        float vlo = l[n], vhi = l[8 + n], elo = ex[n], ehi = ex[8 + n];
        asm volatile("" : "+v"(vlo), "+v"(vhi), "+v"(elo), "+v"(ehi));
        const float v = hi ? vhi : vlo;
        const float g = (hi ? ehi : elo) * inv;
        const unsigned c = __float_as_uint(v) & 0xFFu;
        const unsigned ia = scr[r32 * 32 + (c >> 4)], ib = scr[r32 * 32 + 16 + (c & 15)];
        const int e = (int)(ia * PNK + ib);
        eidx[ob + n] = e; egsv[ob + n] = g * sv[e]; esu[ob + n] = su[e];
    }
}

__device__ __forceinline__ f32x2 cvt8(unsigned w, bool hiw) { return hiw ? __builtin_amdgcn_cvt_pk_f32_fp8((int)w, true) : __builtin_amdgcn_cvt_pk_f32_fp8((int)w, false); }
__device__ __forceinline__ void peer_token(int t, const bf16* __restrict__ f16, const int* __restrict__ eidx, const float* __restrict__ egsv, const float* __restrict__ esu,
                                           const unsigned char* __restrict__ U8, const unsigned char* __restrict__ V8, const float* __restrict__ g2, const float* __restrict__ fg,
                                           const float* xin, float* xout, int lane) {
    f32x2 fr[16], acc[16];
    {
        const bf16* fp = f16 + (size_t)t * D + lane * 16;
        const v4u a0 = *(const v4u*)fp, a1 = *(const v4u*)(fp + 8), b0 = *(const v4u*)(fp + 1024), b1 = *(const v4u*)(fp + 1032);
        const unsigned w[16] = {a0.x, a0.y, a0.z, a0.w, a1.x, a1.y, a1.z, a1.w, b0.x, b0.y, b0.z, b0.w, b1.x, b1.y, b1.z, b1.w};
#pragma unroll
        for (int i = 0; i < 16; ++i) { fr[i] = (f32x2){__uint_as_float(w[i] << 16), __uint_as_float(w[i] & 0xFFFF0000u)}; acc[i] = (f32x2){0.f, 0.f}; }
    }
    const int e_a = eidx[(size_t)t * 128 + lane], e_b = eidx[(size_t)t * 128 + 64 + lane];
    const float g_a = egsv[(size_t)t * 128 + lane], g_b = egsv[(size_t)t * 128 + 64 + lane];
    const float s_a = esu[(size_t)t * 128 + lane], s_b = esu[(size_t)t * 128 + 64 + lane];
    const int k2 = lane >> 4;
    v4u ub[4][2], vb[4][2];
#define LOADROWS(buf, base, grp) do { _Pragma("unroll") for (int k = 0; k < 4; ++k) { \
        const int ee = (grp) < 16 ? __builtin_amdgcn_readlane(e_a, ((grp) & 15) * 4 + k) : __builtin_amdgcn_readlane(e_b, ((grp) & 15) * 4 + k); \
        const unsigned char* rp = (base) + (size_t)ee * D + lane * 16; buf[k][0] = *(const v4u*)rp; buf[k][1] = *(const v4u*)(rp + 1024); } } while (0)
    LOADROWS(ub, U8, 0); LOADROWS(vb, V8, 0);
#pragma unroll 1
    for (int grp = 0; grp < 32; ++grp) {
        float dt[4];
#pragma unroll
        for (int k = 0; k < 4; ++k) {
            f32x2 s = {0.f, 0.f};
#pragma unroll
            for (int hf = 0; hf < 2; ++hf) {
                const unsigned w[4] = {ub[k][hf].x, ub[k][hf].y, ub[k][hf].z, ub[k][hf].w};
#pragma unroll
                for (int q = 0; q < 4; ++q) { s += cvt8(w[q], false) * fr[hf * 8 + q * 2]; s += cvt8(w[q], true) * fr[hf * 8 + q * 2 + 1]; }
            }
            dt[k] = s[0] + s[1];
        }
        if (grp + 1 < 32) LOADROWS(ub, U8, grp + 1);
        {
            auto r0 = __builtin_amdgcn_permlane32_swap(__float_as_uint(dt[0]), __float_as_uint(dt[2]), false, false);
            auto r1 = __builtin_amdgcn_permlane32_swap(__float_as_uint(dt[1]), __float_as_uint(dt[3]), false, false);
            float x0 = __uint_as_float(r0[0]) + __uint_as_float(r0[1]);
            float x1 = __uint_as_float(r1[0]) + __uint_as_float(r1[1]);
            const bool b4 = (lane & 16) != 0;
            const float keep = b4 ? x1 : x0, send = b4 ? x0 : x1;
            float y = keep + __shfl_xor(send, 16);
            y += __shfl_xor(y, 8); y += __shfl_xor(y, 4); y += __shfl_xor(y, 2); y += __shfl_xor(y, 1);
            dt[0] = y;
        }
        const int ent = (grp & 15) * 4 + k2;
        const float gsv = grp < 16 ? __shfl(g_a, ent) : __shfl(g_b, ent);
        const float isu = grp < 16 ? __shfl(s_a, ent) : __shfl(s_b, ent);
        const float dv = dt[0] * isu;
        const float wgt = gsv * 0.5f * dv * (1.f + erff(dv * 0.70710678118654752f));
#pragma unroll
        for (int k = 0; k < 4; ++k) {
            const float wk = __uint_as_float(__builtin_amdgcn_readlane(__float_as_uint(wgt), 16 * k));
            const f32x2 wk2 = {wk, wk};
#pragma unroll
            for (int hf = 0; hf < 2; ++hf) {
                const unsigned w[4] = {vb[k][hf].x, vb[k][hf].y, vb[k][hf].z, vb[k][hf].w};
#pragma unroll
                for (int q = 0; q < 4; ++q) { acc[hf * 8 + q * 2] += cvt8(w[q], false) * wk2; acc[hf * 8 + q * 2 + 1] += cvt8(w[q], true) * wk2; }
            }
        }
        if (grp + 1 < 32) LOADROWS(vb, V8, grp + 1);
    }
#undef LOADROWS
    const float* xr = xin + (size_t)t * D + lane * 16; float* xw = xout + (size_t)t * D + lane * 16;
    const float* gr = g2 + lane * 16; const float* fgr = fg + lane * 16;
    f32x4 xv[8]; float ss = 0.f;
#pragma unroll
    for (int j = 0; j < 8; ++j) {
        const int off = (j >> 2) * 1024 + (j & 3) * 4;
        const f32x4 x1v = *(const f32x4*)(xr + off), gv = *(const f32x4*)(gr + off);
        const f32x4 pv = {acc[2 * j][0], acc[2 * j][1], acc[2 * j + 1][0], acc[2 * j + 1][1]};
        xv[j] = x1v + gv * pv;
        ss += (xv[j][0] * xv[j][0] + xv[j][1] * xv[j][1]) + (xv[j][2] * xv[j][2] + xv[j][3] * xv[j][3]);
    }
    ss = wave_sum(ss);
    const float rstd = 1.0f / sqrtf(ss * (1.0f / D) + EPS);
#pragma unroll
    for (int j = 0; j < 8; ++j) { const int off = (j >> 2) * 1024 + (j & 3) * 4; *(f32x4*)(xw + off) = xv[j] * rstd * *(const f32x4*)(fgr + off); }
}
}

namespace peer {
__device__ __forceinline__ void sort128(int (&key)[2], int lane) {
#pragma unroll
    for (int k = 2; k <= 128; k <<= 1) {
#pragma unroll
        for (int j = k >> 1; j > 0; j >>= 1) {
            if (j == 64) {
                const int a = key[0], b = key[1];
                key[0] = a < b ? a : b; key[1] = a < b ? b : a;
            } else {
                const bool lower = (lane & j) == 0;
#pragma unroll
                for (int r = 0; r < 2; ++r) {
                    const int i = r * 64 + lane;
                    const bool asc = (i & k) == 0;
                    const int o = __shfl_xor(key[r], j);
                    const int mn = key[r] < o ? key[r] : o, mx = key[r] < o ? o : key[r];
                    key[r] = (lower == asc) ? mn : mx;
                }
            }
        }
    }
}
__device__ __forceinline__ float dot16(const v4u u, const f32x2 (&f)[8]) {
    f32x2 s = {0.f, 0.f};
    const unsigned w[4] = {u.x, u.y, u.z, u.w};
#pragma unroll
    for (int q = 0; q < 4; ++q) { s += cvt8(w[q], false) * f[q * 2]; s += cvt8(w[q], true) * f[q * 2 + 1]; }
    return s[0] + s[1];
}
__device__ __forceinline__ void axpy16(f32x2 (&a)[8], const v4u v, float wk) {
    const f32x2 wk2 = {wk, wk};
    const unsigned w[4] = {v.x, v.y, v.z, v.w};
#pragma unroll
    for (int q = 0; q < 4; ++q) { a[q * 2] += cvt8(w[q], false) * wk2; a[q * 2 + 1] += cvt8(w[q], true) * wk2; }
}
__device__ __forceinline__ void loadf8(f32x2 (&f)[8], const bf16* fp) {
    const v4u a0 = *(const v4u*)fp, a1 = *(const v4u*)(fp + 8);
    const unsigned w[8] = {a0.x, a0.y, a0.z, a0.w, a1.x, a1.y, a1.z, a1.w};
#pragma unroll
    for (int i = 0; i < 8; ++i) f[i] = (f32x2){__uint_as_float(w[i] << 16), __uint_as_float(w[i] & 0xFFFF0000u)};
}
#define RFL_I(x) __builtin_amdgcn_readfirstlane(x)
#define RFL_F(x) __uint_as_float(__builtin_amdgcn_readfirstlane(__float_as_uint(x)))

template <int H>
__device__ __forceinline__ void peer_usweep(int t0, const bf16* __restrict__ f16, const unsigned char* __restrict__ U8, LAS int* skey, LAS float* sgs, LAS float* sis, LAS float* sw, int lane) {
    f32x2 f0[8], f1[8], f2[8], f3[8];
    loadf8(f0, f16 + (size_t)(t0 + 0) * D + H * 1024 + lane * 16); loadf8(f1, f16 + (size_t)(t0 + 1) * D + H * 1024 + lane * 16);
    loadf8(f2, f16 + (size_t)(t0 + 2) * D + H * 1024 + lane * 16); loadf8(f3, f16 + (size_t)(t0 + 3) * D + H * 1024 + lane * 16);
    const unsigned char* ubase = U8 + H * 1024 + lane * 16;
    const int k2 = lane >> 4;
    v4u ub[4][4];
#define LOADU(S, I) do { _Pragma("unroll") for (int tk = 0; tk < 4; ++tk) { const int ee = RFL_I(skey[tk * 128 + (I)]) >> 7; ub[S][tk] = *(const v4u*)(ubase + (size_t)ee * D); } } while (0)
    LOADU(0, 0); LOADU(1, 1); LOADU(2, 2);
#pragma unroll 1
    for (int i0 = 0; i0 < 128; i0 += 4) {
#pragma unroll
        for (int s = 0; s < 4; ++s) {
            const int i = i0 + s;
            if (i + 3 < 128) LOADU((s + 3) & 3, i + 3);
            const float d0 = dot16(ub[s][0], f0), d1 = dot16(ub[s][1], f1), d2 = dot16(ub[s][2], f2), d3 = dot16(ub[s][3], f3);
            auto r0 = __builtin_amdgcn_permlane32_swap(__float_as_uint(d0), __float_as_uint(d2), false, false);
            auto r1 = __builtin_amdgcn_permlane32_swap(__float_as_uint(d1), __float_as_uint(d3), false, false);
            const float x0 = __uint_as_float(r0[0]) + __uint_as_float(r0[1]);
            const float x1 = __uint_as_float(r1[0]) + __uint_as_float(r1[1]);
            const bool b4 = (lane & 16) != 0;
            const float keep = b4 ? x1 : x0, send = b4 ? x0 : x1;
            float y = keep + __shfl_xor(send, 16);
            y += __shfl_xor(y, 8); y += __shfl_xor(y, 4); y += __shfl_xor(y, 2); y += __shfl_xor(y, 1);
            if (H == 0) { if ((lane & 15) == 0) sw[k2 * 128 + i] = y; }
            else {
                const float dv = (y + sw[k2 * 128 + i]) * sis[k2 * 128 + i];
                const float wgt = sgs[k2 * 128 + i] * 0.5f * dv * (1.f + erff(dv * 0.70710678118654752f));
                if ((lane & 15) == 0) sw[k2 * 128 + i] = wgt;
            }
        }
    }
#undef LOADU
}
template <int H>
__device__ __forceinline__ void peer_vsweep(const unsigned char* __restrict__ V8, LAS int* skey, LAS float* sw, f32x2 (&a0)[8], f32x2 (&a1)[8], f32x2 (&a2)[8], f32x2 (&a3)[8], int lane) {
    const unsigned char* vbase = V8 + H * 1024 + lane * 16;
    v4u vb[4][4];
#define LOADV(S, I) do { _Pragma("unroll") for (int tk = 0; tk < 4; ++tk) { const int ee = RFL_I(skey[tk * 128 + (I)]) >> 7; vb[S][tk] = *(const v4u*)(vbase + (size_t)ee * D); } } while (0)
    LOADV(0, 0); LOADV(1, 1); LOADV(2, 2);
#pragma unroll 1
    for (int i0 = 0; i0 < 128; i0 += 4) {
#pragma unroll
        for (int s = 0; s < 4; ++s) {
            const int i = i0 + s;
            if (i + 3 < 128) LOADV((s + 3) & 3, i + 3);
            axpy16(a0, vb[s][0], RFL_F(sw[0 * 128 + i])); axpy16(a1, vb[s][1], RFL_F(sw[1 * 128 + i]));
            axpy16(a2, vb[s][2], RFL_F(sw[2 * 128 + i])); axpy16(a3, vb[s][3], RFL_F(sw[3 * 128 + i]));
        }
    }
#undef LOADV
}
__device__ __forceinline__ float peer_x2(f32x2 (&a)[8], const GAS float* xr, const GAS float* gr) {
    float ss = 0.f;
#pragma unroll
    for (int j = 0; j < 4; ++j) {
        const f32x4 x1v = *(const GAS f32x4*)(xr + j * 4), gv = *(const GAS f32x4*)(gr + j * 4);
        const f32x4 pv = {a[2 * j][0], a[2 * j][1], a[2 * j + 1][0], a[2 * j + 1][1]};
        const f32x4 o = x1v + gv * pv;
        a[2 * j] = (f32x2){o[0], o[1]}; a[2 * j + 1] = (f32x2){o[2], o[3]};
        ss += (o[0] * o[0] + o[1] * o[1]) + (o[2] * o[2] + o[3] * o[3]);
    }
    return ss;
}
__device__ __forceinline__ void peer_store(const f32x2 (&a)[8], float rstd, const GAS float* fgr, float* __restrict__ xw) {
#pragma unroll
    for (int j = 0; j < 4; ++j) { const f32x4 o = {a[2 * j][0], a[2 * j][1], a[2 * j + 1][0], a[2 * j + 1][1]}; *(f32x4*)(xw + j * 4) = o * rstd * *(const GAS f32x4*)(fgr + j * 4); }
}

__device__ __forceinline__ void peer_wave4(int t0, const bf16* __restrict__ f16, const int* __restrict__ eidx, const float* __restrict__ egsv, const float* __restrict__ esu,
                                           const unsigned char* __restrict__ U8, const unsigned char* __restrict__ V8, const float* __restrict__ g2, const float* __restrict__ fg,
                                           const float* xin, float* xout, LAS unsigned* lw, int lane) {
    LAS int* skey = (LAS int*)lw; LAS float* sgs = (LAS float*)(lw + 512); LAS float* sis = (LAS float*)(lw + 1024); LAS float* sw = (LAS float*)(lw + 1536);
#pragma unroll 1
    for (int tk = 0; tk < 4; ++tk) {
        const size_t eb = (size_t)(t0 + tk) * 128;
        int key[2];
        key[0] = (eidx[eb + lane] << 7) | lane; key[1] = (eidx[eb + 64 + lane] << 7) | (64 + lane);
        sort128(key, lane);
#pragma unroll
        for (int r = 0; r < 2; ++r) { const int n = key[r] & 127, i = tk * 128 + r * 64 + lane; skey[i] = key[r]; sgs[i] = egsv[eb + n]; sis[i] = esu[eb + n]; }
    }
    __builtin_amdgcn_sched_barrier(0);
    peer_usweep<0>(t0, f16, U8, skey, sgs, sis, sw, lane);
    __builtin_amdgcn_sched_barrier(0);
    peer_usweep<1>(t0, f16, U8, skey, sgs, sis, sw, lane);
    __builtin_amdgcn_sched_barrier(0);
    f32x2 lo0[8], lo1[8], lo2[8], lo3[8], hi0[8], hi1[8], hi2[8], hi3[8];
#pragma unroll
    for (int i = 0; i < 8; ++i) { lo0[i] = (f32x2){0.f, 0.f}; lo1[i] = lo0[i]; lo2[i] = lo0[i]; lo3[i] = lo0[i]; hi0[i] = lo0[i]; hi1[i] = lo0[i]; hi2[i] = lo0[i]; hi3[i] = lo0[i]; }
    peer_vsweep<0>(V8, skey, sw, lo0, lo1, lo2, lo3, lane);
    __builtin_amdgcn_sched_barrier(0);
    peer_vsweep<1>(V8, skey, sw, hi0, hi1, hi2, hi3, lane);
    __builtin_amdgcn_sched_barrier(0);
    const GAS float* gr = (const GAS float*)g2 + lane * 16; const GAS float* fgr = (const GAS float*)fg + lane * 16; const GAS float* xin_ = (const GAS float*)xin;
    asm volatile("" : "+v"(gr), "+v"(fgr), "+v"(xin_));
#define FINISH(TK, LO, HI) do { const GAS float* xr = xin_ + (size_t)(t0 + TK) * D + lane * 16; float* xw = xout + (size_t)(t0 + TK) * D + lane * 16; \
        float ss = peer_x2(LO, xr, gr) + peer_x2(HI, xr + 1024, gr + 1024); ss = wave_sum(ss); const float rstd = 1.0f / sqrtf(ss * (1.0f / D) + EPS); \
        peer_store(LO, rstd, fgr, xw); peer_store(HI, rstd, fgr + 1024, xw + 1024); } while (0)
    FINISH(0, lo0, hi0); FINISH(1, lo1, hi1); FINISH(2, lo2, hi2); FINISH(3, lo3, hi3);
#undef FINISH
}
}
__device__ __forceinline__ void p0_transpose_item(const float* W, int K, int N, bf16* WT, int row_off, LAS float* scr, int item, int lane) {
    const int nblk = N / 32, kb = item / nblk, nb = item % nblk, k0 = 64 * kb, n0 = 32 * nb;
#pragma unroll 8
    for (int i = 0; i < 32; ++i) { const int kk = 2 * i + (lane >> 5); scr[kk * 33 + (lane & 31)] = W[(size_t)(k0 + kk) * N + n0 + (lane & 31)]; }
    LDS_WAIT(); asm volatile("" ::: "memory");
    const int c = lane & 7;
#pragma unroll
    for (int j = 0; j < 4; ++j) { const int n = (lane >> 3) + 8 * j; const LAS float* s = scr + (8 * c) * 33 + n;
        v4u o; o.x = pk2(s[0 * 33], s[1 * 33]); o.y = pk2(s[2 * 33], s[3 * 33]); o.z = pk2(s[4 * 33], s[5 * 33]); o.w = pk2(s[6 * 33], s[7 * 33]);
        *(GAS v4u*)(WT + (size_t)(row_off + n0 + n) * K + k0 + 8 * c) = o; }
    LDS_WAIT(); asm volatile("" ::: "memory");
}

struct Args { const float* in[20]; float* out; unsigned char* ws; int ph_lo, ph_hi, li, pad; };
__device__ __forceinline__ const float* karg_ptr(int off) {
    const __attribute__((address_space(4))) char* kp = (const __attribute__((address_space(4))) char*)__builtin_amdgcn_kernarg_segment_ptr();
    asm volatile("" : "+s"(off));
    return *(const float* const __attribute__((address_space(4)))*)(kp + off);
}

__global__ void __launch_bounds__(NWAVES * 64, 2) mega(Args args) {
    extern __shared__ __attribute__((aligned(16))) unsigned char lds[];
    LAS unsigned char* ldsl = (LAS unsigned char*)lds;
    volatile LAS unsigned* MISC = (volatile LAS unsigned*)(ldsl + MISC_OFF);
    const int G = gridDim.x;
#define PHASE_IDS() int tid = threadIdx.x; asm volatile("" : "+v"(tid)); const int lane = tid & 63, wave = __builtin_amdgcn_readfirstlane(tid >> 6); \
    const int gw = blockIdx.x * NWAVES + wave, NGW = G * NWAVES, gtid = blockIdx.x * (NWAVES * 64) + tid, gthreads = G * NWAVES * 64; (void)lane; (void)gw; (void)NGW; (void)gtid; (void)gthreads
    unsigned char* ws = args.ws;
    gu32* ctl = (gu32*)(ws + WS_CTL);
    for (int u = threadIdx.x; u < (LDS_BYTES - LDSCTL_OFF) / 4; u += NWAVES * 64) ((LAS unsigned*)(ldsl + LDSCTL_OFF))[u] = 0u;
    __syncthreads();
    XcdBarrier bar = xcd_barrier_post((unsigned*)(ctl + CW_BAR) + args.li * XCD_BAR_WORDS, MISC + 8);
    const int lo = args.ph_lo, hi = args.ph_hi;
#define IN(k) (lo <= (k) && (k) < hi)
#ifndef PROBE_MASK
#define PROBE_MASK 0
#endif
#define PROBE_REP(k) ((((PROBE_MASK) >> (k)) & 1) ? 2 : 1)
#define SEAM(k) do { if (IN(k) && (k) + 1 < hi) xcd_barrier(bar); } while (0)

#define ARGP(i) karg_ptr((i) * 8)
#define ARG_OUT ((float*)karg_ptr(160))
#define Wt_in ((bf16*)(ws + WS_WIN))
#define Wt_out ((bf16*)(ws + WS_WOUT))
#define Wt_q ((bf16*)(ws + WS_WQ))
#define pwT16 ((bf16*)(ws + WS_PWT16))
#define mod ((float*)(ws + WS_MOD))
#define rope ((float*)(ws + WS_ROPE))
#define adap ((float*)(ws + WS_ADAP))
#define ssq ((float*)(ws + WS_SSQ))

    if (IN(0)) for (int rp = 0; rp < PROBE_REP(0); ++rp) { if (rp) xcd_barrier(bar);
        PHASE_IDS();
        LAS float* scr = (LAS float*)(ldsl + RING_OFF + wave * 16384);
        const float* w_in = ARGP(7); const float* w_out = ARGP(13); const float* peer_wq = ARGP(15); const float* pool_w = ARGP(8);
        constexpr int I_IN = (D / 64) * (INW / 32), I_O = (D / 64) * (D / 32);
        for (int it = gw; it < I_IN + 2 * I_O + 32; it += NGW) {
            int r = it;
            if (r < I_IN) { p0_transpose_item(w_in, D, INW, Wt_in, 0, scr, r, lane); continue; } r -= I_IN;
            if (r < I_O) { p0_transpose_item(w_out, D, D, Wt_out, 0, scr, r, lane); continue; } r -= I_O;
            if (r < I_O) { p0_transpose_item(peer_wq, D, D, Wt_q, 0, scr, r, lane); continue; } r -= I_O;
            p0_transpose_item(pool_w + (size_t)(r >> 3) * 16384, 128, 128, pwT16 + (size_t)(r >> 3) * 16384, 0, scr, r & 7, lane);
        }
        { const float* keys = ARGP(16); bf16* keys16 = (bf16*)(ws + WS_KEYS16);
          for (int i = gtid; i < 2 * PH * PNK * 128 / 4; i += gthreads) { const f32x4 v = *(const f32x4*)(keys + (size_t)i * 4); uint2 o; o.x = pk2(v[0], v[1]); o.y = pk2(v[2], v[3]); *(uint2*)(keys16 + (size_t)i * 4) = o; } }
        p0_lam_rope(ARGP(11), (float*)(ws + WS_LAM), rope, gtid, gthreads);
        __syncthreads();
        { LAS float* sv = (LAS float*)(ldsl + RING_OFF); LAS float* red = sv + 5 * D;
          const float* cvec = ARGP(1); const float* cctx = ARGP(3); const float* ada_w = ARGP(4);
          for (int i = tid; i < 5 * D; i += NWAVES * 64) { const int r = i / D, k = i % D; const float xv = r < 4 ? cvec[r * D + k] : cctx[k]; sv[i] = xv / (1.f + expf(-xv)); }
          __syncthreads();
          for (int unit = blockIdx.x; unit < 768; unit += G) p0_ada_unit(unit, ada_w, adap, sv, red, wave, lane, tid); }
        { const float* pu = ARGP(17); const float* pv = ARGP(18);
          unsigned char* U8 = ws + WS_U8; unsigned char* V8 = ws + WS_V8; float* su = (float*)(ws + WS_SU); float* svs = (float*)(ws + WS_SV);
          for (int row = gw; row < 2 * NEXP; row += NGW) {
              if (row < NEXP) p0_row_to_fp8(pu + (size_t)row * D, U8 + (size_t)row * D, su + row, lane);
              else p0_row_to_fp8(pv + (size_t)(row - NEXP) * D, V8 + (size_t)(row - NEXP) * D, svs + (row - NEXP), lane);
          } }
    }
    SEAM(0);
    if (IN(1)) for (int rp = 0; rp < PROBE_REP(1); ++rp) { if (rp) xcd_barrier(bar);
        PHASE_IDS();
        const float* ada_b = ARGP(5); const float* norm1_g = ARGP(6); const float* ctxp = ARGP(2); const float* x = ARGP(0);
        bf16* h16 = (bf16*)(ws + WS_H16);
        if (tid < 240) { const int idx = blockIdx.x * 240 + tid; const int r = idx / (6 * D), col = idx % (6 * D);
            float s = ada_b[col];
#pragma unroll
            for (int ks = 0; ks < 16; ++ks) s += adap[((size_t)ks * 5 + r) * (6 * D) + col];
            mod[(size_t)r * (6 * D) + col] = s; }
        LAS float* modl = (LAS float*)(ldsl + RING_OFF);
        const int bb = blockIdx.x >> 6;
        for (int i = tid; i < 8192; i += NWAVES * 64) { const int r = i < 4096 ? bb : 4, col = i & 4095;
            float s = ada_b[col];
#pragma unroll
            for (int ks = 0; ks < 16; ++ks) s += adap[((size_t)ks * 5 + r) * (6 * D) + col];
            modl[i] = s; }
        __syncthreads();
#pragma unroll 1
        for (int j = 0; j < 4; ++j) { const int row = blockIdx.x * 32 + wave * 4 + j;
            norm_row_bf16(x + (size_t)row * D, norm1_g, [=](int which, int col) { return *(const LAS f32x4*)(modl + which * 2048 + col); }, h16 + (size_t)row * D, lane, 0.f, false); }
        if (wave < 4) { const int r = blockIdx.x * 4 + wave;
            norm_row_bf16(ctxp + (size_t)r * D, norm1_g, [=](int which, int col) { return *(const LAS f32x4*)(modl + 4096 + which * 2048 + col); }, h16 + (size_t)(NLAT + r) * D, lane, 0.f, false); }
    }
    SEAM(1);
    if (IN(2)) for (int rp = 0; rp < PROBE_REP(2); ++rp) { if (rp) xcd_barrier(bar);
        pg8::Gemm g{(const bf16*)(ws + WS_H16), Wt_in, NTOK, INW, D};
        pg8::InProjOrder S; S.init(G, (int)blockIdx.x);
        pg8::EpiInProj E{(bf16*)(ws + WS_ZP16), (bf16*)(ws + WS_Q16), (bf16*)(ws + WS_K16), (bf16*)(ws + WS_V16), rope};
        pg8::gemm_phase<pg8::EpiInProj, pg8::InProjOrder, true, true>(ldsl + RING_OFF, g, S, E);
    }
    SEAM(2);
    if (IN(3)) for (int rp = 0; rp < PROBE_REP(3); ++rp) { if (rp) xcd_barrier(bar);
        PHASE_IDS();
        bf16* mix16 = (bf16*)(ws + WS_MIX16);
        const float* pool_b = ARGP(9); const float* pool_scale = ARGP(10); const float* subln_g = ARGP(12);
        if (wave < 4) for (int tile = blockIdx.x; tile < NLAT / 32; tile += G) att::pool_item(tile, wave, (const bf16*)(ws + WS_ZP16), pwT16, pool_b, pool_scale, mix16, lane);
        const float lam = *(const float*)(ws + WS_LAM);
        for (int u = blockIdx.x; u < 768; u += G) {
            int bh, qb;
            if (G == 256) { const int i = u >> 8, c = u & 255, xcd = c & 7, j = c >> 3; bh = i * 16 + xcd * 2 + (j >> 4); qb = j & 15; }
            else { bh = u >> 4; qb = u & 15; }
            att::attn_unit(bh / NH, bh % NH, qb, (const bf16*)(ws + WS_Q16), (const bf16*)(ws + WS_K16), (const bf16*)(ws + WS_V16), mix16, lam, subln_g, (char*)lds + RING_OFF);
        }
    }
    SEAM(3);
    if (IN(4)) for (int rp = 0; rp < PROBE_REP(4); ++rp) { if (rp) xcd_barrier(bar);
        pg8::Gemm g{(const bf16*)(ws + WS_MIX16), Wt_out, NLAT, D, D};
        pg8::StaticOrder S; S.init(NLAT, D, G, (int)blockIdx.x);
        pg8::EpiOutProj E{ARGP(0), mod, ARG_OUT, (float*)(ws + WS_SSQ)};
        pg8::gemm_phase<pg8::EpiOutProj, pg8::StaticOrder, true, true>(ldsl + RING_OFF, g, S, E);
    }
    SEAM(4);
    if (IN(5)) for (int rp = 0; rp < PROBE_REP(5); ++rp) { if (rp) xcd_barrier(bar);
        PHASE_IDS();
        const float* norm2_g = ARGP(14); float* xo = ARG_OUT; bf16* f16 = (bf16*)(ws + WS_F16);
        const float* sh2 = mod + (size_t)(blockIdx.x >> 6) * (6 * D) + 3 * D; const float* sc2 = sh2 + D;
#pragma unroll 1
        for (int j = 0; j < 4; ++j) { const int row = blockIdx.x * 32 + wave * 4 + j;
            const float p = lane < 32 ? ssq[(size_t)row * 32 + lane] : 0.f;
            const float rstd = 1.0f / sqrtf(wave_sum(p) * (1.0f / D) + EPS);
            norm_row_bf16(xo + (size_t)row * D, norm2_g, [=](int which, int col) { return *(const f32x4*)((which ? sc2 : sh2) + col); }, f16 + (size_t)row * D, lane, rstd, true); }
    }
    SEAM(5);
    if (IN(6)) for (int rp = 0; rp < PROBE_REP(6); ++rp) { if (rp) xcd_barrier(bar);
        pg8::Gemm g{(const bf16*)(ws + WS_F16), Wt_q, NLAT, D, D};
        pg8::StaticOrder S; S.init(NLAT, D, G, (int)blockIdx.x);
        pg8::EpiBf16Plain E{(bf16*)(ws + WS_QP16), D};
        pg8::gemm_phase<pg8::EpiBf16Plain, pg8::StaticOrder, true, true>(ldsl + RING_OFF, g, S, E);
    }
    SEAM(6);
    if (IN(7)) for (int rp = 0; rp < PROBE_REP(7); ++rp) { if (rp) xcd_barrier(bar);
        PHASE_IDS();
        for (int unit = gw; unit < (NLAT / 32) * PH; unit += NGW)
            peer::topk_unit((unit >> 3) * 32, unit & 7, (const bf16*)(ws + WS_QP16), (const bf16*)(ws + WS_KEYS16), (const float*)(ws + WS_SU), (const float*)(ws + WS_SV),
                            (int*)(ws + WS_EIDX), (float*)(ws + WS_EGATE), (float*)(ws + WS_ESU), ldsl + RING_OFF + wave * 1024, lane);
    }
    SEAM(7);
    if (IN(8)) for (int rp = 0; rp < PROBE_REP(8); ++rp) { if (rp) xcd_barrier(bar);
        PHASE_IDS();
        const float* fgp = ARGP(19); float* xo = ARG_OUT; float* xo2 = args.pad ? (float*)(ws + WS_ZF) : xo;
        { const int t0 = gw * 4;
          if (t0 < NLAT) peer::peer_wave4(t0, (const bf16*)(ws + WS_F16), (const int*)(ws + WS_EIDX), (const float*)(ws + WS_EGATE), (const float*)(ws + WS_ESU),
                             ws + WS_U8, ws + WS_V8, mod + (size_t)(t0 >> 11) * (6 * D) + 5 * D, fgp, xo, xo2, (LAS unsigned*)(ldsl + RING_OFF + wave * 8192), lane); }
    }
#undef IN
#undef SEAM
#undef mod
#undef rope
#undef adap
#undef ssq
#undef Wt_in
#undef Wt_out
#undef Wt_q
#undef pwT16
}
extern "C" void kernel_launch(void* const* d_in, const int* in_sizes, int n_in, void* d_out, int out_size, void* d_ws, size_t ws_size, hipStream_t stream) {
    static int grid = 0;
    if (grid == 0) {
        if (n_in != 20 || out_size != NLAT * D || ws_size < WS_END) { fprintf(stderr, "kernel_launch: unexpected shapes (n_in %d out %d ws %zu)\n", n_in, out_size, ws_size); grid = -1; return; }
        int dev = 0, cus = 0, per_cu = 0;
        if (hipGetDevice(&dev) != hipSuccess || hipDeviceGetAttribute(&cus, hipDeviceAttributeMultiprocessorCount, dev) != hipSuccess) { grid = -1; return; }
        if (hipFuncSetAttribute((const void*)mega, hipFuncAttributeMaxDynamicSharedMemorySize, LDS_BYTES) != hipSuccess) { fprintf(stderr, "kernel_launch: hipFuncSetAttribute failed\n"); grid = -1; return; }
        if (hipOccupancyMaxActiveBlocksPerMultiprocessor(&per_cu, (const void*)mega, NWAVES * 64, LDS_BYTES) != hipSuccess || per_cu < 1) { fprintf(stderr, "kernel_launch: occupancy query says %d blocks per CU\n", per_cu); grid = -1; (void)hipGetLastError(); return; }
        (void)hipGetLastError();
        if (cus < 256) { fprintf(stderr, "kernel_launch: needs 256 CUs, device has %d\n", cus); grid = -1; return; }
        grid = 256;
    }
    if (grid < 0) return;
    unsigned char* ws = (unsigned char*)d_ws;
    (void)hipMemsetAsync(ws + WS_CTL, 0, CTL_ZERO_BYTES, stream);
    Args a{};
    for (int i = 0; i < 20; ++i) a.in[i] = (const float*)d_in[i];
    a.out = (float*)d_out; a.ws = ws;
#ifndef PROBE_PHASE
    a.ph_lo = 0; a.ph_hi = 9; a.li = 0;
    hipLaunchKernelGGL(mega, dim3(grid), dim3(NWAVES * 64), LDS_BYTES, stream, a);
#else
    if (PROBE_PHASE > 0) { a.ph_lo = 0; a.ph_hi = PROBE_PHASE; a.li = 0; hipLaunchKernelGGL(mega, dim3(grid), dim3(NWAVES * 64), LDS_BYTES, stream, a); }
    for (int r = 0; r < PROBE_TIMES; ++r) { a.ph_lo = PROBE_PHASE; a.ph_hi = PROBE_PHASE + 1; a.li = 1; a.pad = (PROBE_PHASE == 8 && r + 1 < PROBE_TIMES) ? 1 : 0;
        hipLaunchKernelGGL(mega, dim3(grid), dim3(NWAVES * 64), LDS_BYTES, stream, a); }
    a.pad = 0;
    if (PROBE_PHASE < 8) { a.ph_lo = PROBE_PHASE + 1; a.ph_hi = 9; a.li = 2; hipLaunchKernelGGL(mega, dim3(grid), dim3(NWAVES * 64), LDS_BYTES, stream, a); }
#endif
}
```

```cpp
#include <hip/hip_runtime.h>
#include <math.h>
#include <stdint.h>
#include <cstdio>

constexpr int D = 2048, NB = 4, L = 2048, CT = 256;
constexpr int NLAT = NB * L;
constexpr int NCTX = NB * CT;
constexpr int NTOK = NLAT + NCTX;
constexpr int INW = 5120, POOLW = 512, ATTW = 1536, NH = 12, DV = 128, DQK = 64;
constexpr int QOFF = POOLW, KOFF = POOLW + ATTW, VOFF = POOLW + 2 * ATTW;
constexpr int LK = CT + L;
constexpr int PH = 8, PNK = 128, PTOPK = 16, NEXP = PNK * PNK;
constexpr float EPS = 1e-6f;
namespace pg8 {
#define PG8_LAS __attribute__((address_space(3)))
typedef unsigned short bf16_t;
typedef short bf16x8 __attribute__((ext_vector_type(8)));
typedef float f32x4 __attribute__((ext_vector_type(4)));
typedef unsigned u32x4 __attribute__((ext_vector_type(4)));
constexpr int BM = 256, BK = 64, HALF = 128, HTB = HALF * BK * 2  , STAGE_BYTES = 8 * HTB, NXCD = 8, WGM = 8;

__host__ __device__ __forceinline__ int lds_byte(int r, int c) { const int st = (r >> 4) * 2 + (c >> 5), rr = r & 15, cc = c & 31, ob = rr * 64 + cc * 2; return st * 1024 + (ob ^ (((ob >> 9) & 1) << 5)); }
__host__ __device__ __forceinline__ void stage_rc(int b, int& R, int& C) { const int st = b / 1024, sb = b % 1024, swz = sb ^ (((sb >> 9) & 1) << 5); R = (st >> 1) * 16 + swz / 64; C = (st & 1) * 32 + (swz % 64) / 2; }
__host__ __device__ __forceinline__ int perm32(int rho) { const int n = rho >> 4, i = rho & 15; return 8 * (i >> 2) + 4 * n + (i & 3); }

struct Unit { int pm, pn; };
struct Gemm { const bf16_t* A; const bf16_t* Bt; int M, N, K; };

struct StaticOrder {
    int nM, nN, nwg, G, c;
    __host__ __device__ void init(int M, int N, int G_, int c_) { nM = M / BM; nN = N / BM; nwg = nM * nN; G = G_; c = c_; }
    __host__ __device__ bool next(int i, Unit& u) const {
        const long L = (long)i * G + c; if (L >= nwg) return false;
        int wgid = (int)L; { const int q = nwg / NXCD, r = nwg % NXCD, xcd = wgid % NXCD, off = wgid / NXCD; wgid = (xcd < r ? xcd * (q + 1) : r * (q + 1) + (xcd - r) * q) + off; }
        const int nig = WGM * nN, gid = wgid / nig, fm = gid * WGM, gsz = (nM - fm) < WGM ? (nM - fm) : WGM;
        u.pm = fm + ((wgid % nig) % gsz); u.pn = (wgid % nig) / gsz; return true;
    }
    __device__ __forceinline__ void a_ready(const Unit&) const {}
    __device__ __forceinline__ void done(const Unit&) const {}
};

__device__ __forceinline__ unsigned cvt_pk_bf16(float lo, float hi) { unsigned r; asm volatile("v_cvt_pk_bf16_f32 %0, %1, %2" : "=v"(r) : "v"(lo), "v"(hi)); return r; }
typedef unsigned u32x2 __attribute__((ext_vector_type(2)));

struct InProjOrder {
    StaticOrder lat; int G, c;
    __device__ void init(int G_, int c_) { lat.init(8192, 5120, G_, c_); G = G_; c = c_; }
    __device__ bool next(int i, Unit& u) const {
        const int Lx = i * G + c;
        if (Lx < 640) return lat.next(i, u);
        const int j = Lx - 640; if (j >= 48) return false;
        u.pm = 32 + j / 12; u.pn = 8 + j % 12; return true;
    }
    __device__ __forceinline__ void a_ready(const Unit&) const {}
    __device__ __forceinline__ void done(const Unit&) const {}
};

struct EpiInProj {
    static constexpr bool PERM = false, AFTER_DRAIN = false;
    bf16_t *ZP, *Q, *Kb, *Vb; const float* rope;
    __device__ __forceinline__ void operator()(const f32x4 (&acc)[2][2][4][2], const Unit& u, int wr, int wc, int fr, int fq) const {
        const bool isctx = u.pm >= 32;
        const int kind = u.pn < 2 ? 0 : (u.pn < 8 ? 1 : (u.pn < 14 ? 2 : 3));
        const int pnl = kind == 0 ? u.pn : (kind == 1 ? u.pn - 2 : (kind == 2 ? u.pn - 8 : u.pn - 14));
        const int colt = pnl * 256 + wc * 32 + 4 * fq;
        bf16_t* dst = kind == 0 ? ZP : (kind == 1 ? Q : (kind == 2 ? Kb : Vb));
        const int ld = kind == 0 ? 512 : 1536;
        const bool dorope = (kind == 1 || kind == 2) && !isctx;
        const int ax = wc & 1;
#pragma unroll
        for (int ai = 0; ai < 2; ++ai)
#pragma unroll
            for (int m = 0; m < 4; ++m) {
                const int rl = ai * 128 + wr * 64 + m * 16 + fr;
                int orow, t = 0;
                if (!isctx) { const int g = u.pm * 256 + rl; t = g & 2047; orow = (kind >= 2) ? (g >> 11) * 2304 + 256 + t : g; }
                else orow = (u.pm - 32) * 2304 + rl;
                f32x4 cs0 = {1.f, 0.f, 1.f, 0.f}, cs1 = {1.f, 0.f, 1.f, 0.f};
                if (dorope) { const float* rp = rope + ((t * 2 + ax) * 16 + 4 * fq) * 2; cs0 = *(const f32x4*)rp; cs1 = *(const f32x4*)(rp + 4); }
#pragma unroll
                for (int bj = 0; bj < 2; ++bj) {
                    f32x4 v0 = acc[ai][bj][m][0], v1 = acc[ai][bj][m][1];
                    if (dorope) {
                        f32x4 o0, o1;
                        o0[0] = v0[0] * cs0[0] - v1[0] * cs0[1]; o1[0] = v0[0] * cs0[1] + v1[0] * cs0[0];
                        o0[1] = v0[1] * cs0[2] - v1[1] * cs0[3]; o1[1] = v0[1] * cs0[3] + v1[1] * cs0[2];
                        o0[2] = v0[2] * cs1[0] - v1[2] * cs1[1]; o1[2] = v0[2] * cs1[1] + v1[2] * cs1[0];
                        o0[3] = v0[3] * cs1[2] - v1[3] * cs1[3]; o1[3] = v0[3] * cs1[3] + v1[3] * cs1[2];
                        v0 = o0; v1 = o1;
                    }
                    bf16_t* p = dst + (size_t)orow * ld + colt + bj * 128;
                    u32x2 w0, w1; w0.x = cvt_pk_bf16(v0[0], v0[1]); w0.y = cvt_pk_bf16(v0[2], v0[3]); w1.x = cvt_pk_bf16(v1[0], v1[1]); w1.y = cvt_pk_bf16(v1[2], v1[3]);
                    *(u32x2*)p = w0; *(u32x2*)(p + 16) = w1;
                }
            }
    }
};

struct EpiOutProj {
    static constexpr bool PERM = false, AFTER_DRAIN = false;
    const float* x; const float* mod; float* x1; float* ssq;
    __device__ __forceinline__ void operator()(const f32x4 (&acc)[2][2][4][2], const Unit& u, int wr, int wc, int fr, int fq) const {
        const float* g1 = mod + (size_t)(u.pm >> 3) * (6 * 2048) + 2 * 2048;
        const int col0 = u.pn * 256 + wc * 32 + 4 * fq;
        f32x4 gv[2][2];
#pragma unroll
        for (int bj = 0; bj < 2; ++bj)
#pragma unroll
            for (int n = 0; n < 2; ++n) gv[bj][n] = *(const f32x4*)(g1 + col0 + bj * 128 + n * 16);
#pragma unroll
        for (int ai = 0; ai < 2; ++ai)
#pragma unroll
            for (int m = 0; m < 4; ++m) {
                const int row = u.pm * 256 + ai * 128 + wr * 64 + m * 16 + fr;
                float s = 0.f;
#pragma unroll
                for (int bj = 0; bj < 2; ++bj)
#pragma unroll
                    for (int n = 0; n < 2; ++n) {
                        const size_t off = (size_t)row * 2048 + col0 + bj * 128 + n * 16;
                        const f32x4 xv = *(const f32x4*)(x + off);
                        const f32x4 o = xv + gv[bj][n] * acc[ai][bj][m][n];
                        *(f32x4*)(x1 + off) = o;
                        s += (o[0] * o[0] + o[1] * o[1]) + (o[2] * o[2] + o[3] * o[3]);
                    }
                s += __shfl_xor(s, 16); s += __shfl_xor(s, 32);
                if (fq == 0) ssq[(size_t)row * 32 + u.pn * 4 + wc] = s;
            }
    }
};

struct EpiBf16Plain {
    static constexpr bool PERM = true, AFTER_DRAIN = false;
    bf16_t* O; int ldc;
    __device__ __forceinline__ void operator()(const f32x4 (&acc)[2][2][4][2], const Unit& u, int wr, int wc, int fr, int fq) const {
        const int row0 = u.pm * BM + wr * 64 + fr, col0 = u.pn * BM + wc * 32 + 8 * fq;
#pragma unroll
        for (int ai = 0; ai < 2; ++ai)
#pragma unroll
            for (int m = 0; m < 4; ++m) { bf16_t* rowp = O + (size_t)(row0 + ai * HALF + m * 16) * ldc + col0;
#pragma unroll
                for (int bj = 0; bj < 2; ++bj) { const f32x4 v0 = acc[ai][bj][m][0], v1 = acc[ai][bj][m][1];
                    u32x4 w; w.x = cvt_pk_bf16(v0[0], v0[1]); w.y = cvt_pk_bf16(v0[2], v0[3]); w.z = cvt_pk_bf16(v1[0], v1[1]); w.w = cvt_pk_bf16(v1[2], v1[3]);
                    *(u32x4*)(rowp + bj * HALF) = w; } }
    }
};

template <class Epi, class Sched, bool ALIGN_EPI = false, bool SP2 = false>
__device__ __forceinline__ void gemm_phase(PG8_LAS unsigned char* lds, const Gemm g, const Sched& S, const Epi& E) {
    const int tid = threadIdx.x, wid = __builtin_amdgcn_readfirstlane(tid >> 6), lane = tid & 63, wr = wid >> 2, wc = wid & 3, fr = lane & 15, fq = lane >> 4;
    const int K = g.K, nt = K / BK;
    unsigned voffA[2], voffB[2];
#pragma unroll
    for (int i = 0; i < 2; ++i) { int R, C; stage_rc(tid * 16 + i * 8192, R, C); const int Rb = Epi::PERM ? ((R & ~31) + perm32(R & 31)) : R;
        voffA[i] = (unsigned)(R * K + C) * 2u; voffB[i] = (unsigned)(Rb * K + C) * 2u; }
    const size_t kstep = (size_t)(BK * 2);
    const size_t hstep = (size_t)HALF * K * 2;
    const size_t tstep = 2 * hstep;
    const unsigned ldsw = (unsigned)wid * 1024u;
    const int aoff = lds_byte(wr * 64 + fr, fq * 8), boff = lds_byte(wc * 32 + fr, fq * 8);
#define PG8_SA(b, h) (((b) * 2 + (h)) * HTB)
#define PG8_SB(b, h) ((4 + (b) * 2 + (h)) * HTB)
#define PG8_STAGE(bufoff, gbase, voff) do { _Pragma("unroll") for (int _i = 0; _i < 2; ++_i) \
        __builtin_amdgcn_global_load_lds((const unsigned*)((const char*)(gbase) + (voff)[_i]), (PG8_LAS unsigned*)(lds + (bufoff) + ldsw + _i * 8192), 16, 0, 0); } while (0)
#define PG8_LDA(dst, b, h) do { _Pragma("unroll") for (int m = 0; m < 4; ++m) _Pragma("unroll") for (int k = 0; k < 2; ++k) dst[m][k] = *(const PG8_LAS bf16x8*)(lds + PG8_SA(b, h) + aoff + m * 2048 + k * 1024); } while (0)
#define PG8_LDB(dst, b, h) do { _Pragma("unroll") for (int n = 0; n < 2; ++n) _Pragma("unroll") for (int k = 0; k < 2; ++k) dst[n][k] = *(const PG8_LAS bf16x8*)(lds + PG8_SB(b, h) + boff + n * 2048 + k * 1024); } while (0)
#define PG8_MMA(ai, bj, At, Bt) do { __builtin_amdgcn_s_setprio(1); _Pragma("unroll") for (int m = 0; m < 4; ++m) _Pragma("unroll") for (int n = 0; n < 2; ++n) _Pragma("unroll") for (int k = 0; k < 2; ++k) \
        acc[ai][bj][m][n] = __builtin_amdgcn_mfma_f32_16x16x32_bf16(Bt[n][k], At[m][k], acc[ai][bj][m][n], 0, 0, 0); __builtin_amdgcn_s_setprio(0); } while (0)
#define PG8_WAIT_V(n) asm volatile("s_waitcnt vmcnt(" #n ")" ::: "memory")
#define PG8_WAIT_L(n) asm volatile("s_waitcnt lgkmcnt(" #n ")" ::: "memory")
#define PG8_BAR __builtin_amdgcn_s_barrier()
#define PG8_SCHED __builtin_amdgcn_sched_barrier(0)
    Unit cur, nxt; int ui = 0;
    if (!S.next(0, cur)) return;
    f32x4 acc[2][2][4][2];
#pragma unroll
    for (int a = 0; a < 2; ++a)
#pragma unroll
        for (int b = 0; b < 2; ++b)
#pragma unroll
            for (int m = 0; m < 4; ++m)
#pragma unroll
                for (int n = 0; n < 2; ++n) acc[a][b][m][n] = (f32x4){0.f, 0.f, 0.f, 0.f};
    bf16x8 At[4][2], B0[2][2], B1[2][2];
    const char* cA = (const char*)g.A + (size_t)cur.pm * tstep; const char* cB = (const char*)g.Bt + (size_t)cur.pn * tstep;
    S.a_ready(cur);
    if constexpr (SP2) {
        PG8_STAGE(PG8_SB(0, 0), cB, voffB); PG8_STAGE(PG8_SB(0, 1), cB + hstep, voffB); PG8_STAGE(PG8_SA(0, 0), cA, voffA); PG8_STAGE(PG8_SA(0, 1), cA + hstep, voffA);
        if (wr == 1) PG8_BAR;
        PG8_WAIT_V(2); PG8_BAR;
        PG8_STAGE(PG8_SB(1, 0), cB + kstep, voffB); PG8_STAGE(PG8_SA(1, 0), cA + kstep, voffA); PG8_STAGE(PG8_SB(1, 1), cB + hstep + kstep, voffB);
        PG8_WAIT_V(6); PG8_BAR;
    } else {
        PG8_STAGE(PG8_SB(0, 0), cB, voffB); PG8_STAGE(PG8_SA(0, 0), cA, voffA); PG8_STAGE(PG8_SB(0, 1), cB + hstep, voffB); PG8_STAGE(PG8_SA(0, 1), cA + hstep, voffA);
        if (wr == 1) PG8_BAR;
        PG8_WAIT_V(4); PG8_BAR;
        PG8_STAGE(PG8_SB(1, 0), cB + kstep, voffB); PG8_STAGE(PG8_SA(1, 0), cA + kstep, voffA); PG8_STAGE(PG8_SB(1, 1), cB + hstep + kstep, voffB);
        PG8_WAIT_V(6); PG8_BAR;
    }
    for (;;) {
        const bool has_next = S.next(ui + 1, nxt);
        const char* nA = has_next ? (const char*)g.A + (size_t)nxt.pm * tstep : cA; const char* nB = has_next ? (const char*)g.Bt + (size_t)nxt.pn * tstep : cB;
        for (int t = 0; t < nt; t += 2) {
            const bool last = (t == nt - 2);
            const char* a1 = cA + (size_t)(t + 1) * kstep;
            const char* a2 = last ? nA : cA + (size_t)(t + 2) * kstep; const char* b2 = last ? nB : cB + (size_t)(t + 2) * kstep;
            const char* a3 = a2 + kstep; const char* b3 = b2 + kstep;
            if (last && has_next) S.a_ready(nxt);
            if constexpr (SP2) {
            PG8_LDB(B0, 0, 0); PG8_LDB(B1, 0, 1); PG8_SCHED; PG8_LDA(At, 0, 0); PG8_STAGE(PG8_SA(1, 1), a1 + hstep, voffA);
            PG8_WAIT_V(8); PG8_WAIT_L(0); PG8_BAR; PG8_MMA(0, 0, At, B0); PG8_MMA(0, 1, At, B1); PG8_BAR; PG8_SCHED;
            PG8_LDA(At, 0, 1); PG8_STAGE(PG8_SB(0, 0), b2, voffB); PG8_STAGE(PG8_SB(0, 1), b2 + hstep, voffB); PG8_STAGE(PG8_SA(0, 0), a2, voffA);
            PG8_WAIT_V(8); PG8_WAIT_L(0); PG8_BAR; PG8_MMA(1, 0, At, B0); PG8_MMA(1, 1, At, B1); PG8_BAR; PG8_SCHED;
            PG8_LDB(B0, 1, 0); PG8_LDB(B1, 1, 1); PG8_SCHED; PG8_LDA(At, 1, 0); PG8_STAGE(PG8_SA(0, 1), a2 + hstep, voffA);
            PG8_WAIT_V(8); PG8_WAIT_L(0); PG8_BAR; PG8_MMA(0, 0, At, B0); PG8_MMA(0, 1, At, B1); PG8_BAR; PG8_SCHED;
            PG8_LDA(At, 1, 1); PG8_STAGE(PG8_SB(1, 0), b3, voffB); PG8_STAGE(PG8_SB(1, 1), b3 + hstep, voffB); PG8_STAGE(PG8_SA(1, 0), a3, voffA);
            PG8_WAIT_V(8); PG8_WAIT_L(0); PG8_BAR; PG8_MMA(1, 0, At, B0); PG8_MMA(1, 1, At, B1); PG8_BAR; PG8_SCHED;
            } else {
            PG8_LDB(B0, 0, 0); PG8_SCHED; PG8_LDA(At, 0, 0); PG8_STAGE(PG8_SA(1, 1), a1 + hstep, voffA);
            PG8_WAIT_L(8); PG8_BAR; PG8_WAIT_L(0); PG8_MMA(0, 0, At, B0); PG8_BAR; PG8_SCHED;
            PG8_LDB(B1, 0, 1); PG8_STAGE(PG8_SB(0, 0), b2, voffB);
            PG8_BAR; PG8_WAIT_L(0); PG8_MMA(0, 1, At, B1); PG8_BAR;
            PG8_LDA(At, 0, 1); PG8_STAGE(PG8_SA(0, 0), a2, voffA);
            PG8_BAR; PG8_WAIT_L(0); PG8_MMA(1, 0, At, B0); PG8_BAR; PG8_SCHED;
            PG8_STAGE(PG8_SB(0, 1), b2 + hstep, voffB);
            PG8_WAIT_V(6); PG8_BAR; PG8_MMA(1, 1, At, B1); PG8_BAR;
            PG8_LDB(B0, 1, 0); PG8_SCHED; PG8_LDA(At, 1, 0); PG8_STAGE(PG8_SA(0, 1), a2 + hstep, voffA);
            PG8_WAIT_L(8); PG8_BAR; PG8_WAIT_L(0); PG8_MMA(0, 0, At, B0); PG8_BAR; PG8_SCHED;
            PG8_LDB(B1, 1, 1); PG8_STAGE(PG8_SB(1, 0), b3, voffB);
            PG8_BAR; PG8_WAIT_L(0); PG8_MMA(0, 1, At, B1); PG8_BAR;
            PG8_LDA(At, 1, 1); PG8_STAGE(PG8_SA(1, 0), a3, voffA);
            PG8_BAR; PG8_WAIT_L(0); PG8_MMA(1, 0, At, B0); PG8_BAR; PG8_SCHED;
            PG8_STAGE(PG8_SB(1, 1), b3 + hstep, voffB);
            PG8_WAIT_V(6); PG8_BAR; PG8_MMA(1, 1, At, B1); PG8_BAR;
            }
        }
        if constexpr (ALIGN_EPI) { if (wr == 0) PG8_BAR; }
        if constexpr (!Epi::AFTER_DRAIN) { E(acc, cur, wr, wc, fr, fq); S.done(cur); }
        if (!has_next) break;
#pragma unroll
        for (int a = 0; a < 2; ++a)
#pragma unroll
            for (int b = 0; b < 2; ++b)
#pragma unroll
                for (int m = 0; m < 4; ++m)
#pragma unroll
                    for (int n = 0; n < 2; ++n) acc[a][b][m][n] = (f32x4){0.f, 0.f, 0.f, 0.f};
        cur = nxt; cA = nA; cB = nB; ++ui;
        if constexpr (ALIGN_EPI) { if (wr == 1) PG8_BAR; }
    }
    PG8_WAIT_V(0);
    if constexpr (!ALIGN_EPI) { if (wr == 0) PG8_BAR; }
    PG8_BAR;
    if constexpr (Epi::AFTER_DRAIN) { E.fused(acc, cur, wr, wc, fr, fq, lds, wid, lane); S.done(cur); }
#undef PG8_SA
#undef PG8_SB
#undef PG8_STAGE
#undef PG8_LDA
#undef PG8_LDB
#undef PG8_MMA
#undef PG8_WAIT_V
#undef PG8_WAIT_L
#undef PG8_BAR
#undef PG8_SCHED
}
}
constexpr size_t MiB = 1u << 20, KiB = 1u << 10;
constexpr size_t WS_CTL = 0, CTL_ZERO_BYTES = 1 * MiB;
constexpr size_t WS_LAM = 1 * MiB;
constexpr size_t WS_ROPE = 1 * MiB + 64 * KiB;
constexpr size_t WS_MOD = 1 * MiB + 640 * KiB;
constexpr size_t WS_ADAP = 2 * MiB;
constexpr size_t WS_SSQ = 6 * MiB;
constexpr size_t WS_SU = 7 * MiB, WS_SV = 7 * MiB + 64 * KiB;
constexpr size_t WS_EIDX = 8 * MiB, WS_EGATE = 12 * MiB;
constexpr size_t WS_KEYS16 = 16 * MiB, WS_PWT16 = 16 * MiB + 512 * KiB;
constexpr size_t WS_WIN = 18 * MiB, WS_WOUT = 38 * MiB, WS_WQ = 46 * MiB;
constexpr size_t WS_HF = 54 * MiB, WS_ZF = 126 * MiB, WS_MIXF = 306 * MiB;
constexpr size_t WS_H16 = 370 * MiB, WS_Q16 = 406 * MiB, WS_K16 = 430 * MiB, WS_V16 = 457 * MiB, WS_ZP16 = 484 * MiB;
constexpr size_t WS_MIX16 = 370 * MiB, WS_F16 = 406 * MiB, WS_QP16 = 438 * MiB;
constexpr size_t WS_U8 = 192 * MiB, WS_V8 = 224 * MiB;
constexpr size_t WS_ESU = 256 * MiB;
constexpr size_t WS_END = 512 * MiB;
constexpr int CW_BAR = 4096;

constexpr int RING_OFF = 0, RING_BYTES = 131072;
constexpr int LDSCTL_OFF = RING_BYTES, MISC_OFF = LDSCTL_OFF + 320;
constexpr int LDS_BYTES = 147456;
constexpr int NWAVES = 8;
#define GAS __attribute__((address_space(1)))
#define LAS __attribute__((address_space(3)))
typedef unsigned short bf16;
typedef unsigned v4u __attribute__((ext_vector_type(4)));
typedef float f32x4 __attribute__((ext_vector_type(4)));
typedef short bf16x8 __attribute__((ext_vector_type(8)));
typedef GAS unsigned gu32;
typedef GAS unsigned long long gu64;
#define RLX_AGENT __ATOMIC_RELAXED, __HIP_MEMORY_SCOPE_AGENT
#define LDS_WAIT() asm volatile("s_waitcnt lgkmcnt(0)" ::: "memory")
#define VM_WAIT() asm volatile("s_waitcnt vmcnt(0)" ::: "memory")
__device__ __forceinline__ unsigned long long rt() { return __builtin_amdgcn_s_memrealtime(); }
__device__ __forceinline__ unsigned f2bf(float f) { unsigned u = __builtin_bit_cast(unsigned, f); return (u + 0x7fffu + ((u >> 16) & 1u)) >> 16; }
__device__ __forceinline__ unsigned pk2(float lo, float hi) { return f2bf(lo) | (f2bf(hi) << 16); }

#define XB_TMO      128
#define XB_XCNT(j)  (256  + 64 * (j))
#define XB_XSUB(j)  (1280 + 64 * (j))
#define XB_XGEN(j)  (2304 + 64 * (j))
#define XB_TOP      3328
#define XB_TOPGEN   3392
#define XCD_BAR_WORDS 3456
#define XB_SPIN_CAP (1u << 18)

__device__ __forceinline__ unsigned xb_ld(unsigned* p)              { return __hip_atomic_load(p, __ATOMIC_RELAXED, __HIP_MEMORY_SCOPE_AGENT); }
__device__ __forceinline__ unsigned xb_add(unsigned* p, unsigned v) { return __hip_atomic_fetch_add(p, v, __ATOMIC_RELAXED, __HIP_MEMORY_SCOPE_AGENT); }
__device__ __forceinline__ unsigned xb_xcc_id() { return (unsigned)__builtin_amdgcn_s_getreg((3 << 11) | 20) & 0xFu; }
#define XB_SPIN(cond, bar) do { unsigned _sp = 0; while (cond) { __builtin_amdgcn_s_sleep(1); \
    if ((++_sp & 255u) == 0u) { if (xb_ld(&(bar)[XB_TMO])) break; if (_sp > XB_SPIN_CAP) { atomicAdd(&(bar)[XB_TMO], 1u); break; } } } } while (0)

struct XcdBarrier {
    unsigned* bar; unsigned x;
    volatile LAS unsigned* st;
};

__device__ __forceinline__ XcdBarrier xcd_barrier_post(unsigned* bar, volatile LAS unsigned* st) {
    XcdBarrier b; b.bar = bar; b.x = xb_xcc_id(); b.st = st;
    if (threadIdx.x == 0) (void)xb_add(&bar[XB_XCNT(b.x)], 1u);
    return b;
}
__device__ __forceinline__ void xcd_barrier_complete(unsigned* bar, unsigned x, unsigned& nloc, unsigned& nx) {
    const unsigned G = gridDim.x * gridDim.y * gridDim.z;
    unsigned sum, cnt, mine, sp = 0u;
    for (;;) {
        sum = 0u; cnt = 0u; mine = 0u;
#pragma unroll
        for (unsigned j = 0; j < 16; ++j) { const unsigned c = xb_ld(&bar[XB_XCNT(j)]); sum += c; cnt += (c > 0u) ? 1u : 0u; mine = (j == x) ? c : mine; }
        if (sum == G) break;
        __builtin_amdgcn_s_sleep(1);
        if ((++sp & 255u) == 0u) { if (xb_ld(&bar[XB_TMO])) break; if (sp > XB_SPIN_CAP) { atomicAdd(&bar[XB_TMO], 1u); break; } }
    }
    nloc = mine > 0u ? mine : 1u; nx = cnt > 0u ? cnt : 1u;
}

__device__ __forceinline__ void xcd_barrier(const XcdBarrier& b) {
    asm volatile("s_waitcnt vmcnt(0)" ::: "memory");
    __syncthreads();
    if (threadIdx.x == 0) {
        unsigned* bar = b.bar;
        __builtin_amdgcn_s_waitcnt(0);
        unsigned nloc = b.st[0], nx = b.st[1];
        if (nloc == 0u) { xcd_barrier_complete(bar, b.x, nloc, nx); b.st[0] = nloc; b.st[1] = nx; }
        const unsigned old = xb_add(&bar[XB_XSUB(b.x)], 1u);
        const unsigned gen = old / nloc;
        if (old + 1u == (gen + 1u) * nloc) {
            __builtin_amdgcn_fence(__ATOMIC_RELEASE, "agent");
            asm volatile("s_waitcnt vmcnt(0)" ::: "memory");
            const unsigned og = xb_add(&bar[XB_TOP], 1u);
            const unsigned tg = og / nx;
            if (og + 1u == (tg + 1u) * nx) xb_add(&bar[XB_TOPGEN], 1u);
            else XB_SPIN(xb_ld(&bar[XB_TOPGEN]) == tg, bar);
            __builtin_amdgcn_fence(__ATOMIC_ACQUIRE, "agent");
            xb_add(&bar[XB_XGEN(b.x)], 1u);
            asm volatile("s_waitcnt vmcnt(0)" ::: "memory");
        } else {
            XB_SPIN(xb_ld(&bar[XB_XGEN(b.x)]) == gen, bar);
            __builtin_amdgcn_fence(__ATOMIC_ACQUIRE, "agent");
            asm volatile("s_waitcnt vmcnt(0)" ::: "memory");
        }
    }
    __syncthreads();
}
namespace att {
using s16x4  = __attribute__((ext_vector_type(4))) short;
using f32x16 = __attribute__((ext_vector_type(16))) float;
constexpr int NW = 8, QBLK = 32, KVBLK = 64, LDQ = 1536, LDK = 1536;
constexpr float SCALE = 0.125f, THR = 8.f;
constexpr int SHM_V = KVBLK * 128 * 2, SHM_K = KVBLK * 128 * 2;
#define KSWZ(row, colB) ((row) * 256 + ((colB) ^ (((row) & 7) << 4)))
#define SBAR() __builtin_amdgcn_sched_barrier(0)
__device__ __forceinline__ int crow(int r, int hi) { return (r & 3) + 8 * (r >> 2) + 4 * hi; }
__device__ __forceinline__ unsigned cvtpk(float lo, float hi) { unsigned r; asm volatile("v_cvt_pk_bf16_f32 %0, %1, %2" : "=v"(r) : "v"(lo), "v"(hi)); return r; }

__device__ __forceinline__ void partialSM(f32x16& p0, f32x16& p1, float& m_reg, float& mn, float& alpha) {
  constexpr float C = SCALE * 1.4426950408889634f;
  float pmax = p0[0]; for (int r = 1; r < 16; ++r) pmax = fmaxf(pmax, p0[r]); for (int r = 0; r < 16; ++r) pmax = fmaxf(pmax, p1[r]);
  { auto rr = __builtin_amdgcn_permlane32_swap(__float_as_uint(pmax), __float_as_uint(pmax), false, false);
    pmax = fmaxf(__uint_as_float(rr[0]), __uint_as_float(rr[1])); }
  if (__builtin_expect(__all(pmax - m_reg <= THR / SCALE), 1)) { mn = m_reg; alpha = 1.f; }
  else { mn = fmaxf(m_reg, pmax); alpha = __builtin_amdgcn_exp2f((m_reg - mn) * C); m_reg = mn; }
  float mnC = -mn * C;
  for (int r = 0; r < 16; ++r) p0[r] = fmaf(p0[r], C, mnC); for (int r = 0; r < 16; ++r) p1[r] = fmaf(p1[r], C, mnC);
  for (int r = 0; r < 16; ++r) p0[r] = __builtin_amdgcn_exp2f(p0[r]);
}
__device__ __forceinline__ void finishSM(f32x16& p0, f32x16& p1, float alpha, float& l_reg, bf16x8& pa0, bf16x8& pa1, bf16x8& pa2, bf16x8& pa3) {
  for (int r = 0; r < 16; ++r) p1[r] = __builtin_amdgcn_exp2f(p1[r]);
  float ps = 0; for (int r = 0; r < 16; ++r) ps += p0[r]; for (int r = 0; r < 16; ++r) ps += p1[r];
  { auto rr = __builtin_amdgcn_permlane32_swap(__float_as_uint(ps), __float_as_uint(ps), false, false);
    ps = __uint_as_float(rr[0]) + __uint_as_float(rr[1]); }
  l_reg = l_reg * alpha + ps;
#define PK4(P, BASE, OUT) do { unsigned a0 = cvtpk(P[BASE + 0], P[BASE + 1]), a1 = cvtpk(P[BASE + 2], P[BASE + 3]);   \
    unsigned b0 = cvtpk(P[BASE + 4], P[BASE + 5]), b1 = cvtpk(P[BASE + 6], P[BASE + 7]);                              \
    auto r0 = __builtin_amdgcn_permlane32_swap(a0, b0, false, false); auto r1 = __builtin_amdgcn_permlane32_swap(a1, b1, false, false); \
    v4u w = {r0[0], r1[0], r0[1], r1[1]}; OUT = *reinterpret_cast<bf16x8*>(&w); } while (0)
  PK4(p0, 0, pa0); PK4(p0, 8, pa1); PK4(p1, 0, pa2); PK4(p1, 8, pa3);
#undef PK4
}
__device__ __forceinline__ void qkt(f32x16& p0, f32x16& p1, const bf16* Ks, const bf16x8* qr, int r32, int hi, int mp) {
  p0 = f32x16{}; p1 = f32x16{};
  for (int d0 = 0; d0 < 4; ++d0) { int cb = (mp * 64 + d0 * 16 + hi * 8) * 2;
    bf16x8 b0 = *reinterpret_cast<const bf16x8*>((const char*)Ks + KSWZ(r32, cb));
    bf16x8 b1 = *reinterpret_cast<const bf16x8*>((const char*)Ks + KSWZ(32 + r32, cb));
    p0 = __builtin_amdgcn_mfma_f32_32x32x16_bf16(b0, qr[d0], p0, 0, 0, 0);
    p1 = __builtin_amdgcn_mfma_f32_32x32x16_bf16(b1, qr[d0], p1, 0, 0, 0); }
}
__device__ __forceinline__ int v_st(int k, int c) { const int kk = (k & ~0xC) | ((k & 4) << 1) | ((k & 8) >> 1); return ((kk >> 3) * 4 + (c >> 5)) * 512 + ((kk & 7) * 32 + (c & 31)) * 2; }
__device__ __forceinline__ int v_rd_base(int lane) { return ((lane & 3) << 3) | (((lane >> 2) & 3) << 6) | (((lane >> 4) & 1) << 5) | (((lane >> 5) & 1) << 8); }
constexpr int v_rd_off(int d0, int ks, int half) { return d0 * 512 + ks * 4096 + half * 2048; }
template <int OFF> __device__ __forceinline__ s16x4 tr_read(int vb) {
  s16x4 r; asm volatile("ds_read_b64_tr_b16 %0, %1 offset:%2" : "=&v"(r) : "v"(vb), "i"(OFF) : "memory"); return r;
}
template <int D0> __device__ __forceinline__ void pv_one(f32x16& od, int vb, bf16x8 pa0, bf16x8 pa1, bf16x8 pa2, bf16x8 pa3) {
  const s16x4 l0 = tr_read<v_rd_off(D0, 0, 0)>(vb), h0 = tr_read<v_rd_off(D0, 0, 1)>(vb), l1 = tr_read<v_rd_off(D0, 1, 0)>(vb), h1 = tr_read<v_rd_off(D0, 1, 1)>(vb);
  const s16x4 l2 = tr_read<v_rd_off(D0, 2, 0)>(vb), h2 = tr_read<v_rd_off(D0, 2, 1)>(vb), l3 = tr_read<v_rd_off(D0, 3, 0)>(vb), h3 = tr_read<v_rd_off(D0, 3, 1)>(vb);
  asm volatile("s_waitcnt lgkmcnt(0)" ::: "memory"); SBAR();
#define PK(L, H) (bf16x8){L[0], L[1], L[2], L[3], H[0], H[1], H[2], H[3]}
  od = __builtin_amdgcn_mfma_f32_32x32x16_bf16(pa0, PK(l0, h0), od, 0, 0, 0);
  od = __builtin_amdgcn_mfma_f32_32x32x16_bf16(pa1, PK(l1, h1), od, 0, 0, 0);
  od = __builtin_amdgcn_mfma_f32_32x32x16_bf16(pa2, PK(l2, h2), od, 0, 0, 0);
  od = __builtin_amdgcn_mfma_f32_32x32x16_bf16(pa3, PK(l3, h3), od, 0, 0, 0);
#undef PK
}
__device__ __forceinline__ void pv_d0(f32x16* o, int vb, bf16x8 pa0, bf16x8 pa1, bf16x8 pa2, bf16x8 pa3) {
  pv_one<0>(o[0], vb, pa0, pa1, pa2, pa3); pv_one<1>(o[1], vb, pa0, pa1, pa2, pa3); pv_one<2>(o[2], vb, pa0, pa1, pa2, pa3); pv_one<3>(o[3], vb, pa0, pa1, pa2, pa3);
}

__device__ __forceinline__ void attn_unit(int b, int h, int qb, const bf16* __restrict__ Q16, const bf16* __restrict__ K16, const bf16* __restrict__ V16,
                                          bf16* __restrict__ mix16, float lam, const float* __restrict__ subg, char* lds) {
  const int tid = threadIdx.x, wid = tid >> 6, lane = tid & 63, r32 = lane & 31, hi = lane >> 5, mp = wid >> 2, qs = wid & 3;
  bf16* V_lds = (bf16*)lds; bf16* K_lds = (bf16*)(lds + 2 * SHM_V);
  float* wsx = (float*)(lds + 2 * SHM_V + 2 * SHM_K) + wid * 64; float* li_l = wsx; float* al_l = wsx + 32;
  float m_reg = -1e30f, l_reg = 0; f32x16 o[4] = {}; bf16x8 qr[4];
  const bf16* Qw = Q16 + (size_t)(b * L + qb * 128 + qs * 32 + r32) * LDQ + h * 128 + mp * 64 + hi * 8;
#pragma unroll
  for (int d0 = 0; d0 < 4; ++d0) qr[d0] = *reinterpret_cast<const bf16x8*>(Qw + d0 * 16);
  const bf16* Kh = K16 + (size_t)(b * LK) * LDK + h * 128;
  const bf16* Vh = V16 + (size_t)(b * LK) * LDK + h * 128;
  const int sr = tid >> 4, sc = (tid & 15) * 8, vst0 = v_st(sr, sc), vst1 = v_st(32 + sr, sc);
  const int vb0 = (int)(uintptr_t)V_lds + v_rd_base(lane);
  struct { bf16x8 vs0, vs1, ks0, ks1; } sr_[2];
#define SLOAD(i, k0) do { sr_[i].vs0 = *(const bf16x8*)(&Vh[(size_t)((k0) + sr) * LDK + sc]); sr_[i].vs1 = *(const bf16x8*)(&Vh[(size_t)((k0) + 32 + sr) * LDK + sc]); \
    sr_[i].ks0 = *(const bf16x8*)(&Kh[(size_t)((k0) + sr) * LDK + sc]); sr_[i].ks1 = *(const bf16x8*)(&Kh[(size_t)((k0) + 32 + sr) * LDK + sc]); } while (0)
#define SWRITE(bb, i) do { *(bf16x8*)((char*)V_lds + (bb) * SHM_V + vst0) = sr_[i].vs0;          \
    *(bf16x8*)((char*)V_lds + (bb) * SHM_V + vst1) = sr_[i].vs1; int kc = sc * 2;               \
    *(bf16x8*)((char*)K_lds + (bb) * SHM_K + KSWZ(sr, kc)) = sr_[i].ks0;                       \
    *(bf16x8*)((char*)K_lds + (bb) * SHM_K + KSWZ(32 + sr, kc)) = sr_[i].ks1; } while (0)
#define SWAIT() asm volatile("s_waitcnt vmcnt(4)" ::: "memory")
#define RESC(a) do { if (__any((a) < 1.f)) { if (hi == 0) al_l[r32] = (a); asm volatile("s_waitcnt lgkmcnt(0)" ::: "memory"); \
    for (int d = 0; d < 4; ++d) for (int r = 0; r < 16; ++r) o[d][r] *= al_l[crow(r, hi)]; } } while (0)
  f32x16 pA0, pA1, pB0, pB1; float mnA, mnB, alA, alB; bf16x8 pa0, pa1, pa2, pa3; constexpr int NT = LK / KVBLK;
  constexpr int SE = 0, SO = 1;
  SLOAD(SE, 0); asm volatile("s_waitcnt vmcnt(0)" ::: "memory"); SWRITE(0, SE); __syncthreads();
  qkt(pA0, pA1, K_lds, qr, r32, hi, mp); partialSM(pA0, pA1, m_reg, mnA, alA);
  SLOAD(SO, KVBLK); SLOAD(SE, 2 * KVBLK);
  SWAIT(); SWRITE(1, SO); __syncthreads();
  for (int j = 1; j + 1 < NT; j += 2) {
    SBAR(); qkt(pB0, pB1, (bf16*)((char*)K_lds + SHM_K), qr, r32, hi, mp);
    finishSM(pA0, pA1, alA, l_reg, pa0, pa1, pa2, pa3); SBAR();
    SLOAD(SO, (j + 2) * KVBLK); SBAR();
    pv_d0(o, vb0, pa0, pa1, pa2, pa3); partialSM(pB0, pB1, m_reg, mnB, alB);
    __syncthreads(); SWAIT(); SWRITE(0, SE);
    RESC(alB); __syncthreads();
    SBAR(); qkt(pA0, pA1, K_lds, qr, r32, hi, mp);
    finishSM(pB0, pB1, alB, l_reg, pa0, pa1, pa2, pa3); SBAR();
    if (j + 3 < NT) SLOAD(SE, (j + 3) * KVBLK); SBAR();
    pv_d0(o, vb0 + SHM_V, pa0, pa1, pa2, pa3); partialSM(pA0, pA1, m_reg, mnA, alA);
    __syncthreads(); SWAIT(); SWRITE(1, SO);
    RESC(alA); __syncthreads();
  }
  SBAR(); qkt(pB0, pB1, (bf16*)((char*)K_lds + SHM_K), qr, r32, hi, mp);
  finishSM(pA0, pA1, alA, l_reg, pa0, pa1, pa2, pa3); SBAR();
  pv_d0(o, vb0, pa0, pa1, pa2, pa3); partialSM(pB0, pB1, m_reg, mnB, alB);
  __syncthreads(); RESC(alB);
  finishSM(pB0, pB1, alB, l_reg, pa0, pa1, pa2, pa3); SBAR();
  pv_d0(o, vb0 + SHM_V, pa0, pa1, pa2, pa3);
  if (hi == 0) li_l[r32] = l_reg;
  asm volatile("s_waitcnt lgkmcnt(0)" ::: "memory");
  float rli[16];
#pragma unroll
  for (int r = 0; r < 16; ++r) rli[r] = 1.0f / li_l[crow(r, hi)];
  __syncthreads();
  float* X = (float*)lds + qs * (32 * 128);
  if (mp == 1) {
#pragma unroll
    for (int r = 0; r < 16; ++r)
#pragma unroll
      for (int d0 = 0; d0 < 4; ++d0) X[crow(r, hi) * 128 + d0 * 32 + r32] = lam * o[d0][r] * rli[r];
  }
  __syncthreads();
  if (mp == 0) {
    float ssq[16];
#pragma unroll
    for (int r = 0; r < 16; ++r) { float s = 0.f;
#pragma unroll
      for (int d0 = 0; d0 < 4; ++d0) { const float v = o[d0][r] * rli[r] - X[crow(r, hi) * 128 + d0 * 32 + r32]; o[d0][r] = v; s += v * v; }
      ssq[r] = s; }
#pragma unroll
    for (int r = 0; r < 16; ++r) {
      float s = ssq[r];
      s += __shfl_xor(s, 1); s += __shfl_xor(s, 2); s += __shfl_xor(s, 4); s += __shfl_xor(s, 8); s += __shfl_xor(s, 16);
      ssq[r] = 1.0f / sqrtf(s * (1.0f / 128.f) + EPS);
    }
    float sg[4];
#pragma unroll
    for (int d0 = 0; d0 < 4; ++d0) sg[d0] = subg[d0 * 32 + r32] * 0.8f;
    asm volatile("s_waitcnt lgkmcnt(0)" ::: "memory");
    unsigned short* Y = (unsigned short*)X;
#pragma unroll
    for (int r = 0; r < 16; ++r)
#pragma unroll
      for (int d0 = 0; d0 < 4; ++d0) Y[crow(r, hi) * 128 + d0 * 32 + r32] = (unsigned short)f2bf(o[d0][r] * ssq[r] * sg[d0]);
    asm volatile("s_waitcnt lgkmcnt(0)" ::: "memory");
    bf16* Ob = mix16 + (size_t)(b * L + qb * 128 + qs * 32) * D + POOLW + h * 128;
#pragma unroll
    for (int j = 0; j < 8; ++j) { const int idx = j * 64 + lane, row = idx >> 4, ch = idx & 15;
      const v4u w = *(const v4u*)(Y + row * 128 + ch * 8);
      *(v4u*)(Ob + (size_t)row * D + ch * 8) = w; }
  }
  __syncthreads();
#undef SLOAD
#undef SWRITE
#undef SWAIT
#undef RESC
}

__device__ __forceinline__ void pool_item(int tile, int g, const bf16* __restrict__ ZP16, const bf16* __restrict__ pwT16, const float* __restrict__ pool_b,
                                          const float* __restrict__ pool_scale, bf16* __restrict__ mix16, int lane) {
  const int r32 = lane & 31, hi = lane >> 5;
  const int row0 = tile * 32, t = (row0 & 2047) + r32, rb = row0 & ~2047;
  const int w = 2 << g, hw = w >> 1;
  const int lo = t - hw < 0 ? 0 : t - hw, hi_ = t + hw > L ? L : t + hw;
  const float inv = 1.0f / (float)(hi_ - lo);
  bf16x8 af[8];
#pragma unroll
  for (int ks = 0; ks < 8; ++ks) {
    const int c0 = g * 128 + ks * 16 + hi * 8;
    float s[8];
#pragma unroll
    for (int e = 0; e < 8; ++e) s[e] = 0.f;
    for (int j = 0; j < w; ++j) {
      const int tt = t - hw + j; const bool ok = tt >= 0 && tt < L; const int tc = tt < 0 ? 0 : (tt >= L ? L - 1 : tt);
      const bf16x8 v = *(const bf16x8*)(ZP16 + (size_t)(rb + tc) * 512 + c0);
      const float m = ok ? 1.f : 0.f;
#pragma unroll
      for (int e = 0; e < 8; ++e) s[e] += m * __uint_as_float((unsigned)(unsigned short)v[e] << 16);
    }
    const bf16x8 own = *(const bf16x8*)(ZP16 + (size_t)(rb + t) * 512 + c0);
    v4u pk;
    pk.x = cvtpk(s[0] * inv - __uint_as_float((unsigned)(unsigned short)own[0] << 16), s[1] * inv - __uint_as_float((unsigned)(unsigned short)own[1] << 16));
    pk.y = cvtpk(s[2] * inv - __uint_as_float((unsigned)(unsigned short)own[2] << 16), s[3] * inv - __uint_as_float((unsigned)(unsigned short)own[3] << 16));
    pk.z = cvtpk(s[4] * inv - __uint_as_float((unsigned)(unsigned short)own[4] << 16), s[5] * inv - __uint_as_float((unsigned)(unsigned short)own[5] << 16));
    pk.w = cvtpk(s[6] * inv - __uint_as_float((unsigned)(unsigned short)own[6] << 16), s[7] * inv - __uint_as_float((unsigned)(unsigned short)own[7] << 16));
    af[ks] = *reinterpret_cast<bf16x8*>(&pk);
  }
  f32x16 acc[4] = {};
#pragma unroll
  for (int d0 = 0; d0 < 4; ++d0)
#pragma unroll
    for (int ks = 0; ks < 8; ++ks) {
      const bf16x8 bfr = *(const bf16x8*)(pwT16 + ((size_t)g * 128 + d0 * 32 + r32) * 128 + ks * 16 + hi * 8);
      acc[d0] = __builtin_amdgcn_mfma_f32_32x32x16_bf16(af[ks], bfr, acc[d0], 0, 0, 0);
    }
#pragma unroll
  for (int d0 = 0; d0 < 4; ++d0) {
    const int dcol = g * 128 + d0 * 32 + r32; const float pb = pool_b[dcol], ps = pool_scale[dcol];
#pragma unroll
    for (int r = 0; r < 16; ++r) mix16[(size_t)(row0 + crow(r, hi)) * D + dcol] = (unsigned short)f2bf((acc[d0][r] + pb) * ps);
  }
}
#undef KSWZ
#undef SBAR
}
__device__ __forceinline__ float wave_sum(float v) {
#pragma unroll
    for (int o = 1; o < 64; o <<= 1) v += __shfl_xor(v, o);
    return v;
}
__device__ __forceinline__ float wave_max(float v) {
#pragma unroll
    for (int o = 1; o < 64; o <<= 1) v = fmaxf(v, __shfl_xor(v, o));
    return v;
}
__device__ __forceinline__ void p0_lam_rope(const float* __restrict__ dl, float* __restrict__ lam_out, float* __restrict__ rope, int gtid, int gthreads) {
    if (gtid == 0) {
        double s01 = 0, s23 = 0;
        for (int i = 0; i < 64; ++i) { s01 += (double)dl[i] * dl[64 + i]; s23 += (double)dl[128 + i] * dl[192 + i]; }
        lam_out[0] = (float)(exp(s01) - exp(s23) + 0.2);
    }
    for (int gid = gtid; gid < L * 32; gid += gthreads) {
        const int t = gid / 32, a = (gid / 16) & 1, i = gid & 15;
        const double pos = a == 0 ? (double)(t / 64) : (double)(t % 64);
        const double ang = pos * pow(10000.0, -(double)i / 16.0);
        rope[gid * 2 + 0] = (float)cos(ang);
        rope[gid * 2 + 1] = (float)sin(ang);
    }
}
__device__ __forceinline__ void p0_ada_unit(int unit, const float* __restrict__ ada_w, float* __restrict__ part, LAS float* sv, LAS float* red, int wave, int lane, int tid) {
    const int cc = unit % 48, ks = unit / 48;
    const int col = cc * 256 + lane * 4;
    f32x4 acc[5];
#pragma unroll
    for (int r = 0; r < 5; ++r) acc[r] = (f32x4){0.f, 0.f, 0.f, 0.f};
    const int k0 = ks * 128 + wave * 16;
#pragma unroll 4
    for (int kk = 0; kk < 16; ++kk) {
        const int k = k0 + kk;
        const f32x4 wv = *(const f32x4*)(ada_w + (size_t)k * (6 * D) + col);
#pragma unroll
        for (int r = 0; r < 5; ++r) acc[r] += wv * sv[r * D + k];
    }
#pragma unroll
    for (int r = 0; r < 5; ++r) *(LAS f32x4*)(red + (wave * 5 + r) * 256 + lane * 4) = acc[r];
    __syncthreads();
    for (int idx = tid; idx < 5 * 256; idx += NWAVES * 64) {
        float s = 0.f;
#pragma unroll
        for (int w = 0; w < 8; ++w) s += red[w * 1280 + idx];
        part[((size_t)ks * 5 + idx / 256) * (6 * D) + cc * 256 + (idx & 255)] = s;
    }
    __syncthreads();
}
__device__ __forceinline__ void p0_row_to_fp8(const float* __restrict__ src, unsigned char* __restrict__ dst, float* __restrict__ inv_scale, int lane) {
    f32x4 v[8];
#pragma unroll
    for (int j = 0; j < 4; ++j) { v[j] = *(const f32x4*)(src + lane * 16 + j * 4); v[4 + j] = *(const f32x4*)(src + 1024 + lane * 16 + j * 4); }
    float am = 0.f;
#pragma unroll
    for (int j = 0; j < 8; ++j) am = fmaxf(am, fmaxf(fmaxf(fabsf(v[j][0]), fabsf(v[j][1])), fmaxf(fabsf(v[j][2]), fabsf(v[j][3]))));
    am = wave_max(am);
    float s = 1.f;
    if (am > 0.f) s = exp2f(floorf(log2f(224.f / am)));
    if (lane == 0) *inv_scale = 1.0f / s;
    v4u o0, o1;
#define PK8(a, b) ({ int _w = 0; _w = __builtin_amdgcn_cvt_pk_fp8_f32((a)[0] * s, (a)[1] * s, _w, false); _w = __builtin_amdgcn_cvt_pk_fp8_f32((a)[2] * s, (a)[3] * s, _w, true); (unsigned)_w; })
    o0.x = PK8(v[0], 0); o0.y = PK8(v[1], 0); o0.z = PK8(v[2], 0); o0.w = PK8(v[3], 0);
    o1.x = PK8(v[4], 0); o1.y = PK8(v[5], 0); o1.z = PK8(v[6], 0); o1.w = PK8(v[7], 0);
#undef PK8
    *(v4u*)(dst + lane * 16) = o0;
    *(v4u*)(dst + 1024 + lane * 16) = o1;
}
__device__ __forceinline__ unsigned pack_i8x4(f32x4 v, float s) {
    const int a = (int)rintf(v[0] * s), b = (int)rintf(v[1] * s), c = (int)rintf(v[2] * s), d = (int)rintf(v[3] * s);
    return (unsigned)(a & 0xFF) | ((unsigned)(b & 0xFF) << 8) | ((unsigned)(c & 0xFF) << 16) | ((unsigned)d << 24);
}
__device__ __forceinline__ void p0_row_to_i8(const float* __restrict__ src, unsigned char* __restrict__ dst, float* __restrict__ inv_scale, int lane) {
    f32x4 v[8];
#pragma unroll
    for (int j = 0; j < 4; ++j) { v[j] = *(const f32x4*)(src + lane * 16 + j * 4); v[4 + j] = *(const f32x4*)(src + 1024 + lane * 16 + j * 4); }
    float am = 0.f;
#pragma unroll
    for (int j = 0; j < 8; ++j) am = fmaxf(am, fmaxf(fmaxf(fabsf(v[j][0]), fabsf(v[j][1])), fmaxf(fabsf(v[j][2]), fabsf(v[j][3]))));
    am = wave_max(am);
    const float s = am > 0.f ? 127.f / am : 0.f;
    if (lane == 0) *inv_scale = am * (1.0f / 127.f);
    v4u o0, o1;
    o0.x = pack_i8x4(v[0], s); o0.y = pack_i8x4(v[1], s); o0.z = pack_i8x4(v[2], s); o0.w = pack_i8x4(v[3], s);
    o1.x = pack_i8x4(v[4], s); o1.y = pack_i8x4(v[5], s); o1.z = pack_i8x4(v[6], s); o1.w = pack_i8x4(v[7], s);
    *(v4u*)(dst + lane * 16) = o0;
    *(v4u*)(dst + 1024 + lane * 16) = o1;
}
template <class LD4>
__device__ __forceinline__ void norm_row_bf16(const float* __restrict__ xr, const float* __restrict__ g, LD4 ldmod, bf16* __restrict__ orow, int lane, float rstd_in, bool have_rstd) {
    f32x4 v[8]; float ss = 0.f;
#pragma unroll
    for (int j = 0; j < 8; ++j) { v[j] = *(const f32x4*)(xr + lane * 4 + 256 * j); ss += (v[j][0] * v[j][0] + v[j][1] * v[j][1]) + (v[j][2] * v[j][2] + v[j][3] * v[j][3]); }
    float rstd = rstd_in;
    if (!have_rstd) rstd = 1.0f / sqrtf(wave_sum(ss) * (1.0f / D) + EPS);
#pragma unroll
    for (int j = 0; j < 8; ++j) {
        const int col = lane * 4 + 256 * j;
        const f32x4 gv = *(const f32x4*)(g + col);
        const f32x4 sh = ldmod(0, col), sc = ldmod(1, col);
        const f32x4 o = v[j] * rstd * gv * (sc + 1.0f) + sh;
        uint2 w; w.x = pk2(o[0], o[1]); w.y = pk2(o[2], o[3]);
        *(uint2*)(orow + col) = w;
    }
}
namespace peer {
using f32x16 = __attribute__((ext_vector_type(16))) float;
using f32x2 = __attribute__((ext_vector_type(2))) float;
__device__ __forceinline__ int crow(int r, int hi) { return (r & 3) + 8 * (r >> 2) + 4 * hi; }
__device__ __forceinline__ float med3(float a, float b, float c) { return __builtin_amdgcn_fmed3f(a, b, c); }
__device__ __forceinline__ void ins16(float (&l)[16], float x) {
#pragma unroll
    for (int i = 15; i >= 1; --i) l[i] = med3(l[i - 1], l[i], x);
    l[0] = fmaxf(l[0], x);
}
__device__ __forceinline__ void merge_pair(float (&l)[16]) {
    float c[16];
#pragma unroll
    for (int i = 0; i < 16; ++i) { const float o = __shfl_xor(l[15 - i], 32); c[i] = fmaxf(l[i], o); }
#pragma unroll
    for (int d = 8; d >= 1; d >>= 1)
#pragma unroll
        for (int i = 0; i < 16; ++i) if ((i & d) == 0) { const float a = c[i], b = c[i + d]; c[i] = fmaxf(a, b); c[i + d] = fminf(a, b); }
#pragma unroll
    for (int i = 0; i < 16; ++i) l[i] = c[i];
}
__device__ __forceinline__ void topk_unit(int t0, int h, const bf16* __restrict__ qp16, const bf16* __restrict__ keys16, const float* __restrict__ su, const float* __restrict__ sv,
                                          int* __restrict__ eidx, float* __restrict__ egsv, float* __restrict__ esu, LAS unsigned char* scr, int lane) {
    const int r32 = lane & 31, hi = lane >> 5;
    float la[16], lb[16];
#pragma unroll
    for (int p = 0; p < 2; ++p) {
        f32x16 acc[4] = {};
        const bf16* qrow = qp16 + (size_t)(t0 + r32) * D + h * 256 + p * 128 + hi * 8;
        const bf16* kbase = keys16 + ((size_t)(h * 2 + p) * PNK + r32) * 128 + hi * 8;
#pragma unroll 2
        for (int ks = 0; ks < 8; ++ks) {
            const bf16x8 qf = *(const bf16x8*)(qrow + ks * 16);
#pragma unroll
            for (int kb = 0; kb < 4; ++kb) {
                const bf16x8 kf = *(const bf16x8*)(kbase + (size_t)kb * 32 * 128 + ks * 16);
                acc[kb] = __builtin_amdgcn_mfma_f32_32x32x16_bf16(kf, qf, acc[kb], 0, 0, 0);
            }
        }
        float l[16];
#pragma unroll
        for (int i = 0; i < 16; ++i) l[i] = -INFINITY;
#pragma unroll
        for (int kb = 0; kb < 4; ++kb)
#pragma unroll
            for (int r = 0; r < 16; ++r) {
                const unsigned k = (unsigned)(32 * kb + crow(r, hi));
                const float x = __uint_as_float((__float_as_uint(acc[kb][r]) & ~0x7Fu) | k);
                ins16(l, x);
            }
        merge_pair(l);
        if (p == 0) {
#pragma unroll
            for (int i = 0; i < 16; ++i) la[i] = l[i];
        } else {
#pragma unroll
            for (int i = 0; i < 16; ++i) lb[i] = l[i];
        }
    }
    {
        unsigned w[4];
#pragma unroll
        for (int q = 0; q < 4; ++q) {
            unsigned x = 0;
#pragma unroll
            for (int e = 0; e < 4; ++e) { float va = la[4 * q + e], vb_ = lb[4 * q + e]; asm volatile("" : "+v"(va), "+v"(vb_)); const float v = hi ? vb_ : va; x |= (__float_as_uint(v) & 0x7Fu) << (8 * e); }
            w[q] = x;
        }
        *(LAS v4u*)(scr + r32 * 32 + hi * 16) = (v4u){w[0], w[1], w[2], w[3]};
    }
    float l[16];
#pragma unroll
    for (int i = 0; i < 16; ++i) l[i] = -INFINITY;
    {
        int n = 0; float pend = 0.f;
#pragma unroll
        for (int i = 0; i < 16; ++i)
#pragma unroll
            for (int j = 0; j < 16; ++j) if ((i + 1) * (j + 1) <= 16) {
                const float s = la[i] + lb[j];
                const float x = __uint_as_float((__float_as_uint(s) & ~0xFFu) | (unsigned)(i * 16 + j));
                if ((n & 1) == 0) pend = x; else ins16(l, hi ? x : pend);
                ++n;
            }
    }
    merge_pair(l);
    asm volatile("s_waitcnt lgkmcnt(0)" ::: "memory");
    float ex[16], sum = 0.f;
#pragma unroll
    for (int i = 0; i < 16; ++i) { ex[i] = __expf(l[i] - l[0]); sum += ex[i]; }
    const float inv = 1.0f / sum;
    const size_t ob = ((size_t)(t0 + r32) * PH + h) * PTOPK + hi * 8;
#pragma unroll
    for (int n = 0; n < 8; ++n) {
        float vlo = l[n], vhi = l[8 + n], elo = ex[n], ehi = ex[8 + n];
        asm volatile("" : "+v"(vlo), "+v"(vhi), "+v"(elo), "+v"(ehi));
        const float v = hi ? vhi : vlo;
        const float g = (hi ? ehi : elo) * inv;
        const unsigned c = __float_as_uint(v) & 0xFFu;
        const unsigned ia = scr[r32 * 32 + (c >> 4)], ib = scr[r32 * 32 + 16 + (c & 15)];
        const int e = (int)(ia * PNK + ib);
        eidx[ob + n] = e; egsv[ob + n] = g * sv[e]; esu[ob + n] = su[e];
    }
}

__device__ __forceinline__ f32x2 cvt8(unsigned w, bool hiw) { return hiw ? __builtin_amdgcn_cvt_pk_f32_fp8((int)w, true) : __builtin_amdgcn_cvt_pk_f32_fp8((int)w, false); }
__device__ __forceinline__ void peer_token(int t, const bf16* __restrict__ f16, const int* __restrict__ eidx, const float* __restrict__ egsv, const float* __restrict__ esu,
                                           const unsigned char* __restrict__ U8, const unsigned char* __restrict__ V8, const float* __restrict__ g2, const float* __restrict__ fg,
                                           const float* xin, float* xout, int lane) {
    f32x2 fr[16], acc[16];
    {
        const bf16* fp = f16 + (size_t)t * D + lane * 16;
        const v4u a0 = *(const v4u*)fp, a1 = *(const v4u*)(fp + 8), b0 = *(const v4u*)(fp + 1024), b1 = *(const v4u*)(fp + 1032);
        const unsigned w[16] = {a0.x, a0.y, a0.z, a0.w, a1.x, a1.y, a1.z, a1.w, b0.x, b0.y, b0.z, b0.w, b1.x, b1.y, b1.z, b1.w};
#pragma unroll
        for (int i = 0; i < 16; ++i) { fr[i] = (f32x2){__uint_as_float(w[i] << 16), __uint_as_float(w[i] & 0xFFFF0000u)}; acc[i] = (f32x2){0.f, 0.f}; }
    }
    const int e_a = eidx[(size_t)t * 128 + lane], e_b = eidx[(size_t)t * 128 + 64 + lane];
    const float g_a = egsv[(size_t)t * 128 + lane], g_b = egsv[(size_t)t * 128 + 64 + lane];
    const float s_a = esu[(size_t)t * 128 + lane], s_b = esu[(size_t)t * 128 + 64 + lane];
    const int k2 = lane >> 4;
    v4u ub[4][2], vb[4][2];
#define LOADROWS(buf, base, grp) do { _Pragma("unroll") for (int k = 0; k < 4; ++k) { \
        const int ee = (grp) < 16 ? __builtin_amdgcn_readlane(e_a, ((grp) & 15) * 4 + k) : __builtin_amdgcn_readlane(e_b, ((grp) & 15) * 4 + k); \
        const unsigned char* rp = (base) + (size_t)ee * D + lane * 16; buf[k][0] = *(const v4u*)rp; buf[k][1] = *(const v4u*)(rp + 1024); } } while (0)
    LOADROWS(ub, U8, 0); LOADROWS(vb, V8, 0);
#pragma unroll 1
    for (int grp = 0; grp < 32; ++grp) {
        float dt[4];
#pragma unroll
        for (int k = 0; k < 4; ++k) {
            f32x2 s = {0.f, 0.f};
#pragma unroll
            for (int hf = 0; hf < 2; ++hf) {
                const unsigned w[4] = {ub[k][hf].x, ub[k][hf].y, ub[k][hf].z, ub[k][hf].w};
#pragma unroll
                for (int q = 0; q < 4; ++q) { s += cvt8(w[q], false) * fr[hf * 8 + q * 2]; s += cvt8(w[q], true) * fr[hf * 8 + q * 2 + 1]; }
            }
            dt[k] = s[0] + s[1];
        }
        if (grp + 1 < 32) LOADROWS(ub, U8, grp + 1);
        {
            auto r0 = __builtin_amdgcn_permlane32_swap(__float_as_uint(dt[0]), __float_as_uint(dt[2]), false, false);
            auto r1 = __builtin_amdgcn_permlane32_swap(__float_as_uint(dt[1]), __float_as_uint(dt[3]), false, false);
            float x0 = __uint_as_float(r0[0]) + __uint_as_float(r0[1]);
            float x1 = __uint_as_float(r1[0]) + __uint_as_float(r1[1]);
            const bool b4 = (lane & 16) != 0;
            const float keep = b4 ? x1 : x0, send = b4 ? x0 : x1;
            float y = keep + __shfl_xor(send, 16);
            y += __shfl_xor(y, 8); y += __shfl_xor(y, 4); y += __shfl_xor(y, 2); y += __shfl_xor(y, 1);
            dt[0] = y;
        }
        const int ent = (grp & 15) * 4 + k2;
        const float gsv = grp < 16 ? __shfl(g_a, ent) : __shfl(g_b, ent);
        const float isu = grp < 16 ? __shfl(s_a, ent) : __shfl(s_b, ent);
        const float dv = dt[0] * isu;
        const float wgt = gsv * 0.5f * dv * (1.f + erff(dv * 0.70710678118654752f));
#pragma unroll
        for (int k = 0; k < 4; ++k) {
            const float wk = __uint_as_float(__builtin_amdgcn_readlane(__float_as_uint(wgt), 16 * k));
            const f32x2 wk2 = {wk, wk};
#pragma unroll
            for (int hf = 0; hf < 2; ++hf) {
                const unsigned w[4] = {vb[k][hf].x, vb[k][hf].y, vb[k][hf].z, vb[k][hf].w};
#pragma unroll
                for (int q = 0; q < 4; ++q) { acc[hf * 8 + q * 2] += cvt8(w[q], false) * wk2; acc[hf * 8 + q * 2 + 1] += cvt8(w[q], true) * wk2; }
            }
        }
        if (grp + 1 < 32) LOADROWS(vb, V8, grp + 1);
    }
#undef LOADROWS
    const float* xr = xin + (size_t)t * D + lane * 16; float* xw = xout + (size_t)t * D + lane * 16;
    const float* gr = g2 + lane * 16; const float* fgr = fg + lane * 16;
    f32x4 xv[8]; float ss = 0.f;
#pragma unroll
    for (int j = 0; j < 8; ++j) {
        const int off = (j >> 2) * 1024 + (j & 3) * 4;
        const f32x4 x1v = *(const f32x4*)(xr + off), gv = *(const f32x4*)(gr + off);
        const f32x4 pv = {acc[2 * j][0], acc[2 * j][1], acc[2 * j + 1][0], acc[2 * j + 1][1]};
        xv[j] = x1v + gv * pv;
        ss += (xv[j][0] * xv[j][0] + xv[j][1] * xv[j][1]) + (xv[j][2] * xv[j][2] + xv[j][3] * xv[j][3]);
    }
    ss = wave_sum(ss);
    const float rstd = 1.0f / sqrtf(ss * (1.0f / D) + EPS);
#pragma unroll
    for (int j = 0; j < 8; ++j) { const int off = (j >> 2) * 1024 + (j & 3) * 4; *(f32x4*)(xw + off) = xv[j] * rstd * *(const f32x4*)(fgr + off); }
}
}

#ifndef PEER_NSTU
#define PEER_NSTU 8
#endif
#ifndef PEER_NSTV
#define PEER_NSTV 8
#endif
namespace peer {
__device__ __forceinline__ void sort128(int (&key)[2], int lane) {
#pragma unroll
    for (int k = 2; k <= 128; k <<= 1) {
#pragma unroll
        for (int j = k >> 1; j > 0; j >>= 1) {
            if (j == 64) {
                const int a = key[0], b = key[1];
                key[0] = a < b ? a : b; key[1] = a < b ? b : a;
            } else {
                const bool lower = (lane & j) == 0;
#pragma unroll
                for (int r = 0; r < 2; ++r) {
                    const int i = r * 64 + lane;
                    const bool asc = (i & k) == 0;
                    const int o = __shfl_xor(key[r], j);
                    const int mn = key[r] < o ? key[r] : o, mx = key[r] < o ? o : key[r];
                    key[r] = (lower == asc) ? mn : mx;
                }
            }
        }
    }
}
__device__ __forceinline__ float dot16(const v4u u, const int (&f)[4]) {
    int s = __builtin_amdgcn_sdot4((int)u.x, f[0], 0, false);
    s = __builtin_amdgcn_sdot4((int)u.y, f[1], s, false);
    s = __builtin_amdgcn_sdot4((int)u.z, f[2], s, false);
    s = __builtin_amdgcn_sdot4((int)u.w, f[3], s, false);
    return (float)s;
}
__device__ __forceinline__ void quantf(int (&q)[4], const v4u a0, const v4u a1, float qs) {
    const unsigned w[8] = {a0.x, a0.y, a0.z, a0.w, a1.x, a1.y, a1.z, a1.w};
#pragma unroll
    for (int i = 0; i < 4; ++i) {
        const f32x4 v = {__uint_as_float(w[2 * i] << 16), __uint_as_float(w[2 * i] & 0xFFFF0000u), __uint_as_float(w[2 * i + 1] << 16), __uint_as_float(w[2 * i + 1] & 0xFFFF0000u)};
        q[i] = (int)pack_i8x4(v, qs);
    }
}
__device__ __forceinline__ float absmax16(const v4u a0, const v4u a1) {
    const unsigned w[8] = {a0.x, a0.y, a0.z, a0.w, a1.x, a1.y, a1.z, a1.w};
    float m = 0.f;
#pragma unroll
    for (int i = 0; i < 8; ++i) m = fmaxf(m, fmaxf(fabsf(__uint_as_float(w[i] << 16)), fabsf(__uint_as_float(w[i] & 0xFFFF0000u))));
    return m;
}
__device__ __forceinline__ void axpy16(f32x2 (&a)[8], const v4u v, float wk) {
    f32x2 wk2 = {wk, wk};
    const unsigned w[4] = {v.x, v.y, v.z, v.w};
#pragma unroll
    for (int q = 0; q < 4; ++q) {
        const f32x2 c0 = cvt8(w[q], false), c1 = cvt8(w[q], true);
        asm volatile("v_pk_fma_f32 %0, %1, %2, %0" : "+v"(a[q * 2]) : "v"(c0), "v"(wk2));
        asm volatile("v_pk_fma_f32 %0, %1, %2, %0" : "+v"(a[q * 2 + 1]) : "v"(c1), "v"(wk2));
    }
}
__device__ __forceinline__ void loadf8(f32x2 (&f)[8], const bf16* fp) {
    const v4u a0 = *(const v4u*)fp, a1 = *(const v4u*)(fp + 8);
    const unsigned w[8] = {a0.x, a0.y, a0.z, a0.w, a1.x, a1.y, a1.z, a1.w};
#pragma unroll
    for (int i = 0; i < 8; ++i) f[i] = (f32x2){__uint_as_float(w[i] << 16), __uint_as_float(w[i] & 0xFFFF0000u)};
}
#define RFL_I(x) __builtin_amdgcn_readfirstlane(x)
#define RFL_F(x) __uint_as_float(__builtin_amdgcn_readfirstlane(__float_as_uint(x)))

template <int H>
__device__ __forceinline__ void peer_usweep(const int (&f0)[4], const int (&f1)[4], const int (&f2)[4], const int (&f3)[4], float sfk, const unsigned char* __restrict__ U8,
                                            LAS int* skey, LAS float* sgs, LAS float* sis, LAS float* sw, int lane) {
    const unsigned char* ubase = U8 + H * 1024 + lane * 16;
    const int k2 = lane >> 4;
    constexpr int NST = PEER_NSTU;
    v4u ub[NST][4];
#define LOADU(S, I) do { _Pragma("unroll") for (int tk = 0; tk < 4; ++tk) { const int ee = RFL_I(skey[tk * 128 + (I)]) >> 7; ub[S][tk] = *(const v4u*)(ubase + (size_t)ee * D); } } while (0)
#pragma unroll
    for (int s = 0; s < NST - 1; ++s) LOADU(s, s);
#pragma unroll 1
    for (int i0 = 0; i0 < 128; i0 += NST) {
#pragma unroll
        for (int s = 0; s < NST; ++s) {
            const int i = i0 + s;
            if (i + NST - 1 < 128) LOADU((s + NST - 1) % NST, i + NST - 1);
            const float d0 = dot16(ub[s][0], f0), d1 = dot16(ub[s][1], f1), d2 = dot16(ub[s][2], f2), d3 = dot16(ub[s][3], f3);
            auto r0 = __builtin_amdgcn_permlane32_swap(__float_as_uint(d0), __float_as_uint(d2), false, false);
            auto r1 = __builtin_amdgcn_permlane32_swap(__float_as_uint(d1), __float_as_uint(d3), false, false);
            const float x0 = __uint_as_float(r0[0]) + __uint_as_float(r0[1]);
            const float x1 = __uint_as_float(r1[0]) + __uint_as_float(r1[1]);
            const bool b4 = (lane & 16) != 0;
            const float keep = b4 ? x1 : x0, send = b4 ? x0 : x1;
            float y = keep + __shfl_xor(send, 16);
            y += __shfl_xor(y, 8); y += __shfl_xor(y, 4); y += __shfl_xor(y, 2); y += __shfl_xor(y, 1);
            if (H == 0) { if ((lane & 15) == 0) sw[k2 * 128 + i] = y; }
            else {
                const float dv = (y + sw[k2 * 128 + i]) * (sis[k2 * 128 + i] * sfk);
                const float wgt = sgs[k2 * 128 + i] * 0.5f * dv * (1.f + erff(dv * 0.70710678118654752f));
                if ((lane & 15) == 0) sw[k2 * 128 + i] = wgt;
            }
        }
    }
#undef LOADU
}
template <int H>
__device__ __forceinline__ void peer_vsweep(const unsigned char* __restrict__ V8, LAS int* skey, LAS float* sw, f32x2 (&a0)[8], f32x2 (&a1)[8], f32x2 (&a2)[8], f32x2 (&a3)[8], int lane) {
    const unsigned char* vbase = V8 + H * 1024 + lane * 16;
    constexpr int NST = PEER_NSTV;
    v4u vb[NST][4];
#define LOADV(S, I) do { _Pragma("unroll") for (int tk = 0; tk < 4; ++tk) { const int ee = RFL_I(skey[tk * 128 + (I)]) >> 7; vb[S][tk] = *(const v4u*)(vbase + (size_t)ee * D); } } while (0)
#pragma unroll
    for (int s = 0; s < NST - 1; ++s) LOADV(s, s);
#pragma unroll 1
    for (int i0 = 0; i0 < 128; i0 += NST) {
#pragma unroll
        for (int s = 0; s < NST; ++s) {
            const int i = i0 + s;
            if (i + NST - 1 < 128) LOADV((s + NST - 1) % NST, i + NST - 1);
            axpy16(a0, vb[s][0], RFL_F(sw[0 * 128 + i])); axpy16(a1, vb[s][1], RFL_F(sw[1 * 128 + i]));
            axpy16(a2, vb[s][2], RFL_F(sw[2 * 128 + i])); axpy16(a3, vb[s][3], RFL_F(sw[3 * 128 + i]));
        }
    }
#undef LOADV
}
__device__ __forceinline__ float peer_x2(f32x2 (&a)[8], const GAS float* xr, const GAS float* gr) {
    float ss = 0.f;
#pragma unroll
    for (int j = 0; j < 4; ++j) {
        const f32x4 x1v = *(const GAS f32x4*)(xr + j * 4), gv = *(const GAS f32x4*)(gr + j * 4);
        const f32x4 pv = {a[2 * j][0], a[2 * j][1], a[2 * j + 1][0], a[2 * j + 1][1]};
        const f32x4 o = x1v + gv * pv;
        a[2 * j] = (f32x2){o[0], o[1]}; a[2 * j + 1] = (f32x2){o[2], o[3]};
        ss += (o[0] * o[0] + o[1] * o[1]) + (o[2] * o[2] + o[3] * o[3]);
    }
    return ss;
}
__device__ __forceinline__ void peer_store_raw(const f32x2 (&a)[8], float* __restrict__ xw) {
#pragma unroll
    for (int j = 0; j < 4; ++j) { const f32x4 o = {a[2 * j][0], a[2 * j][1], a[2 * j + 1][0], a[2 * j + 1][1]}; *(f32x4*)(xw + j * 4) = o; }
}
__device__ __forceinline__ void peer_rescale(float rstd, const GAS float* fgr, float* xw_) {
    GAS float* xw = (GAS float*)xw_; asm volatile("" : "+v"(xw));
#pragma unroll
    for (int j = 0; j < 4; ++j) { const f32x4 o = *(const GAS f32x4*)(xw + j * 4); *(GAS f32x4*)(xw + j * 4) = o * rstd * *(const GAS f32x4*)(fgr + j * 4); }
}
__device__ __forceinline__ void peer_store(const f32x2 (&a)[8], float rstd, const GAS float* fgr, float* __restrict__ xw) {
#pragma unroll
    for (int j = 0; j < 4; ++j) { const f32x4 o = {a[2 * j][0], a[2 * j][1], a[2 * j + 1][0], a[2 * j + 1][1]}; *(f32x4*)(xw + j * 4) = o * rstd * *(const GAS f32x4*)(fgr + j * 4); }
}

__device__ __forceinline__ void peer_wave4(int t0, const bf16* __restrict__ f16, const int* __restrict__ eidx, const float* __restrict__ egsv, const float* __restrict__ esu,
                                           const unsigned char* __restrict__ U8, const unsigned char* __restrict__ V8, const float* __restrict__ g2, const float* __restrict__ fg,
                                           const float* xin, float* xout, LAS unsigned* lw, int lane) {
    LAS int* skey = (LAS int*)lw; LAS float* sgs = (LAS float*)(lw + 512); LAS float* sis = (LAS float*)(lw + 1024); LAS float* sw = (LAS float*)(lw + 1536);
#pragma unroll 1
    for (int tk = 0; tk < 4; ++tk) {
        const size_t eb = (size_t)(t0 + tk) * 128;
        int key[2];
        key[0] = (eidx[eb + lane] << 7) | lane; key[1] = (eidx[eb + 64 + lane] << 7) | (64 + lane);
        sort128(key, lane);
#pragma unroll
        for (int r = 0; r < 2; ++r) { const int n = key[r] & 127, i = tk * 128 + r * 64 + lane; skey[i] = key[r]; sgs[i] = egsv[eb + n]; sis[i] = esu[eb + n]; }
    }
    __builtin_amdgcn_sched_barrier(0);
    {
        int fl0[4], fl1[4], fl2[4], fl3[4], fh0[4], fh1[4], fh2[4], fh3[4]; float sfk = 0.f;
#define QUANTF(TK, FL, FH) do { const bf16* fp_ = f16 + (size_t)(t0 + TK) * D + lane * 16; \
        const v4u a0_ = *(const v4u*)fp_, a1_ = *(const v4u*)(fp_ + 8), b0_ = *(const v4u*)(fp_ + 1024), b1_ = *(const v4u*)(fp_ + 1032); \
        const float am_ = wave_max(fmaxf(absmax16(a0_, a1_), absmax16(b0_, b1_))); const float qs_ = am_ > 0.f ? 127.f / am_ : 0.f; \
        quantf(FL, a0_, a1_, qs_); quantf(FH, b0_, b1_, qs_); if ((lane >> 4) == TK) sfk = am_ * (1.0f / 127.f); } while (0)
        QUANTF(0, fl0, fh0); QUANTF(1, fl1, fh1); QUANTF(2, fl2, fh2); QUANTF(3, fl3, fh3);
#undef QUANTF
        __builtin_amdgcn_sched_barrier(0);
        peer_usweep<0>(fl0, fl1, fl2, fl3, sfk, U8, skey, sgs, sis, sw, lane);
        __builtin_amdgcn_sched_barrier(0);
        peer_usweep<1>(fh0, fh1, fh2, fh3, sfk, U8, skey, sgs, sis, sw, lane);
    }
    __builtin_amdgcn_sched_barrier(0);
    const GAS float* gr = (const GAS float*)g2 + lane * 16; const GAS float* fgr = (const GAS float*)fg + lane * 16; const GAS float* xin_ = (const GAS float*)xin; GAS float* xout_ = (GAS float*)xout;
    float ss0, ss1, ss2, ss3;
    {
        f32x2 lo0[8], lo1[8], lo2[8], lo3[8];
#pragma unroll
        for (int i = 0; i < 8; ++i) { lo0[i] = (f32x2){0.f, 0.f}; lo1[i] = lo0[i]; lo2[i] = lo0[i]; lo3[i] = lo0[i]; }
        peer_vsweep<0>(V8, skey, sw, lo0, lo1, lo2, lo3, lane);
        __builtin_amdgcn_sched_barrier(0);
        asm volatile("" : "+v"(gr), "+v"(fgr), "+v"(xin_), "+v"(xout_));
#define LOWER(TK, LO, SS) do { const GAS float* xr = xin_ + (size_t)(t0 + TK) * D + lane * 16; float* xw = (float*)(xout_ + (size_t)(t0 + TK) * D + lane * 16); SS = peer_x2(LO, xr, gr); asm volatile("" : "+v"(SS)); peer_store_raw(LO, xw); } while (0)
        LOWER(0, lo0, ss0); LOWER(1, lo1, ss1); LOWER(2, lo2, ss2); LOWER(3, lo3, ss3);
#undef LOWER
    }
    __builtin_amdgcn_sched_barrier(0);
    {
        f32x2 hi0[8], hi1[8], hi2[8], hi3[8];
#pragma unroll
        for (int i = 0; i < 8; ++i) { hi0[i] = (f32x2){0.f, 0.f}; hi1[i] = hi0[i]; hi2[i] = hi0[i]; hi3[i] = hi0[i]; }
        peer_vsweep<1>(V8, skey, sw, hi0, hi1, hi2, hi3, lane);
        __builtin_amdgcn_sched_barrier(0);
        asm volatile("" : "+v"(gr), "+v"(fgr), "+v"(xin_), "+v"(xout_));
#define UPPER(TK, HI, SS) do { const GAS float* xr = xin_ + (size_t)(t0 + TK) * D + lane * 16; float* xw = (float*)(xout_ + (size_t)(t0 + TK) * D + lane * 16); \
        float ss = SS + peer_x2(HI, xr + 1024, gr + 1024); ss = wave_sum(ss); const float rstd = 1.0f / sqrtf(ss * (1.0f / D) + EPS); \
        peer_store(HI, rstd, fgr + 1024, xw + 1024); asm volatile("s_waitcnt vmcnt(0)" ::: "memory"); peer_rescale(rstd, fgr, xw); } while (0)
        UPPER(0, hi0, ss0); UPPER(1, hi1, ss1); UPPER(2, hi2, ss2); UPPER(3, hi3, ss3);
#undef UPPER
    }
}
}
__device__ __forceinline__ void p0_transpose_item(const float* W, int K, int N, bf16* WT, int row_off, LAS float* scr, int item, int lane) {
    const int nblk = N / 32, kb = item / nblk, nb = item % nblk, k0 = 64 * kb, n0 = 32 * nb;
#pragma unroll 8
    for (int i = 0; i < 32; ++i) { const int kk = 2 * i + (lane >> 5); scr[kk * 33 + (lane & 31)] = W[(size_t)(k0 + kk) * N + n0 + (lane & 31)]; }
    LDS_WAIT(); asm volatile("" ::: "memory");
    const int c = lane & 7;
#pragma unroll
    for (int j = 0; j < 4; ++j) { const int n = (lane >> 3) + 8 * j; const LAS float* s = scr + (8 * c) * 33 + n;
        v4u o; o.x = pk2(s[0 * 33], s[1 * 33]); o.y = pk2(s[2 * 33], s[3 * 33]); o.z = pk2(s[4 * 33], s[5 * 33]); o.w = pk2(s[6 * 33], s[7 * 33]);
        *(GAS v4u*)(WT + (size_t)(row_off + n0 + n) * K + k0 + 8 * c) = o; }
    LDS_WAIT(); asm volatile("" ::: "memory");
}

struct Args { const float* in[20]; float* out; unsigned char* ws; int ph_lo, ph_hi, li, pad; };
__device__ __forceinline__ const float* karg_ptr(int off) {
    const __attribute__((address_space(4))) char* kp = (const __attribute__((address_space(4))) char*)__builtin_amdgcn_kernarg_segment_ptr();
    asm volatile("" : "+s"(off));
    return *(const float* const __attribute__((address_space(4)))*)(kp + off);
}

__global__ void __launch_bounds__(NWAVES * 64, 2) mega(Args args) {
    extern __shared__ __attribute__((aligned(16))) unsigned char lds[];
    LAS unsigned char* ldsl = (LAS unsigned char*)lds;
    volatile LAS unsigned* MISC = (volatile LAS unsigned*)(ldsl + MISC_OFF);
    const int G = gridDim.x;
#define PHASE_IDS() int tid = threadIdx.x; asm volatile("" : "+v"(tid)); const int lane = tid & 63, wave = __builtin_amdgcn_readfirstlane(tid >> 6); \
    const int gw = blockIdx.x * NWAVES + wave, NGW = G * NWAVES, gtid = blockIdx.x * (NWAVES * 64) + tid, gthreads = G * NWAVES * 64; (void)lane; (void)gw; (void)NGW; (void)gtid; (void)gthreads
    unsigned char* ws = args.ws;
    gu32* ctl = (gu32*)(ws + WS_CTL);
    for (int u = threadIdx.x; u < (LDS_BYTES - LDSCTL_OFF) / 4; u += NWAVES * 64) ((LAS unsigned*)(ldsl + LDSCTL_OFF))[u] = 0u;
    __syncthreads();
    XcdBarrier bar = xcd_barrier_post((unsigned*)(ctl + CW_BAR) + args.li * XCD_BAR_WORDS, MISC + 8);
    const int lo = args.ph_lo, hi = args.ph_hi;
#define IN(k) (lo <= (k) && (k) < hi)
#ifndef PROBE_MASK
#define PROBE_MASK 0
#endif
#define PROBE_REP(k) ((((PROBE_MASK) >> (k)) & 1) ? 2 : 1)
#define SEAM(k) do { if (IN(k) && (k) + 1 < hi) xcd_barrier(bar); } while (0)

#define ARGP(i) karg_ptr((i) * 8)
#define ARG_OUT ((float*)karg_ptr(160))
#define Wt_in ((bf16*)(ws + WS_WIN))
#define Wt_out ((bf16*)(ws + WS_WOUT))
#define Wt_q ((bf16*)(ws + WS_WQ))
#define pwT16 ((bf16*)(ws + WS_PWT16))
#define mod ((float*)(ws + WS_MOD))
#define rope ((float*)(ws + WS_ROPE))
#define adap ((float*)(ws + WS_ADAP))
#define ssq ((float*)(ws + WS_SSQ))

    if (IN(0)) for (int rp = 0; rp < PROBE_REP(0); ++rp) { if (rp) xcd_barrier(bar);
        PHASE_IDS();
        LAS float* scr = (LAS float*)(ldsl + RING_OFF + wave * 16384);
        const float* w_in = ARGP(7); const float* w_out = ARGP(13); const float* peer_wq = ARGP(15); const float* pool_w = ARGP(8);
        constexpr int I_IN = (D / 64) * (INW / 32), I_O = (D / 64) * (D / 32);
        for (int it = gw; it < I_IN + 2 * I_O + 32; it += NGW) {
            int r = it;
            if (r < I_IN) { p0_transpose_item(w_in, D, INW, Wt_in, 0, scr, r, lane); continue; } r -= I_IN;
            if (r < I_O) { p0_transpose_item(w_out, D, D, Wt_out, 0, scr, r, lane); continue; } r -= I_O;
            if (r < I_O) { p0_transpose_item(peer_wq, D, D, Wt_q, 0, scr, r, lane); continue; } r -= I_O;
            p0_transpose_item(pool_w + (size_t)(r >> 3) * 16384, 128, 128, pwT16 + (size_t)(r >> 3) * 16384, 0, scr, r & 7, lane);
        }
        { const float* keys = ARGP(16); bf16* keys16 = (bf16*)(ws + WS_KEYS16);
          for (int i = gtid; i < 2 * PH * PNK * 128 / 4; i += gthreads) { const f32x4 v = *(const f32x4*)(keys + (size_t)i * 4); uint2 o; o.x = pk2(v[0], v[1]); o.y = pk2(v[2], v[3]); *(uint2*)(keys16 + (size_t)i * 4) = o; } }
        p0_lam_rope(ARGP(11), (float*)(ws + WS_LAM), rope, gtid, gthreads);
        __syncthreads();
        { LAS float* sv = (LAS float*)(ldsl + RING_OFF); LAS float* red = sv + 5 * D;
          const float* cvec = ARGP(1); const float* cctx = ARGP(3); const float* ada_w = ARGP(4);
          for (int i = tid; i < 5 * D; i += NWAVES * 64) { const int r = i / D, k = i % D; const float xv = r < 4 ? cvec[r * D + k] : cctx[k]; sv[i] = xv / (1.f + expf(-xv)); }
          __syncthreads();
          for (int unit = blockIdx.x; unit < 768; unit += G) p0_ada_unit(unit, ada_w, adap, sv, red, wave, lane, tid); }
        { const float* pu = ARGP(17); const float* pv = ARGP(18);
          unsigned char* U8 = ws + WS_U8; unsigned char* V8 = ws + WS_V8; float* su = (float*)(ws + WS_SU); float* svs = (float*)(ws + WS_SV);
          for (int row = gw; row < 2 * NEXP; row += NGW) {
              if (row < NEXP) p0_row_to_i8(pu + (size_t)row * D, U8 + (size_t)row * D, su + row, lane);
              else p0_row_to_fp8(pv + (size_t)(row - NEXP) * D, V8 + (size_t)(row - NEXP) * D, svs + (row - NEXP), lane);
          } }
    }
    SEAM(0);
    if (IN(1)) for (int rp = 0; rp < PROBE_REP(1); ++rp) { if (rp) xcd_barrier(bar);
        PHASE_IDS();
        const float* ada_b = ARGP(5); const float* norm1_g = ARGP(6); const float* ctxp = ARGP(2); const float* x = ARGP(0);
        bf16* h16 = (bf16*)(ws + WS_H16);
        if (tid < 240) { const int idx = blockIdx.x * 240 + tid; const int r = idx / (6 * D), col = idx % (6 * D);
            float s = ada_b[col];
#pragma unroll
            for (int ks = 0; ks < 16; ++ks) s += adap[((size_t)ks * 5 + r) * (6 * D) + col];
            mod[(size_t)r * (6 * D) + col] = s; }
        LAS float* modl = (LAS float*)(ldsl + RING_OFF);
        const int bb = blockIdx.x >> 6;
        for (int i = tid; i < 8192; i += NWAVES * 64) { const int r = i < 4096 ? bb : 4, col = i & 4095;
            float s = ada_b[col];
#pragma unroll
            for (int ks = 0; ks < 16; ++ks) s += adap[((size_t)ks * 5 + r) * (6 * D) + col];
            modl[i] = s; }
        __syncthreads();
#pragma unroll 1
        for (int j = 0; j < 4; ++j) { const int row = blockIdx.x * 32 + wave * 4 + j;
            norm_row_bf16(x + (size_t)row * D, norm1_g, [=](int which, int col) { return *(const LAS f32x4*)(modl + which * 2048 + col); }, h16 + (size_t)row * D, lane, 0.f, false); }
        if (wave < 4) { const int r = blockIdx.x * 4 + wave;
            norm_row_bf16(ctxp + (size_t)r * D, norm1_g, [=](int which, int col) { return *(const LAS f32x4*)(modl + 4096 + which * 2048 + col); }, h16 + (size_t)(NLAT + r) * D, lane, 0.f, false); }
    }
    SEAM(1);
    if (IN(2)) for (int rp = 0; rp < PROBE_REP(2); ++rp) { if (rp) xcd_barrier(bar);
        pg8::Gemm g{(const bf16*)(ws + WS_H16), Wt_in, NTOK, INW, D};
        pg8::InProjOrder S; S.init(G, (int)blockIdx.x);
        pg8::EpiInProj E{(bf16*)(ws + WS_ZP16), (bf16*)(ws + WS_Q16), (bf16*)(ws + WS_K16), (bf16*)(ws + WS_V16), rope};
        pg8::gemm_phase<pg8::EpiInProj, pg8::InProjOrder, true, true>(ldsl + RING_OFF, g, S, E);
    }
    SEAM(2);
    if (IN(3)) for (int rp = 0; rp < PROBE_REP(3); ++rp) { if (rp) xcd_barrier(bar);
        PHASE_IDS();
        bf16* mix16 = (bf16*)(ws + WS_MIX16);
        const float* pool_b = ARGP(9); const float* pool_scale = ARGP(10); const float* subln_g = ARGP(12);
        if (wave < 4) for (int tile = blockIdx.x; tile < NLAT / 32; tile += G) att::pool_item(tile, wave, (const bf16*)(ws + WS_ZP16), pwT16, pool_b, pool_scale, mix16, lane);
        const float lam = *(const float*)(ws + WS_LAM);
        for (int u = blockIdx.x; u < 768; u += G) {
            int bh, qb;
            if (G == 256) { const int i = u >> 8, c = u & 255, xcd = c & 7, j = c >> 3; bh = i * 16 + xcd * 2 + (j >> 4); qb = j & 15; }
            else { bh = u >> 4; qb = u & 15; }
            att::attn_unit(bh / NH, bh % NH, qb, (const bf16*)(ws + WS_Q16), (const bf16*)(ws + WS_K16), (const bf16*)(ws + WS_V16), mix16, lam, subln_g, (char*)lds + RING_OFF);
        }
    }
    SEAM(3);
    if (IN(4)) for (int rp = 0; rp < PROBE_REP(4); ++rp) { if (rp) xcd_barrier(bar);
        pg8::Gemm g{(const bf16*)(ws + WS_MIX16), Wt_out, NLAT, D, D};
        pg8::StaticOrder S; S.init(NLAT, D, G, (int)blockIdx.x);
        pg8::EpiOutProj E{ARGP(0), mod, ARG_OUT, (float*)(ws + WS_SSQ)};
        pg8::gemm_phase<pg8::EpiOutProj, pg8::StaticOrder, true, true>(ldsl + RING_OFF, g, S, E);
    }
    SEAM(4);
    if (IN(5)) for (int rp = 0; rp < PROBE_REP(5); ++rp) { if (rp) xcd_barrier(bar);
        PHASE_IDS();
        const float* norm2_g = ARGP(14); float* xo = ARG_OUT; bf16* f16 = (bf16*)(ws + WS_F16);
        const float* sh2 = mod + (size_t)(blockIdx.x >> 6) * (6 * D) + 3 * D; const float* sc2 = sh2 + D;
#pragma unroll 1
        for (int j = 0; j < 4; ++j) { const int row = blockIdx.x * 32 + wave * 4 + j;
            const float p = lane < 32 ? ssq[(size_t)row * 32 + lane] : 0.f;
            const float rstd = 1.0f / sqrtf(wave_sum(p) * (1.0f / D) + EPS);
            norm_row_bf16(xo + (size_t)row * D, norm2_g, [=](int which, int col) { return *(const f32x4*)((which ? sc2 : sh2) + col); }, f16 + (size_t)row * D, lane, rstd, true); }
    }
    SEAM(5);
    if (IN(6)) for (int rp = 0; rp < PROBE_REP(6); ++rp) { if (rp) xcd_barrier(bar);
        pg8::Gemm g{(const bf16*)(ws + WS_F16), Wt_q, NLAT, D, D};
        pg8::StaticOrder S; S.init(NLAT, D, G, (int)blockIdx.x);
        pg8::EpiBf16Plain E{(bf16*)(ws + WS_QP16), D};
        pg8::gemm_phase<pg8::EpiBf16Plain, pg8::StaticOrder, true, true>(ldsl + RING_OFF, g, S, E);
    }
    SEAM(6);
    if (IN(7)) for (int rp = 0; rp < PROBE_REP(7); ++rp) { if (rp) xcd_barrier(bar);
        PHASE_IDS();
        for (int unit = gw; unit < (NLAT / 32) * PH; unit += NGW)
            peer::topk_unit((unit >> 3) * 32, unit & 7, (const bf16*)(ws + WS_QP16), (const bf16*)(ws + WS_KEYS16), (const float*)(ws + WS_SU), (const float*)(ws + WS_SV),
                            (int*)(ws + WS_EIDX), (float*)(ws + WS_EGATE), (float*)(ws + WS_ESU), ldsl + RING_OFF + wave * 1024, lane);
    }
    if (IN(7) && 8 < hi) { asm volatile("s_waitcnt vmcnt(0)" ::: "memory"); __syncthreads();
        if (threadIdx.x == 0) { __builtin_amdgcn_fence(__ATOMIC_ACQUIRE, "agent"); asm volatile("s_waitcnt vmcnt(0)" ::: "memory"); }
        __syncthreads(); }
    if (IN(8)) for (int rp = 0; rp < PROBE_REP(8); ++rp) { if (rp) xcd_barrier(bar);
        PHASE_IDS();
        const float* fgp = ARGP(19); float* xo = ARG_OUT; float* xo2 = args.pad ? (float*)(ws + WS_ZF) : xo;
        { const int t0 = gw * 4;
          if (t0 < NLAT) peer::peer_wave4(t0, (const bf16*)(ws + WS_F16), (const int*)(ws + WS_EIDX), (const float*)(ws + WS_EGATE), (const float*)(ws + WS_ESU),
                             ws + WS_U8, ws + WS_V8, mod + (size_t)(t0 >> 11) * (6 * D) + 5 * D, fgp, xo, xo2, (LAS unsigned*)(ldsl + RING_OFF + wave * 8192), lane); }
    }
#undef IN
#undef SEAM
#undef mod
#undef rope
#undef adap
#undef ssq
#undef Wt_in
#undef Wt_out
#undef Wt_q
#undef pwT16
}
extern "C" void kernel_launch(void* const* d_in, const int* in_sizes, int n_in, void* d_out, int out_size, void* d_ws, size_t ws_size, hipStream_t stream) {
    static int grid = 0;
    if (grid == 0) {
        if (n_in != 20 || out_size != NLAT * D || ws_size < WS_END) { fprintf(stderr, "kernel_launch: unexpected shapes (n_in %d out %d ws %zu)\n", n_in, out_size, ws_size); grid = -1; return; }
        int dev = 0, cus = 0, per_cu = 0;
        if (hipGetDevice(&dev) != hipSuccess || hipDeviceGetAttribute(&cus, hipDeviceAttributeMultiprocessorCount, dev) != hipSuccess) { grid = -1; return; }
        if (hipFuncSetAttribute((const void*)mega, hipFuncAttributeMaxDynamicSharedMemorySize, LDS_BYTES) != hipSuccess) { fprintf(stderr, "kernel_launch: hipFuncSetAttribute failed\n"); grid = -1; return; }
        if (hipOccupancyMaxActiveBlocksPerMultiprocessor(&per_cu, (const void*)mega, NWAVES * 64, LDS_BYTES) != hipSuccess || per_cu < 1) { fprintf(stderr, "kernel_launch: occupancy query says %d blocks per CU\n", per_cu); grid = -1; (void)hipGetLastError(); return; }
        (void)hipGetLastError();
        if (cus < 256) { fprintf(stderr, "kernel_launch: needs 256 CUs, device has %d\n", cus); grid = -1; return; }
        grid = 256;
    }
    if (grid < 0) return;
    unsigned char* ws = (unsigned char*)d_ws;
    (void)hipMemsetAsync(ws + WS_CTL, 0, CTL_ZERO_BYTES, stream);
    Args a{};
    for (int i = 0; i < 20; ++i) a.in[i] = (const float*)d_in[i];
    a.out = (float*)d_out; a.ws = ws;
#ifndef PROBE_PHASE
    a.ph_lo = 0; a.ph_hi = 9; a.li = 0;
    hipLaunchKernelGGL(mega, dim3(grid), dim3(NWAVES * 64), LDS_BYTES, stream, a);
#else
    if (PROBE_PHASE > 0) { a.ph_lo = 0; a.ph_hi = PROBE_PHASE; a.li = 0; hipLaunchKernelGGL(mega, dim3(grid), dim3(NWAVES * 64), LDS_BYTES, stream, a); }
    for (int r = 0; r < PROBE_TIMES; ++r) { a.ph_lo = PROBE_PHASE; a.ph_hi = PROBE_PHASE + 1; a.li = 1; a.pad = (PROBE_PHASE == 8 && r + 1 < PROBE_TIMES) ? 1 : 0;
        hipLaunchKernelGGL(mega, dim3(grid), dim3(NWAVES * 64), LDS_BYTES, stream, a); }
    a.pad = 0;
    if (PROBE_PHASE < 8) { a.ph_lo = PROBE_PHASE + 1; a.ph_hi = 9; a.li = 2; hipLaunchKernelGGL(mega, dim3(grid), dim3(NWAVES * 64), LDS_BYTES, stream, a); }
#endif
}
```

```cpp
#include <hip/hip_runtime.h>
#include <math.h>
#include <stdint.h>
#include <cstdio>

constexpr int D = 2048, NB = 4, L = 2048, CT = 256;
constexpr int NLAT = NB * L;
constexpr int NCTX = NB * CT;
constexpr int NTOK = NLAT + NCTX;
constexpr int INW = 5120, POOLW = 512, ATTW = 1536, NH = 12, DV = 128, DQK = 64;
constexpr int QOFF = POOLW, KOFF = POOLW + ATTW, VOFF = POOLW + 2 * ATTW;
constexpr int LK = CT + L;
constexpr int PH = 8, PNK = 128, PTOPK = 16, NEXP = PNK * PNK;
constexpr float EPS = 1e-6f;
namespace pg8 {
#define PG8_LAS __attribute__((address_space(3)))
typedef unsigned short bf16_t;
typedef short bf16x8 __attribute__((ext_vector_type(8)));
typedef float f32x4 __attribute__((ext_vector_type(4)));
typedef unsigned u32x4 __attribute__((ext_vector_type(4)));
constexpr int BM = 256, BK = 64, HALF = 128, HTB = HALF * BK * 2  , STAGE_BYTES = 8 * HTB, NXCD = 8, WGM = 8;

__host__ __device__ __forceinline__ int lds_byte(int r, int c) { const int st = (r >> 4) * 2 + (c >> 5), rr = r & 15, cc = c & 31, ob = rr * 64 + cc * 2; return st * 1024 + (ob ^ (((ob >> 9) & 1) << 5)); }
__host__ __device__ __forceinline__ void stage_rc(int b, int& R, int& C) { const int st = b / 1024, sb = b % 1024, swz = sb ^ (((sb >> 9) & 1) << 5); R = (st >> 1) * 16 + swz / 64; C = (st & 1) * 32 + (swz % 64) / 2; }
__host__ __device__ __forceinline__ int perm32(int rho) { const int n = rho >> 4, i = rho & 15; return 8 * (i >> 2) + 4 * n + (i & 3); }

struct Unit { int pm, pn; };
struct Gemm { const bf16_t* A; const bf16_t* Bt; int M, N, K; };

struct StaticOrder {
    int nM, nN, nwg, G, c;
    __host__ __device__ void init(int M, int N, int G_, int c_) { nM = M / BM; nN = N / BM; nwg = nM * nN; G = G_; c = c_; }
    __host__ __device__ bool next(int i, Unit& u) const {
        const long L = (long)i * G + c; if (L >= nwg) return false;
        int wgid = (int)L; { const int q = nwg / NXCD, r = nwg % NXCD, xcd = wgid % NXCD, off = wgid / NXCD; wgid = (xcd < r ? xcd * (q + 1) : r * (q + 1) + (xcd - r) * q) + off; }
        const int nig = WGM * nN, gid = wgid / nig, fm = gid * WGM, gsz = (nM - fm) < WGM ? (nM - fm) : WGM;
        u.pm = fm + ((wgid % nig) % gsz); u.pn = (wgid % nig) / gsz; return true;
    }
    __device__ __forceinline__ void a_ready(const Unit&) const {}
    __device__ __forceinline__ void done(const Unit&) const {}
};

__device__ __forceinline__ unsigned cvt_pk_bf16(float lo, float hi) { unsigned r; asm volatile("v_cvt_pk_bf16_f32 %0, %1, %2" : "=v"(r) : "v"(lo), "v"(hi)); return r; }
typedef unsigned u32x2 __attribute__((ext_vector_type(2)));
__device__ __forceinline__ void st8_wt(void* p, u32x2 v) {
    __hip_atomic_store((__attribute__((address_space(1))) unsigned long long*)p, ((unsigned long long)v.y << 32) | v.x, __ATOMIC_RELAXED, __HIP_MEMORY_SCOPE_AGENT);
}

struct InProjOrder {
    StaticOrder lat; int G, c;
    __device__ void init(int G_, int c_) { lat.init(8192, 5120, G_, c_); G = G_; c = c_; }
    __device__ bool next(int i, Unit& u) const {
        const int Lx = i * G + c;
        if (Lx < 640) return lat.next(i, u);
        const int j = Lx - 640; if (j >= 48) return false;
        u.pm = 32 + j / 12; u.pn = 8 + j % 12; return true;
    }
    __device__ __forceinline__ void a_ready(const Unit&) const {}
    __device__ __forceinline__ void done(const Unit&) const {}
};

struct EpiInProj {
    static constexpr bool PERM = false, AFTER_DRAIN = false;
    bf16_t *ZP, *Q, *Kb, *Vb; const float* rope;
    __device__ __forceinline__ void operator()(const f32x4 (&acc)[2][2][4][2], const Unit& u, int wr, int wc, int fr, int fq) const {
        const bool isctx = u.pm >= 32;
        const int kind = u.pn < 2 ? 0 : (u.pn < 8 ? 1 : (u.pn < 14 ? 2 : 3));
        const int pnl = kind == 0 ? u.pn : (kind == 1 ? u.pn - 2 : (kind == 2 ? u.pn - 8 : u.pn - 14));
        const int colt = pnl * 256 + wc * 32 + 4 * fq;
        bf16_t* dst = kind == 0 ? ZP : (kind == 1 ? Q : (kind == 2 ? Kb : Vb));
        const int ld = kind == 0 ? 512 : 1536;
        const bool dorope = (kind == 1 || kind == 2) && !isctx;
        const int ax = wc & 1;
#pragma unroll
        for (int ai = 0; ai < 2; ++ai)
#pragma unroll
            for (int m = 0; m < 4; ++m) {
                const int rl = ai * 128 + wr * 64 + m * 16 + fr;
                int orow, t = 0;
                if (!isctx) { const int g = u.pm * 256 + rl; t = g & 2047; orow = (kind >= 2) ? (g >> 11) * 2304 + 256 + t : g; }
                else orow = (u.pm - 32) * 2304 + rl;
                f32x4 cs0 = {1.f, 0.f, 1.f, 0.f}, cs1 = {1.f, 0.f, 1.f, 0.f};
                if (dorope) { const float* rp = rope + ((t * 2 + ax) * 16 + 4 * fq) * 2; cs0 = *(const f32x4*)rp; cs1 = *(const f32x4*)(rp + 4); }
#pragma unroll
                for (int bj = 0; bj < 2; ++bj) {
                    f32x4 v0 = acc[ai][bj][m][0], v1 = acc[ai][bj][m][1];
                    if (dorope) {
                        f32x4 o0, o1;
                        o0[0] = v0[0] * cs0[0] - v1[0] * cs0[1]; o1[0] = v0[0] * cs0[1] + v1[0] * cs0[0];
                        o0[1] = v0[1] * cs0[2] - v1[1] * cs0[3]; o1[1] = v0[1] * cs0[3] + v1[1] * cs0[2];
                        o0[2] = v0[2] * cs1[0] - v1[2] * cs1[1]; o1[2] = v0[2] * cs1[1] + v1[2] * cs1[0];
                        o0[3] = v0[3] * cs1[2] - v1[3] * cs1[3]; o1[3] = v0[3] * cs1[3] + v1[3] * cs1[2];
                        v0 = o0; v1 = o1;
                    }
                    bf16_t* p = dst + (size_t)orow * ld + colt + bj * 128;
                    u32x2 w0, w1; w0.x = cvt_pk_bf16(v0[0], v0[1]); w0.y = cvt_pk_bf16(v0[2], v0[3]); w1.x = cvt_pk_bf16(v1[0], v1[1]); w1.y = cvt_pk_bf16(v1[2], v1[3]);
                    *(u32x2*)p = w0; *(u32x2*)(p + 16) = w1;
                }
            }
    }
};

struct EpiOutProj {
    static constexpr bool PERM = false, AFTER_DRAIN = false;
    const float* x; const float* mod; float* x1; float* ssq;
    __device__ __forceinline__ void operator()(const f32x4 (&acc)[2][2][4][2], const Unit& u, int wr, int wc, int fr, int fq) const {
        const float* g1 = mod + (size_t)(u.pm >> 3) * (6 * 2048) + 2 * 2048;
        const int col0 = u.pn * 256 + wc * 32 + 4 * fq;
        f32x4 gv[2][2];
#pragma unroll
        for (int bj = 0; bj < 2; ++bj)
#pragma unroll
            for (int n = 0; n < 2; ++n) gv[bj][n] = *(const f32x4*)(g1 + col0 + bj * 128 + n * 16);
#pragma unroll
        for (int ai = 0; ai < 2; ++ai)
#pragma unroll
            for (int m = 0; m < 4; ++m) {
                const int row = u.pm * 256 + ai * 128 + wr * 64 + m * 16 + fr;
                float s = 0.f;
#pragma unroll
                for (int bj = 0; bj < 2; ++bj)
#pragma unroll
                    for (int n = 0; n < 2; ++n) {
                        const size_t off = (size_t)row * 2048 + col0 + bj * 128 + n * 16;
                        const f32x4 xv = *(const f32x4*)(x + off);
                        const f32x4 o = xv + gv[bj][n] * acc[ai][bj][m][n];
                        *(f32x4*)(x1 + off) = o;
                        s += (o[0] * o[0] + o[1] * o[1]) + (o[2] * o[2] + o[3] * o[3]);
                    }
                s += __shfl_xor(s, 16); s += __shfl_xor(s, 32);
                if (fq == 0) ssq[(size_t)row * 32 + u.pn * 4 + wc] = s;
            }
    }
};

struct EpiBf16Plain {
    static constexpr bool PERM = true, AFTER_DRAIN = false;
    bf16_t* O; int ldc;
    __device__ __forceinline__ void operator()(const f32x4 (&acc)[2][2][4][2], const Unit& u, int wr, int wc, int fr, int fq) const {
        const int row0 = u.pm * BM + wr * 64 + fr, col0 = u.pn * BM + wc * 32 + 8 * fq;
#pragma unroll
        for (int ai = 0; ai < 2; ++ai)
#pragma unroll
            for (int m = 0; m < 4; ++m) { bf16_t* rowp = O + (size_t)(row0 + ai * HALF + m * 16) * ldc + col0;
#pragma unroll
                for (int bj = 0; bj < 2; ++bj) { const f32x4 v0 = acc[ai][bj][m][0], v1 = acc[ai][bj][m][1];
                    u32x4 w; w.x = cvt_pk_bf16(v0[0], v0[1]); w.y = cvt_pk_bf16(v0[2], v0[3]); w.z = cvt_pk_bf16(v1[0], v1[1]); w.w = cvt_pk_bf16(v1[2], v1[3]);
                    *(u32x4*)(rowp + bj * HALF) = w; } }
    }
};

template <class Epi, class Sched, bool ALIGN_EPI = false, bool SP2 = false>
__device__ __forceinline__ void gemm_phase(PG8_LAS unsigned char* lds, const Gemm g, const Sched& S, const Epi& E) {
    const int tid = threadIdx.x, wid = __builtin_amdgcn_readfirstlane(tid >> 6), lane = tid & 63, wr = wid >> 2, wc = wid & 3, fr = lane & 15, fq = lane >> 4;
    const int K = g.K, nt = K / BK;
    unsigned voffA[2], voffB[2];
#pragma unroll
    for (int i = 0; i < 2; ++i) { int R, C; stage_rc(tid * 16 + i * 8192, R, C); const int Rb = Epi::PERM ? ((R & ~31) + perm32(R & 31)) : R;
        voffA[i] = (unsigned)(R * K + C) * 2u; voffB[i] = (unsigned)(Rb * K + C) * 2u; }
    const size_t kstep = (size_t)(BK * 2);
    const size_t hstep = (size_t)HALF * K * 2;
    const size_t tstep = 2 * hstep;
    const unsigned ldsw = (unsigned)wid * 1024u;
    const int aoff = lds_byte(wr * 64 + fr, fq * 8), boff = lds_byte(wc * 32 + fr, fq * 8);
#define PG8_SA(b, h) (((b) * 2 + (h)) * HTB)
#define PG8_SB(b, h) ((4 + (b) * 2 + (h)) * HTB)
#define PG8_STAGE(bufoff, gbase, voff) do { _Pragma("unroll") for (int _i = 0; _i < 2; ++_i) \
        __builtin_amdgcn_global_load_lds((const unsigned*)((const char*)(gbase) + (voff)[_i]), (PG8_LAS unsigned*)(lds + (bufoff) + ldsw + _i * 8192), 16, 0, 0); } while (0)
#define PG8_LDA(dst, b, h) do { _Pragma("unroll") for (int m = 0; m < 4; ++m) _Pragma("unroll") for (int k = 0; k < 2; ++k) dst[m][k] = *(const PG8_LAS bf16x8*)(lds + PG8_SA(b, h) + aoff + m * 2048 + k * 1024); } while (0)
#define PG8_LDB(dst, b, h) do { _Pragma("unroll") for (int n = 0; n < 2; ++n) _Pragma("unroll") for (int k = 0; k < 2; ++k) dst[n][k] = *(const PG8_LAS bf16x8*)(lds + PG8_SB(b, h) + boff + n * 2048 + k * 1024); } while (0)
#define PG8_MMA(ai, bj, At, Bt) do { __builtin_amdgcn_s_setprio(1); _Pragma("unroll") for (int m = 0; m < 4; ++m) _Pragma("unroll") for (int n = 0; n < 2; ++n) _Pragma("unroll") for (int k = 0; k < 2; ++k) \
        acc[ai][bj][m][n] = __builtin_amdgcn_mfma_f32_16x16x32_bf16(Bt[n][k], At[m][k], acc[ai][bj][m][n], 0, 0, 0); __builtin_amdgcn_s_setprio(0); } while (0)
#define PG8_WAIT_V(n) asm volatile("s_waitcnt vmcnt(" #n ")" ::: "memory")
#define PG8_WAIT_L(n) asm volatile("s_waitcnt lgkmcnt(" #n ")" ::: "memory")
#define PG8_BAR __builtin_amdgcn_s_barrier()
#define PG8_SCHED __builtin_amdgcn_sched_barrier(0)
    Unit cur, nxt; int ui = 0;
    if (!S.next(0, cur)) return;
    f32x4 acc[2][2][4][2];
#pragma unroll
    for (int a = 0; a < 2; ++a)
#pragma unroll
        for (int b = 0; b < 2; ++b)
#pragma unroll
            for (int m = 0; m < 4; ++m)
#pragma unroll
                for (int n = 0; n < 2; ++n) acc[a][b][m][n] = (f32x4){0.f, 0.f, 0.f, 0.f};
    bf16x8 At[4][2], B0[2][2], B1[2][2];
    const char* cA = (const char*)g.A + (size_t)cur.pm * tstep; const char* cB = (const char*)g.Bt + (size_t)cur.pn * tstep;
    S.a_ready(cur);
    if constexpr (SP2) {
        PG8_STAGE(PG8_SB(0, 0), cB, voffB); PG8_STAGE(PG8_SB(0, 1), cB + hstep, voffB); PG8_STAGE(PG8_SA(0, 0), cA, voffA); PG8_STAGE(PG8_SA(0, 1), cA + hstep, voffA);
        if (wr == 1) PG8_BAR;
        PG8_WAIT_V(2); PG8_BAR;
        PG8_STAGE(PG8_SB(1, 0), cB + kstep, voffB); PG8_STAGE(PG8_SA(1, 0), cA + kstep, voffA); PG8_STAGE(PG8_SB(1, 1), cB + hstep + kstep, voffB);
        PG8_WAIT_V(6); PG8_BAR;
    } else {
        PG8_STAGE(PG8_SB(0, 0), cB, voffB); PG8_STAGE(PG8_SA(0, 0), cA, voffA); PG8_STAGE(PG8_SB(0, 1), cB + hstep, voffB); PG8_STAGE(PG8_SA(0, 1), cA + hstep, voffA);
        if (wr == 1) PG8_BAR;
        PG8_WAIT_V(4); PG8_BAR;
        PG8_STAGE(PG8_SB(1, 0), cB + kstep, voffB); PG8_STAGE(PG8_SA(1, 0), cA + kstep, voffA); PG8_STAGE(PG8_SB(1, 1), cB + hstep + kstep, voffB);
        PG8_WAIT_V(6); PG8_BAR;
    }
    for (;;) {
        const bool has_next = S.next(ui + 1, nxt);
        const char* nA = has_next ? (const char*)g.A + (size_t)nxt.pm * tstep : cA; const char* nB = has_next ? (const char*)g.Bt + (size_t)nxt.pn * tstep : cB;
        for (int t = 0; t < nt; t += 2) {
            const bool last = (t == nt - 2);
            const char* a1 = cA + (size_t)(t + 1) * kstep;
            const char* a2 = last ? nA : cA + (size_t)(t + 2) * kstep; const char* b2 = last ? nB : cB + (size_t)(t + 2) * kstep;
            const char* a3 = a2 + kstep; const char* b3 = b2 + kstep;
            if (last && has_next) S.a_ready(nxt);
            if constexpr (SP2) {
            PG8_LDB(B0, 0, 0); PG8_LDB(B1, 0, 1); PG8_SCHED; PG8_LDA(At, 0, 0); PG8_STAGE(PG8_SA(1, 1), a1 + hstep, voffA);
            PG8_WAIT_V(8); PG8_WAIT_L(0); PG8_BAR; PG8_MMA(0, 0, At, B0); PG8_MMA(0, 1, At, B1); PG8_BAR; PG8_SCHED;
            PG8_LDA(At, 0, 1); PG8_STAGE(PG8_SB(0, 0), b2, voffB); PG8_STAGE(PG8_SB(0, 1), b2 + hstep, voffB); PG8_STAGE(PG8_SA(0, 0), a2, voffA);
            PG8_WAIT_V(8); PG8_WAIT_L(0); PG8_BAR; PG8_MMA(1, 0, At, B0); PG8_MMA(1, 1, At, B1); PG8_BAR; PG8_SCHED;
            PG8_LDB(B0, 1, 0); PG8_LDB(B1, 1, 1); PG8_SCHED; PG8_LDA(At, 1, 0); PG8_STAGE(PG8_SA(0, 1), a2 + hstep, voffA);
            PG8_WAIT_V(8); PG8_WAIT_L(0); PG8_BAR; PG8_MMA(0, 0, At, B0); PG8_MMA(0, 1, At, B1); PG8_BAR; PG8_SCHED;
            PG8_LDA(At, 1, 1); PG8_STAGE(PG8_SB(1, 0), b3, voffB); PG8_STAGE(PG8_SB(1, 1), b3 + hstep, voffB); PG8_STAGE(PG8_SA(1, 0), a3, voffA);
            PG8_WAIT_V(8); PG8_WAIT_L(0); PG8_BAR; PG8_MMA(1, 0, At, B0); PG8_MMA(1, 1, At, B1); PG8_BAR; PG8_SCHED;
            } else {
            PG8_LDB(B0, 0, 0); PG8_SCHED; PG8_LDA(At, 0, 0); PG8_STAGE(PG8_SA(1, 1), a1 + hstep, voffA);
            PG8_WAIT_L(8); PG8_BAR; PG8_WAIT_L(0); PG8_MMA(0, 0, At, B0); PG8_BAR; PG8_SCHED;
            PG8_LDB(B1, 0, 1); PG8_STAGE(PG8_SB(0, 0), b2, voffB);
            PG8_BAR; PG8_WAIT_L(0); PG8_MMA(0, 1, At, B1); PG8_BAR;
            PG8_LDA(At, 0, 1); PG8_STAGE(PG8_SA(0, 0), a2, voffA);
            PG8_BAR; PG8_WAIT_L(0); PG8_MMA(1, 0, At, B0); PG8_BAR; PG8_SCHED;
            PG8_STAGE(PG8_SB(0, 1), b2 + hstep, voffB);
            PG8_WAIT_V(6); PG8_BAR; PG8_MMA(1, 1, At, B1); PG8_BAR;
            PG8_LDB(B0, 1, 0); PG8_SCHED; PG8_LDA(At, 1, 0); PG8_STAGE(PG8_SA(0, 1), a2 + hstep, voffA);
            PG8_WAIT_L(8); PG8_BAR; PG8_WAIT_L(0); PG8_MMA(0, 0, At, B0); PG8_BAR; PG8_SCHED;
            PG8_LDB(B1, 1, 1); PG8_STAGE(PG8_SB(1, 0), b3, voffB);
            PG8_BAR; PG8_WAIT_L(0); PG8_MMA(0, 1, At, B1); PG8_BAR;
            PG8_LDA(At, 1, 1); PG8_STAGE(PG8_SA(1, 0), a3, voffA);
            PG8_BAR; PG8_WAIT_L(0); PG8_MMA(1, 0, At, B0); PG8_BAR; PG8_SCHED;
            PG8_STAGE(PG8_SB(1, 1), b3 + hstep, voffB);
            PG8_WAIT_V(6); PG8_BAR; PG8_MMA(1, 1, At, B1); PG8_BAR;
            }
        }
        if constexpr (ALIGN_EPI) { if (wr == 0) PG8_BAR; }
        if constexpr (!Epi::AFTER_DRAIN) { E(acc, cur, wr, wc, fr, fq); S.done(cur); }
        if (!has_next) break;
#pragma unroll
        for (int a = 0; a < 2; ++a)
#pragma unroll
            for (int b = 0; b < 2; ++b)
#pragma unroll
                for (int m = 0; m < 4; ++m)
#pragma unroll
                    for (int n = 0; n < 2; ++n) acc[a][b][m][n] = (f32x4){0.f, 0.f, 0.f, 0.f};
        cur = nxt; cA = nA; cB = nB; ++ui;
        if constexpr (ALIGN_EPI) { if (wr == 1) PG8_BAR; }
    }
    PG8_WAIT_V(0);
    if constexpr (!ALIGN_EPI) { if (wr == 0) PG8_BAR; }
    PG8_BAR;
    if constexpr (Epi::AFTER_DRAIN) { E.fused(acc, cur, wr, wc, fr, fq, lds, wid, lane); S.done(cur); }
#undef PG8_SA
#undef PG8_SB
#undef PG8_STAGE
#undef PG8_LDA
#undef PG8_LDB
#undef PG8_MMA
#undef PG8_WAIT_V
#undef PG8_WAIT_L
#undef PG8_BAR
#undef PG8_SCHED
}
}
constexpr size_t MiB = 1u << 20, KiB = 1u << 10;
constexpr size_t WS_CTL = 0, CTL_ZERO_BYTES = 1 * MiB;
constexpr size_t WS_LAM = 1 * MiB;
constexpr size_t WS_ROPE = 1 * MiB + 64 * KiB;
constexpr size_t WS_MOD = 1 * MiB + 640 * KiB;
constexpr size_t WS_ADAP = 2 * MiB;
constexpr size_t WS_SSQ = 6 * MiB;
constexpr size_t WS_SU = 7 * MiB, WS_SV = 7 * MiB + 64 * KiB;
constexpr size_t WS_EIDX = 8 * MiB, WS_EGATE = 12 * MiB;
constexpr size_t WS_KEYS16 = 16 * MiB, WS_PWT16 = 16 * MiB + 512 * KiB;
constexpr size_t WS_WIN = 18 * MiB, WS_WOUT = 38 * MiB, WS_WQ = 46 * MiB;
constexpr size_t WS_HF = 54 * MiB, WS_ZF = 126 * MiB, WS_MIXF = 306 * MiB;
constexpr size_t WS_H16 = 370 * MiB, WS_Q16 = 406 * MiB, WS_K16 = 430 * MiB, WS_V16 = 457 * MiB, WS_ZP16 = 484 * MiB;
constexpr size_t WS_MIX16 = 370 * MiB, WS_F16 = 406 * MiB, WS_QP16 = 438 * MiB;
constexpr size_t WS_U8 = 192 * MiB, WS_V8 = 224 * MiB;
constexpr size_t WS_ESU = 256 * MiB;
constexpr size_t WS_END = 512 * MiB;
constexpr int CW_BAR = 4096;

constexpr int RING_OFF = 0, RING_BYTES = 131072;
constexpr int LDSCTL_OFF = RING_BYTES, MISC_OFF = LDSCTL_OFF + 320;
constexpr int LDS_BYTES = 147456;
constexpr int NWAVES = 8;
#define GAS __attribute__((address_space(1)))
#define LAS __attribute__((address_space(3)))
typedef unsigned short bf16;
typedef unsigned v4u __attribute__((ext_vector_type(4)));
typedef float f32x4 __attribute__((ext_vector_type(4)));
typedef short bf16x8 __attribute__((ext_vector_type(8)));
typedef GAS unsigned gu32;
typedef GAS unsigned long long gu64;
#define RLX_AGENT __ATOMIC_RELAXED, __HIP_MEMORY_SCOPE_AGENT
#define LDS_WAIT() asm volatile("s_waitcnt lgkmcnt(0)" ::: "memory")
#define VM_WAIT() asm volatile("s_waitcnt vmcnt(0)" ::: "memory")
__device__ __forceinline__ unsigned long long rt() { return __builtin_amdgcn_s_memrealtime(); }
__device__ __forceinline__ unsigned f2bf(float f) { unsigned u = __builtin_bit_cast(unsigned, f); return (u + 0x7fffu + ((u >> 16) & 1u)) >> 16; }
__device__ __forceinline__ unsigned pk2(float lo, float hi) { return f2bf(lo) | (f2bf(hi) << 16); }

#define XB_TMO      128
#define XB_XCNT(j)  (256  + 64 * (j))
#define XB_XSUB(j)  (1280 + 64 * (j))
#define XB_XGEN(j)  (2304 + 64 * (j))
#define XB_TOP      3328
#define XB_TOPGEN   3392
#define XCD_BAR_WORDS 3456
#define XB_SPIN_CAP (1u << 18)

__device__ __forceinline__ unsigned xb_ld(unsigned* p)              { return __hip_atomic_load(p, __ATOMIC_RELAXED, __HIP_MEMORY_SCOPE_AGENT); }
__device__ __forceinline__ unsigned xb_add(unsigned* p, unsigned v) { return __hip_atomic_fetch_add(p, v, __ATOMIC_RELAXED, __HIP_MEMORY_SCOPE_AGENT); }
__device__ __forceinline__ unsigned xb_xcc_id() { return (unsigned)__builtin_amdgcn_s_getreg((3 << 11) | 20) & 0xFu; }
#define XB_SPIN(cond, bar) do { unsigned _sp = 0; while (cond) { __builtin_amdgcn_s_sleep(1); \
    if ((++_sp & 255u) == 0u) { if (xb_ld(&(bar)[XB_TMO])) break; if (_sp > XB_SPIN_CAP) { atomicAdd(&(bar)[XB_TMO], 1u); break; } } } } while (0)

struct XcdBarrier {
    unsigned* bar; unsigned x;
    volatile LAS unsigned* st;
};

__device__ __forceinline__ XcdBarrier xcd_barrier_post(unsigned* bar, volatile LAS unsigned* st) {
    XcdBarrier b; b.bar = bar; b.x = xb_xcc_id(); b.st = st;
    if (threadIdx.x == 0) (void)xb_add(&bar[XB_XCNT(b.x)], 1u);
    return b;
}
__device__ __forceinline__ void xcd_barrier_complete(unsigned* bar, unsigned x, unsigned& nloc, unsigned& nx) {
    const unsigned G = gridDim.x * gridDim.y * gridDim.z;
    unsigned sum, cnt, mine, sp = 0u;
    for (;;) {
        sum = 0u; cnt = 0u; mine = 0u;
#pragma unroll
        for (unsigned j = 0; j < 16; ++j) { const unsigned c = xb_ld(&bar[XB_XCNT(j)]); sum += c; cnt += (c > 0u) ? 1u : 0u; mine = (j == x) ? c : mine; }
        if (sum == G) break;
        __builtin_amdgcn_s_sleep(1);
        if ((++sp & 255u) == 0u) { if (xb_ld(&bar[XB_TMO])) break; if (sp > XB_SPIN_CAP) { atomicAdd(&bar[XB_TMO], 1u); break; } }
    }
    nloc = mine > 0u ? mine : 1u; nx = cnt > 0u ? cnt : 1u;
}

__device__ __forceinline__ void xcd_barrier(const XcdBarrier& b) {
    asm volatile("s_waitcnt vmcnt(0)" ::: "memory");
    __syncthreads();
    if (threadIdx.x == 0) {
        unsigned* bar = b.bar;
        __builtin_amdgcn_s_waitcnt(0);
        unsigned nloc = b.st[0], nx = b.st[1];
        if (nloc == 0u) { xcd_barrier_complete(bar, b.x, nloc, nx); b.st[0] = nloc; b.st[1] = nx; }
        const unsigned old = xb_add(&bar[XB_XSUB(b.x)], 1u);
        const unsigned gen = old / nloc;
        if (old + 1u == (gen + 1u) * nloc) {
            __builtin_amdgcn_fence(__ATOMIC_RELEASE, "agent");
            asm volatile("s_waitcnt vmcnt(0)" ::: "memory");
            const unsigned og = xb_add(&bar[XB_TOP], 1u);
            const unsigned tg = og / nx;
            if (og + 1u == (tg + 1u) * nx) xb_add(&bar[XB_TOPGEN], 1u);
            else XB_SPIN(xb_ld(&bar[XB_TOPGEN]) == tg, bar);
            __builtin_amdgcn_fence(__ATOMIC_ACQUIRE, "agent");
            xb_add(&bar[XB_XGEN(b.x)], 1u);
            asm volatile("s_waitcnt vmcnt(0)" ::: "memory");
        } else {
            XB_SPIN(xb_ld(&bar[XB_XGEN(b.x)]) == gen, bar);
            __builtin_amdgcn_fence(__ATOMIC_ACQUIRE, "agent");
            asm volatile("s_waitcnt vmcnt(0)" ::: "memory");
        }
    }
    __syncthreads();
}
namespace att {
using s16x4  = __attribute__((ext_vector_type(4))) short;
using f32x16 = __attribute__((ext_vector_type(16))) float;
constexpr int NW = 8, QBLK = 32, KVBLK = 64, LDQ = 1536, LDK = 1536;
constexpr float SCALE = 0.125f, THR = 8.f;
constexpr int SHM_V = KVBLK * 128 * 2, SHM_K = KVBLK * 128 * 2;
#define KSWZ(row, colB) ((row) * 256 + ((colB) ^ (((row) & 7) << 4)))
#define SBAR() __builtin_amdgcn_sched_barrier(0)
__device__ __forceinline__ int crow(int r, int hi) { return (r & 3) + 8 * (r >> 2) + 4 * hi; }
__device__ __forceinline__ unsigned cvtpk(float lo, float hi) { unsigned r; asm volatile("v_cvt_pk_bf16_f32 %0, %1, %2" : "=v"(r) : "v"(lo), "v"(hi)); return r; }

__device__ __forceinline__ void partialSM(f32x16& p0, f32x16& p1, float& m_reg, float& mn, float& alpha) {
  constexpr float C = SCALE * 1.4426950408889634f;
  float pmax = p0[0]; for (int r = 1; r < 16; ++r) pmax = fmaxf(pmax, p0[r]); for (int r = 0; r < 16; ++r) pmax = fmaxf(pmax, p1[r]);
  { auto rr = __builtin_amdgcn_permlane32_swap(__float_as_uint(pmax), __float_as_uint(pmax), false, false);
    pmax = fmaxf(__uint_as_float(rr[0]), __uint_as_float(rr[1])); }
  if (__builtin_expect(__all(pmax - m_reg <= THR / SCALE), 1)) { mn = m_reg; alpha = 1.f; }
  else { mn = fmaxf(m_reg, pmax); alpha = __builtin_amdgcn_exp2f((m_reg - mn) * C); m_reg = mn; }
  float mnC = -mn * C;
  for (int r = 0; r < 16; ++r) p0[r] = fmaf(p0[r], C, mnC); for (int r = 0; r < 16; ++r) p1[r] = fmaf(p1[r], C, mnC);
  for (int r = 0; r < 16; ++r) p0[r] = __builtin_amdgcn_exp2f(p0[r]);
}
__device__ __forceinline__ void finishSM(f32x16& p0, f32x16& p1, float alpha, float& l_reg, bf16x8& pa0, bf16x8& pa1, bf16x8& pa2, bf16x8& pa3) {
  for (int r = 0; r < 16; ++r) p1[r] = __builtin_amdgcn_exp2f(p1[r]);
  float ps = 0; for (int r = 0; r < 16; ++r) ps += p0[r]; for (int r = 0; r < 16; ++r) ps += p1[r];
  { auto rr = __builtin_amdgcn_permlane32_swap(__float_as_uint(ps), __float_as_uint(ps), false, false);
    ps = __uint_as_float(rr[0]) + __uint_as_float(rr[1]); }
  l_reg = l_reg * alpha + ps;
#define PK4(P, BASE, OUT) do { unsigned a0 = cvtpk(P[BASE + 0], P[BASE + 1]), a1 = cvtpk(P[BASE + 2], P[BASE + 3]);   \
    unsigned b0 = cvtpk(P[BASE + 4], P[BASE + 5]), b1 = cvtpk(P[BASE + 6], P[BASE + 7]);                              \
    auto r0 = __builtin_amdgcn_permlane32_swap(a0, b0, false, false); auto r1 = __builtin_amdgcn_permlane32_swap(a1, b1, false, false); \
    v4u w = {r0[0], r1[0], r0[1], r1[1]}; OUT = *reinterpret_cast<bf16x8*>(&w); } while (0)
  PK4(p0, 0, pa0); PK4(p0, 8, pa1); PK4(p1, 0, pa2); PK4(p1, 8, pa3);
#undef PK4
}
__device__ __forceinline__ void qkt(f32x16& p0, f32x16& p1, const bf16* Ks, const bf16x8* qr, int r32, int hi, int mp) {
  p0 = f32x16{}; p1 = f32x16{};
  for (int d0 = 0; d0 < 4; ++d0) { int cb = (mp * 64 + d0 * 16 + hi * 8) * 2;
    bf16x8 b0 = *reinterpret_cast<const bf16x8*>((const char*)Ks + KSWZ(r32, cb));
    bf16x8 b1 = *reinterpret_cast<const bf16x8*>((const char*)Ks + KSWZ(32 + r32, cb));
    p0 = __builtin_amdgcn_mfma_f32_32x32x16_bf16(b0, qr[d0], p0, 0, 0, 0);
    p1 = __builtin_amdgcn_mfma_f32_32x32x16_bf16(b1, qr[d0], p1, 0, 0, 0); }
}
__device__ __forceinline__ int v_st(int k, int c) { const int kk = (k & ~0xC) | ((k & 4) << 1) | ((k & 8) >> 1); return ((kk >> 3) * 4 + (c >> 5)) * 512 + ((kk & 7) * 32 + (c & 31)) * 2; }
__device__ __forceinline__ int v_rd_base(int lane) { return ((lane & 3) << 3) | (((lane >> 2) & 3) << 6) | (((lane >> 4) & 1) << 5) | (((lane >> 5) & 1) << 8); }
constexpr int v_rd_off(int d0, int ks, int half) { return d0 * 512 + ks * 4096 + half * 2048; }
template <int OFF> __device__ __forceinline__ s16x4 tr_read(int vb) {
  s16x4 r; asm volatile("ds_read_b64_tr_b16 %0, %1 offset:%2" : "=&v"(r) : "v"(vb), "i"(OFF) : "memory"); return r;
}
template <int D0> __device__ __forceinline__ void pv_one(f32x16& od, int vb, bf16x8 pa0, bf16x8 pa1, bf16x8 pa2, bf16x8 pa3) {
  const s16x4 l0 = tr_read<v_rd_off(D0, 0, 0)>(vb), h0 = tr_read<v_rd_off(D0, 0, 1)>(vb), l1 = tr_read<v_rd_off(D0, 1, 0)>(vb), h1 = tr_read<v_rd_off(D0, 1, 1)>(vb);
  const s16x4 l2 = tr_read<v_rd_off(D0, 2, 0)>(vb), h2 = tr_read<v_rd_off(D0, 2, 1)>(vb), l3 = tr_read<v_rd_off(D0, 3, 0)>(vb), h3 = tr_read<v_rd_off(D0, 3, 1)>(vb);
  asm volatile("s_waitcnt lgkmcnt(0)" ::: "memory"); SBAR();
#define PK(L, H) (bf16x8){L[0], L[1], L[2], L[3], H[0], H[1], H[2], H[3]}
  od = __builtin_amdgcn_mfma_f32_32x32x16_bf16(pa0, PK(l0, h0), od, 0, 0, 0);
  od = __builtin_amdgcn_mfma_f32_32x32x16_bf16(pa1, PK(l1, h1), od, 0, 0, 0);
  od = __builtin_amdgcn_mfma_f32_32x32x16_bf16(pa2, PK(l2, h2), od, 0, 0, 0);
  od = __builtin_amdgcn_mfma_f32_32x32x16_bf16(pa3, PK(l3, h3), od, 0, 0, 0);
#undef PK
}
__device__ __forceinline__ void pv_d0(f32x16* o, int vb, bf16x8 pa0, bf16x8 pa1, bf16x8 pa2, bf16x8 pa3) {
  pv_one<0>(o[0], vb, pa0, pa1, pa2, pa3); pv_one<1>(o[1], vb, pa0, pa1, pa2, pa3); pv_one<2>(o[2], vb, pa0, pa1, pa2, pa3); pv_one<3>(o[3], vb, pa0, pa1, pa2, pa3);
}

__device__ __forceinline__ void attn_unit(int b, int h, int qb, const bf16* __restrict__ Q16, const bf16* __restrict__ K16, const bf16* __restrict__ V16,
                                          bf16* __restrict__ mix16, float lam, const float* __restrict__ subg, char* lds) {
  const int tid = threadIdx.x, wid = tid >> 6, lane = tid & 63, r32 = lane & 31, hi = lane >> 5, mp = wid >> 2, qs = wid & 3;
  bf16* V_lds = (bf16*)lds; bf16* K_lds = (bf16*)(lds + 2 * SHM_V);
  float* wsx = (float*)(lds + 2 * SHM_V + 2 * SHM_K) + wid * 64; float* li_l = wsx; float* al_l = wsx + 32;
  float m_reg = -1e30f, l_reg = 0; f32x16 o[4] = {}; bf16x8 qr[4];
  const bf16* Qw = Q16 + (size_t)(b * L + qb * 128 + qs * 32 + r32) * LDQ + h * 128 + mp * 64 + hi * 8;
#pragma unroll
  for (int d0 = 0; d0 < 4; ++d0) qr[d0] = *reinterpret_cast<const bf16x8*>(Qw + d0 * 16);
  const bf16* Kh = K16 + (size_t)(b * LK) * LDK + h * 128;
  const bf16* Vh = V16 + (size_t)(b * LK) * LDK + h * 128;
  const int sr = tid >> 4, sc = (tid & 15) * 8, vst0 = v_st(sr, sc), vst1 = v_st(32 + sr, sc);
  const int vb0 = (int)(uintptr_t)V_lds + v_rd_base(lane);
  struct { bf16x8 vs0, vs1, ks0, ks1; } sr_[2];
#define SLOAD(i, k0) do { sr_[i].vs0 = *(const bf16x8*)(&Vh[(size_t)((k0) + sr) * LDK + sc]); sr_[i].vs1 = *(const bf16x8*)(&Vh[(size_t)((k0) + 32 + sr) * LDK + sc]); \
    sr_[i].ks0 = *(const bf16x8*)(&Kh[(size_t)((k0) + sr) * LDK + sc]); sr_[i].ks1 = *(const bf16x8*)(&Kh[(size_t)((k0) + 32 + sr) * LDK + sc]); } while (0)
#define SWRITE(bb, i) do { *(bf16x8*)((char*)V_lds + (bb) * SHM_V + vst0) = sr_[i].vs0;          \
    *(bf16x8*)((char*)V_lds + (bb) * SHM_V + vst1) = sr_[i].vs1; int kc = sc * 2;               \
    *(bf16x8*)((char*)K_lds + (bb) * SHM_K + KSWZ(sr, kc)) = sr_[i].ks0;                       \
    *(bf16x8*)((char*)K_lds + (bb) * SHM_K + KSWZ(32 + sr, kc)) = sr_[i].ks1; } while (0)
#define SWAIT() asm volatile("s_waitcnt vmcnt(4)" ::: "memory")
#define RESC(a) do { if (__any((a) < 1.f)) { if (hi == 0) al_l[r32] = (a); asm volatile("s_waitcnt lgkmcnt(0)" ::: "memory"); \
    for (int d = 0; d < 4; ++d) for (int r = 0; r < 16; ++r) o[d][r] *= al_l[crow(r, hi)]; } } while (0)
  f32x16 pA0, pA1, pB0, pB1; float mnA, mnB, alA, alB; bf16x8 pa0, pa1, pa2, pa3; constexpr int NT = LK / KVBLK;
  constexpr int SE = 0, SO = 1;
  SLOAD(SE, 0); asm volatile("s_waitcnt vmcnt(0)" ::: "memory"); SWRITE(0, SE); __syncthreads();
  qkt(pA0, pA1, K_lds, qr, r32, hi, mp); partialSM(pA0, pA1, m_reg, mnA, alA);
  SLOAD(SO, KVBLK); SLOAD(SE, 2 * KVBLK);
  SWAIT(); SWRITE(1, SO); __syncthreads();
  for (int j = 1; j + 1 < NT; j += 2) {
    SBAR(); qkt(pB0, pB1, (bf16*)((char*)K_lds + SHM_K), qr, r32, hi, mp);
    finishSM(pA0, pA1, alA, l_reg, pa0, pa1, pa2, pa3); SBAR();
    SLOAD(SO, (j + 2) * KVBLK); SBAR();
    pv_d0(o, vb0, pa0, pa1, pa2, pa3); partialSM(pB0, pB1, m_reg, mnB, alB);
    __syncthreads(); SWAIT(); SWRITE(0, SE);
    RESC(alB); __syncthreads();
    SBAR(); qkt(pA0, pA1, K_lds, qr, r32, hi, mp);
    finishSM(pB0, pB1, alB, l_reg, pa0, pa1, pa2, pa3); SBAR();
    if (j + 3 < NT) SLOAD(SE, (j + 3) * KVBLK); SBAR();
    pv_d0(o, vb0 + SHM_V, pa0, pa1, pa2, pa3); partialSM(pA0, pA1, m_reg, mnA, alA);
    __syncthreads(); SWAIT(); SWRITE(1, SO);
    RESC(alA); __syncthreads();
  }
  SBAR(); qkt(pB0, pB1, (bf16*)((char*)K_lds + SHM_K), qr, r32, hi, mp);
  finishSM(pA0, pA1, alA, l_reg, pa0, pa1, pa2, pa3); SBAR();
  pv_d0(o, vb0, pa0, pa1, pa2, pa3); partialSM(pB0, pB1, m_reg, mnB, alB);
  __syncthreads(); RESC(alB);
  finishSM(pB0, pB1, alB, l_reg, pa0, pa1, pa2, pa3); SBAR();
  pv_d0(o, vb0 + SHM_V, pa0, pa1, pa2, pa3);
  if (hi == 0) li_l[r32] = l_reg;
  asm volatile("s_waitcnt lgkmcnt(0)" ::: "memory");
  float rli[16];
#pragma unroll
  for (int r = 0; r < 16; ++r) rli[r] = 1.0f / li_l[crow(r, hi)];
  __syncthreads();
  float* X = (float*)lds + qs * (32 * 128);
  if (mp == 1) {
#pragma unroll
    for (int r = 0; r < 16; ++r)
#pragma unroll
      for (int d0 = 0; d0 < 4; ++d0) X[crow(r, hi) * 128 + d0 * 32 + r32] = lam * o[d0][r] * rli[r];
  }
  __syncthreads();
  if (mp == 0) {
    float ssq[16];
#pragma unroll
    for (int r = 0; r < 16; ++r) { float s = 0.f;
#pragma unroll
      for (int d0 = 0; d0 < 4; ++d0) { const float v = o[d0][r] * rli[r] - X[crow(r, hi) * 128 + d0 * 32 + r32]; o[d0][r] = v; s += v * v; }
      ssq[r] = s; }
#pragma unroll
    for (int r = 0; r < 16; ++r) {
      float s = ssq[r];
      s += __shfl_xor(s, 1); s += __shfl_xor(s, 2); s += __shfl_xor(s, 4); s += __shfl_xor(s, 8); s += __shfl_xor(s, 16);
      ssq[r] = 1.0f / sqrtf(s * (1.0f / 128.f) + EPS);
    }
    float sg[4];
#pragma unroll
    for (int d0 = 0; d0 < 4; ++d0) sg[d0] = subg[d0 * 32 + r32] * 0.8f;
    asm volatile("s_waitcnt lgkmcnt(0)" ::: "memory");
    unsigned short* Y = (unsigned short*)X;
#pragma unroll
    for (int r = 0; r < 16; ++r)
#pragma unroll
      for (int d0 = 0; d0 < 4; ++d0) Y[crow(r, hi) * 128 + d0 * 32 + r32] = (unsigned short)f2bf(o[d0][r] * ssq[r] * sg[d0]);
    asm volatile("s_waitcnt lgkmcnt(0)" ::: "memory");
    bf16* Ob = mix16 + (size_t)(b * L + qb * 128 + qs * 32) * D + POOLW + h * 128;
#pragma unroll
    for (int j = 0; j < 8; ++j) { const int idx = j * 64 + lane, row = idx >> 4, ch = idx & 15;
      const v4u w = *(const v4u*)(Y + row * 128 + ch * 8);
      *(v4u*)(Ob + (size_t)row * D + ch * 8) = w; }
  }
  __syncthreads();
#undef SLOAD
#undef SWRITE
#undef SWAIT
#undef RESC
}

__device__ __forceinline__ void pool_item(int tile, int g, const bf16* __restrict__ ZP16, const bf16* __restrict__ pwT16, const float* __restrict__ pool_b,
                                          const float* __restrict__ pool_scale, bf16* __restrict__ mix16, int lane) {
  const int r32 = lane & 31, hi = lane >> 5;
  const int row0 = tile * 32, t = (row0 & 2047) + r32, rb = row0 & ~2047;
  const int w = 2 << g, hw = w >> 1;
  const int lo = t - hw < 0 ? 0 : t - hw, hi_ = t + hw > L ? L : t + hw;
  const float inv = 1.0f / (float)(hi_ - lo);
  bf16x8 af[8];
#pragma unroll
  for (int ks = 0; ks < 8; ++ks) {
    const int c0 = g * 128 + ks * 16 + hi * 8;
    float s[8];
#pragma unroll
    for (int e = 0; e < 8; ++e) s[e] = 0.f;
    for (int j = 0; j < w; ++j) {
      const int tt = t - hw + j; const bool ok = tt >= 0 && tt < L; const int tc = tt < 0 ? 0 : (tt >= L ? L - 1 : tt);
      const bf16x8 v = *(const bf16x8*)(ZP16 + (size_t)(rb + tc) * 512 + c0);
      const float m = ok ? 1.f : 0.f;
#pragma unroll
      for (int e = 0; e < 8; ++e) s[e] += m * __uint_as_float((unsigned)(unsigned short)v[e] << 16);
    }
    const bf16x8 own = *(const bf16x8*)(ZP16 + (size_t)(rb + t) * 512 + c0);
    v4u pk;
    pk.x = cvtpk(s[0] * inv - __uint_as_float((unsigned)(unsigned short)own[0] << 16), s[1] * inv - __uint_as_float((unsigned)(unsigned short)own[1] << 16));
    pk.y = cvtpk(s[2] * inv - __uint_as_float((unsigned)(unsigned short)own[2] << 16), s[3] * inv - __uint_as_float((unsigned)(unsigned short)own[3] << 16));
    pk.z = cvtpk(s[4] * inv - __uint_as_float((unsigned)(unsigned short)own[4] << 16), s[5] * inv - __uint_as_float((unsigned)(unsigned short)own[5] << 16));
    pk.w = cvtpk(s[6] * inv - __uint_as_float((unsigned)(unsigned short)own[6] << 16), s[7] * inv - __uint_as_float((unsigned)(unsigned short)own[7] << 16));
    af[ks] = *reinterpret_cast<bf16x8*>(&pk);
  }
  f32x16 acc[4] = {};
#pragma unroll
  for (int d0 = 0; d0 < 4; ++d0)
#pragma unroll
    for (int ks = 0; ks < 8; ++ks) {
      const bf16x8 bfr = *(const bf16x8*)(pwT16 + ((size_t)g * 128 + d0 * 32 + r32) * 128 + ks * 16 + hi * 8);
      acc[d0] = __builtin_amdgcn_mfma_f32_32x32x16_bf16(af[ks], bfr, acc[d0], 0, 0, 0);
    }
#pragma unroll
  for (int d0 = 0; d0 < 4; ++d0) {
    const int dcol = g * 128 + d0 * 32 + r32; const float pb = pool_b[dcol], ps = pool_scale[dcol];
#pragma unroll
    for (int r = 0; r < 16; ++r) mix16[(size_t)(row0 + crow(r, hi)) * D + dcol] = (unsigned short)f2bf((acc[d0][r] + pb) * ps);
  }
}
#undef KSWZ
#undef SBAR
}
__device__ __forceinline__ float wave_sum(float v) {
#pragma unroll
    for (int o = 1; o < 64; o <<= 1) v += __shfl_xor(v, o);
    return v;
}
__device__ __forceinline__ float wave_max(float v) {
#pragma unroll
    for (int o = 1; o < 64; o <<= 1) v = fmaxf(v, __shfl_xor(v, o));
    return v;
}
__device__ __forceinline__ void p0_lam_rope(const float* __restrict__ dl, float* __restrict__ lam_out, float* __restrict__ rope, int gtid, int gthreads) {
    if (gtid == 0) {
        double s01 = 0, s23 = 0;
        for (int i = 0; i < 64; ++i) { s01 += (double)dl[i] * dl[64 + i]; s23 += (double)dl[128 + i] * dl[192 + i]; }
        lam_out[0] = (float)(exp(s01) - exp(s23) + 0.2);
    }
    for (int gid = gtid; gid < L * 32; gid += gthreads) {
        const int t = gid / 32, a = (gid / 16) & 1, i = gid & 15;
        const double pos = a == 0 ? (double)(t / 64) : (double)(t % 64);
        const double ang = pos * pow(10000.0, -(double)i / 16.0);
        rope[gid * 2 + 0] = (float)cos(ang);
        rope[gid * 2 + 1] = (float)sin(ang);
    }
}
__device__ __forceinline__ void p0_ada_unit(int unit, const float* __restrict__ ada_w, float* __restrict__ part, LAS float* sv, LAS float* red, int wave, int lane, int tid) {
    const int cc = unit % 48, ks = unit / 48;
    const int col = cc * 256 + lane * 4;
    f32x4 acc[5];
#pragma unroll
    for (int r = 0; r < 5; ++r) acc[r] = (f32x4){0.f, 0.f, 0.f, 0.f};
    const int k0 = ks * 128 + wave * 16;
#pragma unroll 4
    for (int kk = 0; kk < 16; ++kk) {
        const int k = k0 + kk;
        const f32x4 wv = *(const f32x4*)(ada_w + (size_t)k * (6 * D) + col);
#pragma unroll
        for (int r = 0; r < 5; ++r) acc[r] += wv * sv[r * D + k];
    }
#pragma unroll
    for (int r = 0; r < 5; ++r) *(LAS f32x4*)(red + (wave * 5 + r) * 256 + lane * 4) = acc[r];
    __syncthreads();
    for (int idx = tid; idx < 5 * 256; idx += NWAVES * 64) {
        float s = 0.f;
#pragma unroll
        for (int w = 0; w < 8; ++w) s += red[w * 1280 + idx];
        part[((size_t)ks * 5 + idx / 256) * (6 * D) + cc * 256 + (idx & 255)] = s;
    }
    __syncthreads();
}
__device__ __forceinline__ void p0_row_to_fp8(const float* __restrict__ src, unsigned char* __restrict__ dst, float* __restrict__ inv_scale, int lane) {
    f32x4 v[8];
#pragma unroll
    for (int j = 0; j < 4; ++j) { v[j] = *(const f32x4*)(src + lane * 16 + j * 4); v[4 + j] = *(const f32x4*)(src + 1024 + lane * 16 + j * 4); }
    float am = 0.f;
#pragma unroll
    for (int j = 0; j < 8; ++j) am = fmaxf(am, fmaxf(fmaxf(fabsf(v[j][0]), fabsf(v[j][1])), fmaxf(fabsf(v[j][2]), fabsf(v[j][3]))));
    am = wave_max(am);
    float s = 1.f;
    if (am > 0.f) s = exp2f(floorf(log2f(224.f / am)));
    if (lane == 0) *inv_scale = 1.0f / s;
    v4u o0, o1;
#define PK8(a, b) ({ int _w = 0; _w = __builtin_amdgcn_cvt_pk_fp8_f32((a)[0] * s, (a)[1] * s, _w, false); _w = __builtin_amdgcn_cvt_pk_fp8_f32((a)[2] * s, (a)[3] * s, _w, true); (unsigned)_w; })
    o0.x = PK8(v[0], 0); o0.y = PK8(v[1], 0); o0.z = PK8(v[2], 0); o0.w = PK8(v[3], 0);
    o1.x = PK8(v[4], 0); o1.y = PK8(v[5], 0); o1.z = PK8(v[6], 0); o1.w = PK8(v[7], 0);
#undef PK8
    *(v4u*)(dst + lane * 16) = o0;
    *(v4u*)(dst + 1024 + lane * 16) = o1;
}
__device__ __forceinline__ unsigned pack_i8x4(f32x4 v, float s) {
    const int a = (int)rintf(v[0] * s), b = (int)rintf(v[1] * s), c = (int)rintf(v[2] * s), d = (int)rintf(v[3] * s);
    return (unsigned)(a & 0xFF) | ((unsigned)(b & 0xFF) << 8) | ((unsigned)(c & 0xFF) << 16) | ((unsigned)d << 24);
}
__device__ __forceinline__ void p0_row_to_i8(const float* __restrict__ src, unsigned char* __restrict__ dst, float* __restrict__ inv_scale, int lane) {
    f32x4 v[8];
#pragma unroll
    for (int j = 0; j < 4; ++j) { v[j] = *(const f32x4*)(src + lane * 16 + j * 4); v[4 + j] = *(const f32x4*)(src + 1024 + lane * 16 + j * 4); }
    float am = 0.f;
#pragma unroll
    for (int j = 0; j < 8; ++j) am = fmaxf(am, fmaxf(fmaxf(fabsf(v[j][0]), fabsf(v[j][1])), fmaxf(fabsf(v[j][2]), fabsf(v[j][3]))));
    am = wave_max(am);
    const float s = am > 0.f ? 127.f / am : 0.f;
    if (lane == 0) *inv_scale = am * (1.0f / 127.f);
    v4u o0, o1;
    o0.x = pack_i8x4(v[0], s); o0.y = pack_i8x4(v[1], s); o0.z = pack_i8x4(v[2], s); o0.w = pack_i8x4(v[3], s);
    o1.x = pack_i8x4(v[4], s); o1.y = pack_i8x4(v[5], s); o1.z = pack_i8x4(v[6], s); o1.w = pack_i8x4(v[7], s);
    *(v4u*)(dst + lane * 16) = o0;
    *(v4u*)(dst + 1024 + lane * 16) = o1;
}
constexpr int U4_ROW = 1152;
__device__ __forceinline__ void p0_row_to_i4(const float* __restrict__ src, unsigned char* __restrict__ dst, int lane) {
    f32x4 v[8];
#pragma unroll
    for (int j = 0; j < 8; ++j) v[j] = *(const f32x4*)(src + lane * 4 + 256 * j);
    float am = 0.f;
#pragma unroll
    for (int j = 0; j < 8; ++j) am = fmaxf(am, fmaxf(fmaxf(fabsf(v[j][0]), fabsf(v[j][1])), fmaxf(fabsf(v[j][2]), fabsf(v[j][3]))));
    const unsigned sb = f2bf(am * (1.0f / 7.0f));
    const float sf = __uint_as_float(sb << 16);
    const float inv = sf > 0.f ? 1.0f / sf : 0.f;
    unsigned w[4];
#pragma unroll
    for (int d = 0; d < 4; ++d) {
        unsigned x = 0;
#pragma unroll
        for (int jj = 0; jj < 2; ++jj)
#pragma unroll
            for (int e = 0; e < 4; ++e) {
                int q = (int)rintf(v[2 * d + jj][e] * inv); q = q > 7 ? 7 : (q < -7 ? -7 : q);
                x |= ((unsigned)q & 0xFu) << (4 * (4 * jj + e));
            }
        w[d] = x;
    }
    *(v4u*)(dst + lane * 16) = (v4u){w[0], w[1], w[2], w[3]};
    *(unsigned short*)(dst + 1024 + lane * 2) = (unsigned short)sb;
}
__device__ __forceinline__ void p0_row_to_fp4(const float* __restrict__ src, unsigned char* __restrict__ dst, int lane) {
    f32x4 v[8];
#pragma unroll
    for (int j = 0; j < 8; ++j) v[j] = *(const f32x4*)(src + lane * 4 + 256 * j);
    float am = 0.f;
#pragma unroll
    for (int j = 0; j < 8; ++j) am = fmaxf(am, fmaxf(fmaxf(fabsf(v[j][0]), fabsf(v[j][1])), fmaxf(fabsf(v[j][2]), fabsf(v[j][3]))));
    const unsigned sb = f2bf(am * (1.0f / 6.0f));
    const float sf = __uint_as_float(sb << 16);
    const float inv = sf > 0.f ? 1.0f / sf : 0.f;
    unsigned w[4];
#pragma unroll
    for (int d = 0; d < 4; ++d) {
        unsigned x = 0;
        x = __builtin_amdgcn_cvt_scalef32_pk_fp4_f32(x, v[2 * d][0] * inv, v[2 * d][1] * inv, 1.0f, 0);
        x = __builtin_amdgcn_cvt_scalef32_pk_fp4_f32(x, v[2 * d][2] * inv, v[2 * d][3] * inv, 1.0f, 1);
        x = __builtin_amdgcn_cvt_scalef32_pk_fp4_f32(x, v[2 * d + 1][0] * inv, v[2 * d + 1][1] * inv, 1.0f, 2);
        x = __builtin_amdgcn_cvt_scalef32_pk_fp4_f32(x, v[2 * d + 1][2] * inv, v[2 * d + 1][3] * inv, 1.0f, 3);
        w[d] = x;
    }
    *(v4u*)(dst + lane * 16) = (v4u){w[0], w[1], w[2], w[3]};
    *(unsigned short*)(dst + 1024 + lane * 2) = (unsigned short)sb;
}
template <class LD4>
__device__ __forceinline__ void norm_row_bf16(const float* __restrict__ xr, const float* __restrict__ g, LD4 ldmod, bf16* __restrict__ orow, int lane, float rstd_in, bool have_rstd) {
    f32x4 v[8]; float ss = 0.f;
#pragma unroll
    for (int j = 0; j < 8; ++j) { v[j] = *(const f32x4*)(xr + lane * 4 + 256 * j); ss += (v[j][0] * v[j][0] + v[j][1] * v[j][1]) + (v[j][2] * v[j][2] + v[j][3] * v[j][3]); }
    float rstd = rstd_in;
    if (!have_rstd) rstd = 1.0f / sqrtf(wave_sum(ss) * (1.0f / D) + EPS);
#pragma unroll
    for (int j = 0; j < 8; ++j) {
        const int col = lane * 4 + 256 * j;
        const f32x4 gv = *(const f32x4*)(g + col);
        const f32x4 sh = ldmod(0, col), sc = ldmod(1, col);
        const f32x4 o = v[j] * rstd * gv * (sc + 1.0f) + sh;
        uint2 w; w.x = pk2(o[0], o[1]); w.y = pk2(o[2], o[3]);
        *(uint2*)(orow + col) = w;
    }
}
namespace peer {
using f32x16 = __attribute__((ext_vector_type(16))) float;
using f32x2 = __attribute__((ext_vector_type(2))) float;
__device__ __forceinline__ int crow(int r, int hi) { return (r & 3) + 8 * (r >> 2) + 4 * hi; }
__device__ __forceinline__ float med3(float a, float b, float c) { return __builtin_amdgcn_fmed3f(a, b, c); }
__device__ __forceinline__ void ins16(float (&l)[16], float x) {
#pragma unroll
    for (int i = 15; i >= 1; --i) l[i] = med3(l[i - 1], l[i], x);
    l[0] = fmaxf(l[0], x);
}
__device__ __forceinline__ void merge_pair(float (&l)[16]) {
    float c[16];
#pragma unroll
    for (int i = 0; i < 16; ++i) { const float o = __shfl_xor(l[15 - i], 32); c[i] = fmaxf(l[i], o); }
#pragma unroll
    for (int d = 8; d >= 1; d >>= 1)
#pragma unroll
        for (int i = 0; i < 16; ++i) if ((i & d) == 0) { const float a = c[i], b = c[i + d]; c[i] = fmaxf(a, b); c[i + d] = fminf(a, b); }
#pragma unroll
    for (int i = 0; i < 16; ++i) l[i] = c[i];
}
__device__ __forceinline__ void topk_unit(int t0, int h, const bf16* __restrict__ qp16, const bf16* __restrict__ keys16, const float* __restrict__ su, const float* __restrict__ sv,
                                          int* __restrict__ eidx, float* __restrict__ egsv, float* __restrict__ esu, LAS unsigned char* scr, int lane) {
    const int r32 = lane & 31, hi = lane >> 5;
    float la[16], lb[16];
#pragma unroll
    for (int p = 0; p < 2; ++p) {
        f32x16 acc[4] = {};
        const bf16* qrow = qp16 + (size_t)(t0 + r32) * D + h * 256 + p * 128 + hi * 8;
        const bf16* kbase = keys16 + ((size_t)(h * 2 + p) * PNK + r32) * 128 + hi * 8;
#pragma unroll 4
        for (int ks = 0; ks < 8; ++ks) {
            const bf16x8 qf = *(const bf16x8*)(qrow + ks * 16);
#pragma unroll
            for (int kb = 0; kb < 4; ++kb) {
                const bf16x8 kf = *(const bf16x8*)(kbase + (size_t)kb * 32 * 128 + ks * 16);
                acc[kb] = __builtin_amdgcn_mfma_f32_32x32x16_bf16(kf, qf, acc[kb], 0, 0, 0);
            }
        }
        float l[16];
#pragma unroll
        for (int i = 0; i < 16; ++i) l[i] = -INFINITY;
#pragma unroll
        for (int kb = 0; kb < 4; ++kb)
#pragma unroll
            for (int r = 0; r < 16; ++r) {
                const unsigned k = (unsigned)(32 * kb + crow(r, hi));
                const float x = __uint_as_float((__float_as_uint(acc[kb][r]) & ~0x7Fu) | k);
                ins16(l, x);
            }
        merge_pair(l);
        if (p == 0) {
#pragma unroll
            for (int i = 0; i < 16; ++i) la[i] = l[i];
        } else {
#pragma unroll
            for (int i = 0; i < 16; ++i) lb[i] = l[i];
        }
    }
    {
        unsigned w[4];
#pragma unroll
        for (int q = 0; q < 4; ++q) {
            unsigned x = 0;
#pragma unroll
            for (int e = 0; e < 4; ++e) { float va = la[4 * q + e], vb_ = lb[4 * q + e]; asm volatile("" : "+v"(va), "+v"(vb_)); const float v = hi ? vb_ : va; x |= (__float_as_uint(v) & 0x7Fu) << (8 * e); }
            w[q] = x;
        }
        *(LAS v4u*)(scr + r32 * 32 + hi * 16) = (v4u){w[0], w[1], w[2], w[3]};
    }
    float l[16];
#pragma unroll
    for (int i = 0; i < 16; ++i) l[i] = -INFINITY;
    {
        int n = 0; float pend = 0.f;
#pragma unroll
        for (int i = 0; i < 16; ++i)
#pragma unroll
            for (int j = 0; j < 16; ++j) if ((i + 1) * (j + 1) <= 16) {
                const float s = la[i] + lb[j];
                const float x = __uint_as_float((__float_as_uint(s) & ~0xFFu) | (unsigned)(i * 16 + j));
                if ((n & 1) == 0) pend = x; else ins16(l, hi ? x : pend);
                ++n;
            }
    }
    merge_pair(l);
    asm volatile("s_waitcnt lgkmcnt(0)" ::: "memory");
    float ex[16], sum = 0.f;
#pragma unroll
    for (int i = 0; i < 16; ++i) { ex[i] = __expf(l[i] - l[0]); sum += ex[i]; }
    const float inv = 1.0f / sum;
    const size_t ob = ((size_t)(t0 + r32) * PH + h) * PTOPK + hi * 8;
#pragma unroll
    for (int n = 0; n < 8; ++n) {
        float vlo = l[n], vhi = l[8 + n], elo = ex[n], ehi = ex[8 + n];
        asm volatile("" : "+v"(vlo), "+v"(vhi), "+v"(elo), "+v"(ehi));
        const float v = hi ? vhi : vlo;
        const float g = (hi ? ehi : elo) * inv;
        const unsigned c = __float_as_uint(v) & 0xFFu;
        const unsigned ia = scr[r32 * 32 + (c >> 4)], ib = scr[r32 * 32 + 16 + (c & 15)];
        const int e = (int)(ia * PNK + ib);
        eidx[ob + n] = e; egsv[ob + n] = g;
    }
}

__device__ __forceinline__ f32x2 cvt8(unsigned w, bool hiw) { return hiw ? __builtin_amdgcn_cvt_pk_f32_fp8((int)w, true) : __builtin_amdgcn_cvt_pk_f32_fp8((int)w, false); }
__device__ __forceinline__ void peer_token(int t, const bf16* __restrict__ f16, const int* __restrict__ eidx, const float* __restrict__ egsv, const float* __restrict__ esu,
                                           const unsigned char* __restrict__ U8, const unsigned char* __restrict__ V8, const float* __restrict__ g2, const float* __restrict__ fg,
                                           const float* xin, float* xout, int lane) {
    f32x2 fr[16], acc[16];
    {
        const bf16* fp = f16 + (size_t)t * D + lane * 16;
        const v4u a0 = *(const v4u*)fp, a1 = *(const v4u*)(fp + 8), b0 = *(const v4u*)(fp + 1024), b1 = *(const v4u*)(fp + 1032);
        const unsigned w[16] = {a0.x, a0.y, a0.z, a0.w, a1.x, a1.y, a1.z, a1.w, b0.x, b0.y, b0.z, b0.w, b1.x, b1.y, b1.z, b1.w};
#pragma unroll
        for (int i = 0; i < 16; ++i) { fr[i] = (f32x2){__uint_as_float(w[i] << 16), __uint_as_float(w[i] & 0xFFFF0000u)}; acc[i] = (f32x2){0.f, 0.f}; }
    }
    const int e_a = eidx[(size_t)t * 128 + lane], e_b = eidx[(size_t)t * 128 + 64 + lane];
    const float g_a = egsv[(size_t)t * 128 + lane], g_b = egsv[(size_t)t * 128 + 64 + lane];
    const float s_a = esu[(size_t)t * 128 + lane], s_b = esu[(size_t)t * 128 + 64 + lane];
    const int k2 = lane >> 4;
    v4u ub[4][2], vb[4][2];
#define LOADROWS(buf, base, grp) do { _Pragma("unroll") for (int k = 0; k < 4; ++k) { \
        const int ee = (grp) < 16 ? __builtin_amdgcn_readlane(e_a, ((grp) & 15) * 4 + k) : __builtin_amdgcn_readlane(e_b, ((grp) & 15) * 4 + k); \
        const unsigned char* rp = (base) + (size_t)ee * D + lane * 16; buf[k][0] = *(const v4u*)rp; buf[k][1] = *(const v4u*)(rp + 1024); } } while (0)
    LOADROWS(ub, U8, 0); LOADROWS(vb, V8, 0);
#pragma unroll 1
    for (int grp = 0; grp < 32; ++grp) {
        float dt[4];
#pragma unroll
        for (int k = 0; k < 4; ++k) {
            f32x2 s = {0.f, 0.f};
#pragma unroll
            for (int hf = 0; hf < 2; ++hf) {
                const unsigned w[4] = {ub[k][hf].x, ub[k][hf].y, ub[k][hf].z, ub[k][hf].w};
#pragma unroll
                for (int q = 0; q < 4; ++q) { s += cvt8(w[q], false) * fr[hf * 8 + q * 2]; s += cvt8(w[q], true) * fr[hf * 8 + q * 2 + 1]; }
            }
            dt[k] = s[0] + s[1];
        }
        if (grp + 1 < 32) LOADROWS(ub, U8, grp + 1);
        {
            auto r0 = __builtin_amdgcn_permlane32_swap(__float_as_uint(dt[0]), __float_as_uint(dt[2]), false, false);
            auto r1 = __builtin_amdgcn_permlane32_swap(__float_as_uint(dt[1]), __float_as_uint(dt[3]), false, false);
            float x0 = __uint_as_float(r0[0]) + __uint_as_float(r0[1]);
            float x1 = __uint_as_float(r1[0]) + __uint_as_float(r1[1]);
            const bool b4 = (lane & 16) != 0;
            const float keep = b4 ? x1 : x0, send = b4 ? x0 : x1;
            float y = keep + __shfl_xor(send, 16);
            y += __shfl_xor(y, 8); y += __shfl_xor(y, 4); y += __shfl_xor(y, 2); y += __shfl_xor(y, 1);
            dt[0] = y;
        }
        const int ent = (grp & 15) * 4 + k2;
        const float gsv = grp < 16 ? __shfl(g_a, ent) : __shfl(g_b, ent);
        const float isu = grp < 16 ? __shfl(s_a, ent) : __shfl(s_b, ent);
        const float dv = dt[0] * isu;
        const float wgt = gsv * 0.5f * dv * (1.f + erff(dv * 0.70710678118654752f));
#pragma unroll
        for (int k = 0; k < 4; ++k) {
            const float wk = __uint_as_float(__builtin_amdgcn_readlane(__float_as_uint(wgt), 16 * k));
            const f32x2 wk2 = {wk, wk};
#pragma unroll
            for (int hf = 0; hf < 2; ++hf) {
                const unsigned w[4] = {vb[k][hf].x, vb[k][hf].y, vb[k][hf].z, vb[k][hf].w};
#pragma unroll
                for (int q = 0; q < 4; ++q) { acc[hf * 8 + q * 2] += cvt8(w[q], false) * wk2; acc[hf * 8 + q * 2 + 1] += cvt8(w[q], true) * wk2; }
            }
        }
        if (grp + 1 < 32) LOADROWS(vb, V8, grp + 1);
    }
#undef LOADROWS
    const float* xr = xin + (size_t)t * D + lane * 16; float* xw = xout + (size_t)t * D + lane * 16;
    const float* gr = g2 + lane * 16; const float* fgr = fg + lane * 16;
    f32x4 xv[8]; float ss = 0.f;
#pragma unroll
    for (int j = 0; j < 8; ++j) {
        const int off = (j >> 2) * 1024 + (j & 3) * 4;
        const f32x4 x1v = *(const f32x4*)(xr + off), gv = *(const f32x4*)(gr + off);
        const f32x4 pv = {acc[2 * j][0], acc[2 * j][1], acc[2 * j + 1][0], acc[2 * j + 1][1]};
        xv[j] = x1v + gv * pv;
        ss += (xv[j][0] * xv[j][0] + xv[j][1] * xv[j][1]) + (xv[j][2] * xv[j][2] + xv[j][3] * xv[j][3]);
    }
    ss = wave_sum(ss);
    const float rstd = 1.0f / sqrtf(ss * (1.0f / D) + EPS);
#pragma unroll
    for (int j = 0; j < 8; ++j) { const int off = (j >> 2) * 1024 + (j & 3) * 4; *(f32x4*)(xw + off) = xv[j] * rstd * *(const f32x4*)(fgr + off); }
}
}

#ifndef PEER_NSTU
#define PEER_NSTU 8
#endif
#ifndef PEER_NSTV
#define PEER_NSTV 4
#endif
namespace peer {
__device__ __forceinline__ void sort128x4(int (&key)[4][2], int lane) {
#pragma unroll
    for (int k = 2; k <= 128; k <<= 1) {
#pragma unroll
        for (int j = k >> 1; j > 0; j >>= 1) {
            if (j == 64) {
#pragma unroll
                for (int t = 0; t < 4; ++t) { const int a = key[t][0], b = key[t][1]; key[t][0] = a < b ? a : b; key[t][1] = a < b ? b : a; }
            } else {
                const bool lower = (lane & j) == 0;
#pragma unroll
                for (int r = 0; r < 2; ++r) {
                    const int i = r * 64 + lane;
                    const bool keepmin = (lower == ((i & k) == 0));
#pragma unroll
                    for (int t = 0; t < 4; ++t) {
                        const int o = __shfl_xor(key[t][r], j);
                        const int mn = key[t][r] < o ? key[t][r] : o, mx = key[t][r] < o ? o : key[t][r];
                        key[t][r] = keepmin ? mn : mx;
                    }
                }
            }
        }
    }
}
__device__ __forceinline__ float dot32_i4(const v4u u, unsigned sc, const int (&fa)[4], const int (&fb)[4]) {
    const unsigned w[4] = {u.x, u.y, u.z, u.w};
    int s = 0;
#pragma unroll
    for (int d = 0; d < 4; ++d) {
        s = __builtin_amdgcn_sdot4((int)((w[d] << 4) & 0xF0F0F0F0u), fa[d], s, false);
        s = __builtin_amdgcn_sdot4((int)(w[d] & 0xF0F0F0F0u), fb[d], s, false);
    }
    return (float)s * __uint_as_float(sc << 16);
}
__device__ __forceinline__ float gelu_as(float v) {
    const float av = fabsf(v), t = __builtin_amdgcn_rcpf(av * 0.2316418882f + 1.0f);
    float q = t * 0.5307027145f + (-0.7265760135f); q = q * t + 0.7107068705f; q = q * t + (-0.142248368f); q = q * t + 0.127414796f; q = q * t;
    const float e = __builtin_amdgcn_exp2f((v * v) * (-0.72134752044f));
    const float m = v * (q * e);
    return v < 0.f ? m : v - m;
}
__device__ __forceinline__ float bfu(unsigned h) { return __uint_as_float(h << 16); }
__device__ __forceinline__ int qi8(float x, float qs) { return (int)rintf(x * qs) & 0xFF; }
__device__ __forceinline__ void axpy16(f32x2 (&a)[8], const v4u v, float wk) {
    f32x2 wk2 = {wk, wk};
    const unsigned w[4] = {v.x, v.y, v.z, v.w};
#pragma unroll
    for (int q = 0; q < 4; ++q) {
        const f32x2 c0 = cvt8(w[q], false), c1 = cvt8(w[q], true);
        asm volatile("v_pk_fma_f32 %0, %1, %2, %0" : "+v"(a[q * 2]) : "v"(c0), "v"(wk2));
        asm volatile("v_pk_fma_f32 %0, %1, %2, %0" : "+v"(a[q * 2 + 1]) : "v"(c1), "v"(wk2));
    }
}
__device__ __forceinline__ void loadf8(f32x2 (&f)[8], const bf16* fp) {
    const v4u a0 = *(const v4u*)fp, a1 = *(const v4u*)(fp + 8);
    const unsigned w[8] = {a0.x, a0.y, a0.z, a0.w, a1.x, a1.y, a1.z, a1.w};
#pragma unroll
    for (int i = 0; i < 8; ++i) f[i] = (f32x2){__uint_as_float(w[i] << 16), __uint_as_float(w[i] & 0xFFFF0000u)};
}
#define RFL_I(x) __builtin_amdgcn_readfirstlane(x)
#define RFL_F(x) __uint_as_float(__builtin_amdgcn_readfirstlane(__float_as_uint(x)))

__device__ __forceinline__ void peer_usweep(const int (&fa0)[4], const int (&fb0)[4], const int (&fa1)[4], const int (&fb1)[4], const int (&fa2)[4], const int (&fb2)[4],
                                            const int (&fa3)[4], const int (&fb3)[4], float sfk, const unsigned char* __restrict__ U4,
                                            LAS int* skey, LAS float* sgs, LAS float* sw, int lane) {
    const unsigned char* ubase = U4 + lane * 16; const unsigned char* sbase = U4 + 1024 + lane * 2;
    const int k2 = lane >> 4;
    constexpr int NST = PEER_NSTU;
    v4u ub[NST][4]; unsigned us[NST][4];
#define LOADU(S, I) do { _Pragma("unroll") for (int tk = 0; tk < 4; ++tk) { const size_t ro = (size_t)(RFL_I(skey[tk * 128 + (I)]) >> 7) * U4_ROW; \
        ub[S][tk] = *(const v4u*)(ubase + ro); us[S][tk] = *(const unsigned short*)(sbase + ro); } } while (0)
#pragma unroll
    for (int s = 0; s < NST - 1; ++s) LOADU(s, s);
#pragma unroll 1
    for (int i0 = 0; i0 < 128; i0 += NST) {
#pragma unroll
        for (int s = 0; s < NST; ++s) {
            const int i = i0 + s;
            if (i + NST - 1 < 128) LOADU((s + NST - 1) % NST, i + NST - 1);
            const float d0 = dot32_i4(ub[s][0], us[s][0], fa0, fb0), d1 = dot32_i4(ub[s][1], us[s][1], fa1, fb1);
            const float d2 = dot32_i4(ub[s][2], us[s][2], fa2, fb2), d3 = dot32_i4(ub[s][3], us[s][3], fa3, fb3);
            auto r0 = __builtin_amdgcn_permlane32_swap(__float_as_uint(d0), __float_as_uint(d2), false, false);
            auto r1 = __builtin_amdgcn_permlane32_swap(__float_as_uint(d1), __float_as_uint(d3), false, false);
            const float x0 = __uint_as_float(r0[0]) + __uint_as_float(r0[1]);
            const float x1 = __uint_as_float(r1[0]) + __uint_as_float(r1[1]);
            const bool b4 = (lane & 16) != 0;
            const float keep = b4 ? x1 : x0, send = b4 ? x0 : x1;
            float y = keep + __shfl_xor(send, 16);
            y += __shfl_xor(y, 8); y += __shfl_xor(y, 4); y += __shfl_xor(y, 2); y += __shfl_xor(y, 1);
            const int nn = k2 * 128 + (skey[k2 * 128 + i] & 127);
            const float dv = y * sfk;
            const float wgt = sgs[nn] * gelu_as(dv);
            if ((lane & 15) == 0) sw[k2 * 128 + i] = wgt;
        }
    }
#undef LOADU
}
__device__ __forceinline__ void axpy32_fp4(f32x2 (&a)[16], const v4u v, float wks) {
    f32x2 wk2 = {wks, wks};
    const unsigned w[4] = {v.x, v.y, v.z, v.w};
#pragma unroll
    for (int d = 0; d < 4; ++d) {
        const f32x2 c0 = __builtin_amdgcn_cvt_scalef32_pk_f32_fp4(w[d], 1.0f, 0), c1 = __builtin_amdgcn_cvt_scalef32_pk_f32_fp4(w[d], 1.0f, 1);
        const f32x2 c2 = __builtin_amdgcn_cvt_scalef32_pk_f32_fp4(w[d], 1.0f, 2), c3 = __builtin_amdgcn_cvt_scalef32_pk_f32_fp4(w[d], 1.0f, 3);
        asm volatile("v_pk_fma_f32 %0, %1, %2, %0" : "+v"(a[4 * d + 0]) : "v"(c0), "v"(wk2));
        asm volatile("v_pk_fma_f32 %0, %1, %2, %0" : "+v"(a[4 * d + 1]) : "v"(c1), "v"(wk2));
        asm volatile("v_pk_fma_f32 %0, %1, %2, %0" : "+v"(a[4 * d + 2]) : "v"(c2), "v"(wk2));
        asm volatile("v_pk_fma_f32 %0, %1, %2, %0" : "+v"(a[4 * d + 3]) : "v"(c3), "v"(wk2));
    }
}
__device__ __forceinline__ void peer_vsweep(const unsigned char* __restrict__ V4, LAS int* skey, LAS float* sw, f32x2 (&a0)[16], f32x2 (&a1)[16], f32x2 (&a2)[16], f32x2 (&a3)[16], int lane) {
    const unsigned char* vbase = V4 + lane * 16; const unsigned char* sbase = V4 + 1024 + lane * 2;
    constexpr int NST = PEER_NSTV;
    v4u vb[NST][4]; unsigned vs[NST][4];
#define LOADV(S, I) do { _Pragma("unroll") for (int tk = 0; tk < 4; ++tk) { const size_t ro = (size_t)(RFL_I(skey[tk * 128 + (I)]) >> 7) * U4_ROW; \
        vb[S][tk] = *(const v4u*)(vbase + ro); vs[S][tk] = *(const unsigned short*)(sbase + ro); } } while (0)
#pragma unroll
    for (int s = 0; s < NST - 1; ++s) LOADV(s, s);
#pragma unroll 1
    for (int i0 = 0; i0 < 128; i0 += NST) {
#pragma unroll
        for (int s = 0; s < NST; ++s) {
            const int i = i0 + s;
            if (i + NST - 1 < 128) LOADV((s + NST - 1) % NST, i + NST - 1);
            axpy32_fp4(a0, vb[s][0], RFL_F(sw[0 * 128 + i]) * bfu(vs[s][0])); axpy32_fp4(a1, vb[s][1], RFL_F(sw[1 * 128 + i]) * bfu(vs[s][1]));
            axpy32_fp4(a2, vb[s][2], RFL_F(sw[2 * 128 + i]) * bfu(vs[s][2])); axpy32_fp4(a3, vb[s][3], RFL_F(sw[3 * 128 + i]) * bfu(vs[s][3]));
        }
    }
#undef LOADV
}
__device__ __forceinline__ void peer_finish4(int t, const f32x2 (&a)[16], const GAS float* g2, const GAS float* fg, const GAS float* xin, GAS float* xout, int lane) {
    const GAS float* xr = xin + (size_t)t * D + lane * 4; GAS float* xw = xout + (size_t)t * D + lane * 4;
    f32x4 xv[8]; float ss = 0.f;
#pragma unroll
    for (int j = 0; j < 8; ++j) {
        const f32x4 x1v = *(const GAS f32x4*)(xr + 256 * j), gv = *(const GAS f32x4*)(g2 + lane * 4 + 256 * j);
        const f32x4 pv = {a[2 * j][0], a[2 * j][1], a[2 * j + 1][0], a[2 * j + 1][1]};
        xv[j] = x1v + gv * pv;
        ss += (xv[j][0] * xv[j][0] + xv[j][1] * xv[j][1]) + (xv[j][2] * xv[j][2] + xv[j][3] * xv[j][3]);
    }
    ss = wave_sum(ss);
    const float rstd = 1.0f / sqrtf(ss * (1.0f / D) + EPS);
#pragma unroll
    for (int j = 0; j < 8; ++j) *(GAS f32x4*)(xw + 256 * j) = xv[j] * rstd * *(const GAS f32x4*)(fg + lane * 4 + 256 * j);
}
__device__ __forceinline__ float peer_x2(f32x2 (&a)[8], const GAS float* xr, const GAS float* gr) {
    float ss = 0.f;
#pragma unroll
    for (int j = 0; j < 4; ++j) {
        const f32x4 x1v = *(const GAS f32x4*)(xr + j * 4), gv = *(const GAS f32x4*)(gr + j * 4);
        const f32x4 pv = {a[2 * j][0], a[2 * j][1], a[2 * j + 1][0], a[2 * j + 1][1]};
        const f32x4 o = x1v + gv * pv;
        a[2 * j] = (f32x2){o[0], o[1]}; a[2 * j + 1] = (f32x2){o[2], o[3]};
        ss += (o[0] * o[0] + o[1] * o[1]) + (o[2] * o[2] + o[3] * o[3]);
    }
    return ss;
}
__device__ __forceinline__ void peer_store_raw(const f32x2 (&a)[8], float* __restrict__ xw) {
#pragma unroll
    for (int j = 0; j < 4; ++j) { const f32x4 o = {a[2 * j][0], a[2 * j][1], a[2 * j + 1][0], a[2 * j + 1][1]}; *(f32x4*)(xw + j * 4) = o; }
}
__device__ __forceinline__ void peer_rescale(float rstd, const GAS float* fgr, float* xw_) {
    GAS float* xw = (GAS float*)xw_; asm volatile("" : "+v"(xw));
#pragma unroll
    for (int j = 0; j < 4; ++j) { const f32x4 o = *(const GAS f32x4*)(xw + j * 4); *(GAS f32x4*)(xw + j * 4) = o * rstd * *(const GAS f32x4*)(fgr + j * 4); }
}
__device__ __forceinline__ void peer_store(const f32x2 (&a)[8], float rstd, const GAS float* fgr, float* __restrict__ xw) {
#pragma unroll
    for (int j = 0; j < 4; ++j) { const f32x4 o = {a[2 * j][0], a[2 * j][1], a[2 * j + 1][0], a[2 * j + 1][1]}; *(f32x4*)(xw + j * 4) = o * rstd * *(const GAS f32x4*)(fgr + j * 4); }
}

__device__ __forceinline__ void peer_wave4(int t0, const bf16* __restrict__ f16, const int* __restrict__ eidx, const float* __restrict__ egsv, const float* __restrict__ esu,
                                           const unsigned char* __restrict__ U8, const unsigned char* __restrict__ V8, const float* __restrict__ g2, const float* __restrict__ fg,
                                           const float* xin, float* xout, LAS unsigned* lw, int lane, int probe) {
    LAS int* skey = (LAS int*)lw; LAS float* sgs = (LAS float*)(lw + 512); LAS float* sis = (LAS float*)(lw + 1024); LAS float* sw = (LAS float*)(lw + 1536);
    int key[4][2]; float gq[4][2];
#pragma unroll
    for (int tk = 0; tk < 4; ++tk)
#pragma unroll
        for (int r = 0; r < 2; ++r) { const size_t ix = (size_t)(t0 + tk) * 128 + r * 64 + lane; key[tk][r] = (eidx[ix] << 7) | (r * 64 + lane); gq[tk][r] = egsv[ix]; }
    uint2 fr_[4][8];
#pragma unroll
    for (int tk = 0; tk < 4; ++tk) { const bf16* fp_ = f16 + (size_t)(t0 + tk) * D + lane * 4;
#pragma unroll
        for (int j = 0; j < 8; ++j) fr_[tk][j] = *(const uint2*)(fp_ + 256 * j); }
#pragma unroll
    for (int tk = 0; tk < 4; ++tk)
#pragma unroll
        for (int r = 0; r < 2; ++r) sgs[tk * 128 + r * 64 + lane] = gq[tk][r];
    sort128x4(key, lane);
#pragma unroll
    for (int tk = 0; tk < 4; ++tk)
#pragma unroll
        for (int r = 0; r < 2; ++r) skey[tk * 128 + r * 64 + lane] = key[tk][r];
    {
        int fa0[4], fb0[4], fa1[4], fb1[4], fa2[4], fb2[4], fa3[4], fb3[4]; float sfk = 0.f;
        float am_[4];
#pragma unroll
        for (int tk = 0; tk < 4; ++tk) { float m = 0.f;
#pragma unroll
            for (int j = 0; j < 8; ++j) m = fmaxf(m, fmaxf(fmaxf(fabsf(bfu(fr_[tk][j].x & 0xFFFFu)), fabsf(bfu(fr_[tk][j].x >> 16))), fmaxf(fabsf(bfu(fr_[tk][j].y & 0xFFFFu)), fabsf(bfu(fr_[tk][j].y >> 16)))));
            am_[tk] = m; }
#pragma unroll
        for (int o = 1; o < 64; o <<= 1)
#pragma unroll
            for (int tk = 0; tk < 4; ++tk) am_[tk] = fmaxf(am_[tk], __shfl_xor(am_[tk], o));
#define QUANTF(TK, FA, FB) do { const float qs_ = am_[TK] > 0.f ? 127.f / am_[TK] : 0.f; \
        _Pragma("unroll") for (int d = 0; d < 4; ++d) { const uint2 p0_ = fr_[TK][2 * d], p1_ = fr_[TK][2 * d + 1]; \
            FA[d] = qi8(bfu(p0_.x & 0xFFFFu), qs_) | (qi8(bfu(p0_.y & 0xFFFFu), qs_) << 8) | (qi8(bfu(p1_.x & 0xFFFFu), qs_) << 16) | (qi8(bfu(p1_.y & 0xFFFFu), qs_) << 24); \
            FB[d] = qi8(bfu(p0_.x >> 16), qs_) | (qi8(bfu(p0_.y >> 16), qs_) << 8) | (qi8(bfu(p1_.x >> 16), qs_) << 16) | (qi8(bfu(p1_.y >> 16), qs_) << 24); } \
        if ((lane >> 4) == TK) sfk = am_[TK] * (1.0f / (127.f * 16.f)); } while (0)
        QUANTF(0, fa0, fb0); QUANTF(1, fa1, fb1); QUANTF(2, fa2, fb2); QUANTF(3, fa3, fb3);
#undef QUANTF
        __builtin_amdgcn_sched_barrier(0);
        if (probe != 3) peer_usweep(fa0, fb0, fa1, fb1, fa2, fb2, fa3, fb3, sfk, U8, skey, sgs, sw, lane);
    }
    __builtin_amdgcn_sched_barrier(0);
    {
        f32x2 a0[16], a1[16], a2[16], a3[16];
#pragma unroll
        for (int i = 0; i < 16; ++i) { a0[i] = (f32x2){0.f, 0.f}; a1[i] = a0[i]; a2[i] = a0[i]; a3[i] = a0[i]; }
        if (probe != 2) peer_vsweep(V8, skey, sw, a0, a1, a2, a3, lane);
        __builtin_amdgcn_sched_barrier(0);
        const GAS float* g2_ = (const GAS float*)g2; const GAS float* fg_ = (const GAS float*)fg; const GAS float* xin_ = (const GAS float*)xin; GAS float* xout_ = (GAS float*)xout;
        asm volatile("" : "+v"(g2_), "+v"(fg_), "+v"(xin_), "+v"(xout_));
        peer_finish4(t0 + 0, a0, g2_, fg_, xin_, xout_, lane); peer_finish4(t0 + 1, a1, g2_, fg_, xin_, xout_, lane);
        peer_finish4(t0 + 2, a2, g2_, fg_, xin_, xout_, lane); peer_finish4(t0 + 3, a3, g2_, fg_, xin_, xout_, lane);
    }
}
}
__device__ __forceinline__ void p0_transpose_item(const float* W, int K, int N, bf16* WT, int row_off, LAS float* scr, int item, int lane) {
    const int nblk = N / 32, kb = item / nblk, nb = item % nblk, k0 = 64 * kb, n0 = 32 * nb;
#pragma unroll 8
    for (int i = 0; i < 32; ++i) { const int kk = 2 * i + (lane >> 5); scr[kk * 33 + (lane & 31)] = W[(size_t)(k0 + kk) * N + n0 + (lane & 31)]; }
    LDS_WAIT(); asm volatile("" ::: "memory");
    const int c = lane & 7;
#pragma unroll
    for (int j = 0; j < 4; ++j) { const int n = (lane >> 3) + 8 * j; const LAS float* s = scr + (8 * c) * 33 + n;
        v4u o; o.x = pk2(s[0 * 33], s[1 * 33]); o.y = pk2(s[2 * 33], s[3 * 33]); o.z = pk2(s[4 * 33], s[5 * 33]); o.w = pk2(s[6 * 33], s[7 * 33]);
        *(GAS v4u*)(WT + (size_t)(row_off + n0 + n) * K + k0 + 8 * c) = o; }
    LDS_WAIT(); asm volatile("" ::: "memory");
}

constexpr int TBL_ROWS_IN_P2 = 12288;
struct Args { const float* in[20]; float* out; unsigned char* ws; int ph_lo, ph_hi, li, pad; };
__device__ __forceinline__ const float* karg_ptr(int off) {
    const __attribute__((address_space(4))) char* kp = (const __attribute__((address_space(4))) char*)__builtin_amdgcn_kernarg_segment_ptr();
    asm volatile("" : "+s"(off));
    return *(const float* const __attribute__((address_space(4)))*)(kp + off);
}

__global__ void __launch_bounds__(NWAVES * 64, 2) mega(Args args) {
    extern __shared__ __attribute__((aligned(16))) unsigned char lds[];
    LAS unsigned char* ldsl = (LAS unsigned char*)lds;
    volatile LAS unsigned* MISC = (volatile LAS unsigned*)(ldsl + MISC_OFF);
    const int G = gridDim.x;
#define PHASE_IDS() int tid = threadIdx.x; asm volatile("" : "+v"(tid)); const int lane = tid & 63, wave = __builtin_amdgcn_readfirstlane(tid >> 6); \
    const int gw = blockIdx.x * NWAVES + wave, NGW = G * NWAVES, gtid = blockIdx.x * (NWAVES * 64) + tid, gthreads = G * NWAVES * 64; (void)lane; (void)gw; (void)NGW; (void)gtid; (void)gthreads
    unsigned char* ws = args.ws;
    gu32* ctl = (gu32*)(ws + WS_CTL);
    for (int u = threadIdx.x; u < (LDS_BYTES - LDSCTL_OFF) / 4; u += NWAVES * 64) ((LAS unsigned*)(ldsl + LDSCTL_OFF))[u] = 0u;
    __syncthreads();
    XcdBarrier bar = xcd_barrier_post((unsigned*)(ctl + CW_BAR) + args.li * XCD_BAR_WORDS, MISC + 8);
    const int lo = args.ph_lo, hi = args.ph_hi;
#define IN(k) (lo <= (k) && (k) < hi)
#ifndef PROBE_MASK
#define PROBE_MASK 0
#endif
#define PROBE_REP(k) ((((PROBE_MASK) >> (k)) & 1) ? 2 : 1)
#define SEAM(k) do { if (IN(k) && (k) + 1 < hi) xcd_barrier(bar); } while (0)

#define ARGP(i) karg_ptr((i) * 8)
#define ARG_OUT ((float*)karg_ptr(160))
#define Wt_in ((bf16*)(ws + WS_WIN))
#define Wt_out ((bf16*)(ws + WS_WOUT))
#define Wt_q ((bf16*)(ws + WS_WQ))
#define pwT16 ((bf16*)(ws + WS_PWT16))
#define mod ((float*)(ws + WS_MOD))
#define rope ((float*)(ws + WS_ROPE))
#define adap ((float*)(ws + WS_ADAP))
#define ssq ((float*)(ws + WS_SSQ))

    if (IN(0)) for (int rp = 0; rp < PROBE_REP(0); ++rp) { if (rp) xcd_barrier(bar);
        PHASE_IDS();
        LAS float* scr = (LAS float*)(ldsl + RING_OFF + wave * 16384);
        const float* w_in = ARGP(7); const float* w_out = ARGP(13); const float* peer_wq = ARGP(15); const float* pool_w = ARGP(8);
        constexpr int I_IN = (D / 64) * (INW / 32), I_O = (D / 64) * (D / 32);
        for (int it = gw; it < I_IN + 2 * I_O + 32; it += NGW) {
            int r = it;
            if (r < I_IN) { p0_transpose_item(w_in, D, INW, Wt_in, 0, scr, r, lane); continue; } r -= I_IN;
            if (r < I_O) { p0_transpose_item(w_out, D, D, Wt_out, 0, scr, r, lane); continue; } r -= I_O;
            if (r < I_O) { p0_transpose_item(peer_wq, D, D, Wt_q, 0, scr, r, lane); continue; } r -= I_O;
            p0_transpose_item(pool_w + (size_t)(r >> 3) * 16384, 128, 128, pwT16 + (size_t)(r >> 3) * 16384, 0, scr, r & 7, lane);
        }
        { const float* keys = ARGP(16); bf16* keys16 = (bf16*)(ws + WS_KEYS16);
          for (int i = gtid; i < 2 * PH * PNK * 128 / 4; i += gthreads) { const f32x4 v = *(const f32x4*)(keys + (size_t)i * 4); uint2 o; o.x = pk2(v[0], v[1]); o.y = pk2(v[2], v[3]); *(uint2*)(keys16 + (size_t)i * 4) = o; } }
        p0_lam_rope(ARGP(11), (float*)(ws + WS_LAM), rope, gtid, gthreads);
        __syncthreads();
        { LAS float* sv = (LAS float*)(ldsl + RING_OFF); LAS float* red = sv + 5 * D;
          const float* cvec = ARGP(1); const float* cctx = ARGP(3); const float* ada_w = ARGP(4);
          for (int i = tid; i < 5 * D; i += NWAVES * 64) { const int r = i / D, k = i % D; const float xv = r < 4 ? cvec[r * D + k] : cctx[k]; sv[i] = xv / (1.f + expf(-xv)); }
          __syncthreads();
          for (int unit = blockIdx.x; unit < 768; unit += G) p0_ada_unit(unit, ada_w, adap, sv, red, wave, lane, tid); }
        { const float* pu = ARGP(17); const float* pv = ARGP(18);
          unsigned char* U8 = ws + WS_U8; unsigned char* V8 = ws + WS_V8; float* su = (float*)(ws + WS_SU); float* svs = (float*)(ws + WS_SV);
          for (int row = (G == 256 ? TBL_ROWS_IN_P2 : 0) + gw; row < 2 * NEXP; row += NGW) {
              if (row < NEXP) p0_row_to_i4(pu + (size_t)row * D, U8 + (size_t)row * U4_ROW, lane);
              else p0_row_to_fp4(pv + (size_t)(row - NEXP) * D, V8 + (size_t)(row - NEXP) * U4_ROW, lane);
          } }
    }
    SEAM(0);
    if (IN(1)) for (int rp = 0; rp < PROBE_REP(1); ++rp) { if (rp) xcd_barrier(bar);
        PHASE_IDS();
        const float* ada_b = ARGP(5); const float* norm1_g = ARGP(6); const float* ctxp = ARGP(2); const float* x = ARGP(0);
        bf16* h16 = (bf16*)(ws + WS_H16);
        if (tid < 240) { const int idx = blockIdx.x * 240 + tid; const int r = idx / (6 * D), col = idx % (6 * D);
            float s = ada_b[col];
#pragma unroll
            for (int ks = 0; ks < 16; ++ks) s += adap[((size_t)ks * 5 + r) * (6 * D) + col];
            mod[(size_t)r * (6 * D) + col] = s; }
        LAS float* modl = (LAS float*)(ldsl + RING_OFF);
        const int bb = blockIdx.x >> 6;
        for (int i = tid; i < 8192; i += NWAVES * 64) { const int r = i < 4096 ? bb : 4, col = i & 4095;
            float s = ada_b[col];
#pragma unroll
            for (int ks = 0; ks < 16; ++ks) s += adap[((size_t)ks * 5 + r) * (6 * D) + col];
            modl[i] = s; }
        __syncthreads();
#pragma unroll 1
        for (int j = 0; j < 4; ++j) { const int row = blockIdx.x * 32 + wave * 4 + j;
            norm_row_bf16(x + (size_t)row * D, norm1_g, [=](int which, int col) { return *(const LAS f32x4*)(modl + which * 2048 + col); }, h16 + (size_t)row * D, lane, 0.f, false); }
        if (wave < 4) { const int r = blockIdx.x * 4 + wave;
            norm_row_bf16(ctxp + (size_t)r * D, norm1_g, [=](int which, int col) { return *(const LAS f32x4*)(modl + 4096 + which * 2048 + col); }, h16 + (size_t)(NLAT + r) * D, lane, 0.f, false); }
    }
    SEAM(1);
    if (IN(2)) for (int rp = 0; rp < PROBE_REP(2); ++rp) { if (rp) xcd_barrier(bar);
        pg8::Gemm g{(const bf16*)(ws + WS_H16), Wt_in, NTOK, INW, D};
        pg8::InProjOrder S; S.init(G, (int)blockIdx.x);
        pg8::EpiInProj E{(bf16*)(ws + WS_ZP16), (bf16*)(ws + WS_Q16), (bf16*)(ws + WS_K16), (bf16*)(ws + WS_V16), rope};
        pg8::gemm_phase<pg8::EpiInProj, pg8::InProjOrder, true, true>(ldsl + RING_OFF, g, S, E);
        if (G == 256 && blockIdx.x >= 176) { PHASE_IDS();
            const float* pu = ARGP(17); unsigned char* U8 = ws + WS_U8; float* su = (float*)(ws + WS_SU);
            for (int row = (blockIdx.x - 176) * NWAVES + wave; row < TBL_ROWS_IN_P2; row += 80 * NWAVES) p0_row_to_i4(pu + (size_t)row * D, U8 + (size_t)row * U4_ROW, lane); }
    }
    SEAM(2);
    if (IN(3)) for (int rp = 0; rp < PROBE_REP(3); ++rp) { if (rp) xcd_barrier(bar);
        PHASE_IDS();
        bf16* mix16 = (bf16*)(ws + WS_MIX16);
        const float* pool_b = ARGP(9); const float* pool_scale = ARGP(10); const float* subln_g = ARGP(12);
        if (wave < 4) for (int tile = blockIdx.x; tile < NLAT / 32; tile += G) att::pool_item(tile, wave, (const bf16*)(ws + WS_ZP16), pwT16, pool_b, pool_scale, mix16, lane);
        const float lam = *(const float*)(ws + WS_LAM);
        for (int u = blockIdx.x; u < 768; u += G) {
            int bh, qb;
            if (G == 256) { const int i = u >> 8, c = u & 255, xcd = c & 7, j = c >> 3; bh = i * 16 + xcd * 2 + (j >> 4); qb = j & 15; }
            else { bh = u >> 4; qb = u & 15; }
            att::attn_unit(bh / NH, bh % NH, qb, (const bf16*)(ws + WS_Q16), (const bf16*)(ws + WS_K16), (const bf16*)(ws + WS_V16), mix16, lam, subln_g, (char*)lds + RING_OFF);
        }
    }
    SEAM(3);
    if (IN(4)) for (int rp = 0; rp < PROBE_REP(4); ++rp) { if (rp) xcd_barrier(bar);
        pg8::Gemm g{(const bf16*)(ws + WS_MIX16), Wt_out, NLAT, D, D};
        pg8::StaticOrder S; S.init(NLAT, D, G, (int)blockIdx.x);
        pg8::EpiOutProj E{ARGP(0), mod, ARG_OUT, (float*)(ws + WS_SSQ)};
        pg8::gemm_phase<pg8::EpiOutProj, pg8::StaticOrder, true, true>(ldsl + RING_OFF, g, S, E);
    }
    SEAM(4);
    if (IN(5)) for (int rp = 0; rp < PROBE_REP(5); ++rp) { if (rp) xcd_barrier(bar);
        PHASE_IDS();
        const float* norm2_g = ARGP(14); float* xo = ARG_OUT; bf16* f16 = (bf16*)(ws + WS_F16);
        const float* sh2 = mod + (size_t)(blockIdx.x >> 6) * (6 * D) + 3 * D; const float* sc2 = sh2 + D;
#pragma unroll 1
        for (int j = 0; j < 4; ++j) { const int row = blockIdx.x * 32 + wave * 4 + j;
            const float p = lane < 32 ? ssq[(size_t)row * 32 + lane] : 0.f;
            const float rstd = 1.0f / sqrtf(wave_sum(p) * (1.0f / D) + EPS);
            norm_row_bf16(xo + (size_t)row * D, norm2_g, [=](int which, int col) { return *(const f32x4*)((which ? sc2 : sh2) + col); }, f16 + (size_t)row * D, lane, rstd, true); }
    }
    SEAM(5);
    if (IN(6)) for (int rp = 0; rp < PROBE_REP(6); ++rp) { if (rp) xcd_barrier(bar);
        pg8::Gemm g{(const bf16*)(ws + WS_F16), Wt_q, NLAT, D, D};
        pg8::StaticOrder S; S.init(NLAT, D, G, (int)blockIdx.x);
        pg8::EpiBf16Plain E{(bf16*)(ws + WS_QP16), D};
        pg8::gemm_phase<pg8::EpiBf16Plain, pg8::StaticOrder, true, true>(ldsl + RING_OFF, g, S, E);
    }
    SEAM(6);
    if (IN(7)) for (int rp = 0; rp < PROBE_REP(7); ++rp) { if (rp) xcd_barrier(bar);
        PHASE_IDS();
        for (int unit = gw; unit < (NLAT / 32) * PH; unit += NGW)
            peer::topk_unit((unit >> 3) * 32, unit & 7, (const bf16*)(ws + WS_QP16), (const bf16*)(ws + WS_KEYS16), (const float*)(ws + WS_SU), (const float*)(ws + WS_SV),
                            (int*)(ws + WS_EIDX), (float*)(ws + WS_EGATE), (float*)(ws + WS_ESU), ldsl + RING_OFF + wave * 1024, lane);
    }
    if (IN(7) && 8 < hi) { asm volatile("s_waitcnt vmcnt(0)" ::: "memory"); __syncthreads();
        if (threadIdx.x == 0) { __builtin_amdgcn_fence(__ATOMIC_ACQUIRE, "agent"); asm volatile("s_waitcnt vmcnt(0)" ::: "memory"); }
        __syncthreads(); }
    if (IN(8)) for (int rp = 0; rp < PROBE_REP(8); ++rp) { if (rp) xcd_barrier(bar);
        PHASE_IDS();
        const float* fgp = ARGP(19); float* xo = ARG_OUT; float* xo2 = args.pad ? (float*)(ws + WS_ZF) : xo;
        { const int t0 = gw * 4;
          if (t0 < NLAT) peer::peer_wave4(t0, (const bf16*)(ws + WS_F16), (const int*)(ws + WS_EIDX), (const float*)(ws + WS_EGATE), (const float*)(ws + WS_ESU),
                             ws + WS_U8, ws + WS_V8, mod + (size_t)(t0 >> 11) * (6 * D) + 5 * D, fgp, xo, xo2, (LAS unsigned*)(ldsl + RING_OFF + wave * 8192), lane, args.pad); }
    }
#undef IN
#undef SEAM
#undef mod
#undef rope
#undef adap
#undef ssq
#undef Wt_in
#undef Wt_out
#undef Wt_q
#undef pwT16
}
extern "C" void kernel_launch(void* const* d_in, const int* in_sizes, int n_in, void* d_out, int out_size, void* d_ws, size_t ws_size, hipStream_t stream) {
    static int grid = 0;
    if (grid == 0) {
        if (n_in != 20 || out_size != NLAT * D || ws_size < WS_END) { fprintf(stderr, "kernel_launch: unexpected shapes (n_in %d out %d ws %zu)\n", n_in, out_size, ws_size); grid = -1; return; }
        int dev = 0, cus = 0, per_cu = 0;
        if (hipGetDevice(&dev) != hipSuccess || hipDeviceGetAttribute(&cus, hipDeviceAttributeMultiprocessorCount, dev) != hipSuccess) { grid = -1; return; }
        if (hipFuncSetAttribute((const void*)mega, hipFuncAttributeMaxDynamicSharedMemorySize, LDS_BYTES) != hipSuccess) { fprintf(stderr, "kernel_launch: hipFuncSetAttribute failed\n"); grid = -1; return; }
        if (hipOccupancyMaxActiveBlocksPerMultiprocessor(&per_cu, (const void*)mega, NWAVES * 64, LDS_BYTES) != hipSuccess || per_cu < 1) { fprintf(stderr, "kernel_launch: occupancy query says %d blocks per CU\n", per_cu); grid = -1; (void)hipGetLastError(); return; }
        (void)hipGetLastError();
        if (cus < 256) { fprintf(stderr, "kernel_launch: needs 256 CUs, device has %d\n", cus); grid = -1; return; }
        grid = 256;
    }
    if (grid < 0) return;
    unsigned char* ws = (unsigned char*)d_ws;
    (void)hipMemsetAsync(ws + WS_CTL, 0, CTL_ZERO_BYTES, stream);
    Args a{};
    for (int i = 0; i < 20; ++i) a.in[i] = (const float*)d_in[i];
    a.out = (float*)d_out; a.ws = ws;
#ifndef PROBE_PAD
#define PROBE_PAD 1
#endif
#ifndef PROBE_PHASE
    a.ph_lo = 0; a.ph_hi = 9; a.li = 0;
    hipLaunchKernelGGL(mega, dim3(grid), dim3(NWAVES * 64), LDS_BYTES, stream, a);
#else
    if (PROBE_PHASE > 0) { a.ph_lo = 0; a.ph_hi = PROBE_PHASE; a.li = 0; hipLaunchKernelGGL(mega, dim3(grid), dim3(NWAVES * 64), LDS_BYTES, stream, a); }
    for (int r = 0; r < PROBE_TIMES; ++r) { a.ph_lo = PROBE_PHASE; a.ph_hi = PROBE_PHASE + 1; a.li = 1; a.pad = (PROBE_PHASE == 8 && r + 1 < PROBE_TIMES) ? PROBE_PAD : 0;
        hipLaunchKernelGGL(mega, dim3(grid), dim3(NWAVES * 64), LDS_BYTES, stream, a); }
    a.pad = 0;
    if (PROBE_PHASE < 8) { a.ph_lo = PROBE_PHASE + 1; a.ph_hi = 9; a.li = 2; hipLaunchKernelGGL(mega, dim3(grid), dim3(NWAVES * 64), LDS_BYTES, stream, a); }
#endif
}
```

```cpp
#include <hip/hip_runtime.h>
#include <math.h>
#include <stdint.h>
#include <cstdio>

constexpr int D = 2048, NB = 4, L = 2048, CT = 256;
constexpr int NLAT = NB * L;
constexpr int NCTX = NB * CT;
constexpr int NTOK = NLAT + NCTX;
constexpr int INW = 5120, POOLW = 512, ATTW = 1536, NH = 12, DV = 128, DQK = 64;
constexpr int QOFF = POOLW, KOFF = POOLW + ATTW, VOFF = POOLW + 2 * ATTW;
constexpr int LK = CT + L;
constexpr int PH = 8, PNK = 128, PTOPK = 16, NEXP = PNK * PNK;
constexpr float EPS = 1e-6f;
namespace pg8 {
#define PG8_LAS __attribute__((address_space(3)))
typedef unsigned short bf16_t;
typedef short bf16x8 __attribute__((ext_vector_type(8)));
typedef float f32x4 __attribute__((ext_vector_type(4)));
typedef unsigned u32x4 __attribute__((ext_vector_type(4)));
constexpr int BM = 256, BK = 64, HALF = 128, HTB = HALF * BK * 2  , STAGE_BYTES = 8 * HTB, NXCD = 8, WGM = 8;

__host__ __device__ __forceinline__ int lds_byte(int r, int c) { const int st = (r >> 4) * 2 + (c >> 5), rr = r & 15, cc = c & 31, ob = rr * 64 + cc * 2; return st * 1024 + (ob ^ (((ob >> 9) & 1) << 5)); }
__host__ __device__ __forceinline__ void stage_rc(int b, int& R, int& C) { const int st = b / 1024, sb = b % 1024, swz = sb ^ (((sb >> 9) & 1) << 5); R = (st >> 1) * 16 + swz / 64; C = (st & 1) * 32 + (swz % 64) / 2; }
__host__ __device__ __forceinline__ int perm32(int rho) { const int n = rho >> 4, i = rho & 15; return 8 * (i >> 2) + 4 * n + (i & 3); }

struct Unit { int pm, pn; };
struct Gemm { const bf16_t* A; const bf16_t* Bt; int M, N, K; };

struct StaticOrder {
    int nM, nN, nwg, G, c;
    __host__ __device__ void init(int M, int N, int G_, int c_) { nM = M / BM; nN = N / BM; nwg = nM * nN; G = G_; c = c_; }
    __host__ __device__ bool next(int i, Unit& u) const {
        const long L = (long)i * G + c; if (L >= nwg) return false;
        int wgid = (int)L; { const int q = nwg / NXCD, r = nwg % NXCD, xcd = wgid % NXCD, off = wgid / NXCD; wgid = (xcd < r ? xcd * (q + 1) : r * (q + 1) + (xcd - r) * q) + off; }
        const int nig = WGM * nN, gid = wgid / nig, fm = gid * WGM, gsz = (nM - fm) < WGM ? (nM - fm) : WGM;
        u.pm = fm + ((wgid % nig) % gsz); u.pn = (wgid % nig) / gsz; return true;
    }
    __device__ __forceinline__ void a_ready(const Unit&) const {}
    __device__ __forceinline__ void done(const Unit&) const {}
};

__device__ __forceinline__ unsigned cvt_pk_bf16(float lo, float hi) { unsigned r; asm volatile("v_cvt_pk_bf16_f32 %0, %1, %2" : "=v"(r) : "v"(lo), "v"(hi)); return r; }
typedef unsigned u32x2 __attribute__((ext_vector_type(2)));
__device__ __forceinline__ void st8_wt(void* p, u32x2 v) {
    __hip_atomic_store((__attribute__((address_space(1))) unsigned long long*)p, ((unsigned long long)v.y << 32) | v.x, __ATOMIC_RELAXED, __HIP_MEMORY_SCOPE_AGENT);
}

struct InProjOrder {
    StaticOrder lat; int G, c;
    __device__ void init(int G_, int c_) { lat.init(8192, 5120, G_, c_); G = G_; c = c_; }
    __device__ bool next(int i, Unit& u) const {
        const int Lx = i * G + c;
        if (Lx < 640) return lat.next(i, u);
        const int j = Lx - 640; if (j >= 48) return false;
        u.pm = 32 + j / 12; u.pn = 8 + j % 12; return true;
    }
    __device__ __forceinline__ void a_ready(const Unit&) const {}
    __device__ __forceinline__ void done(const Unit&) const {}
};

struct EpiInProj {
    static constexpr bool PERM = false, AFTER_DRAIN = false;
    bf16_t *ZP, *Q, *Kb, *Vb; const float* rope;
    __device__ __forceinline__ void operator()(const f32x4 (&acc)[2][2][4][2], const Unit& u, int wr, int wc, int fr, int fq) const {
        const bool isctx = u.pm >= 32;
        const int kind = u.pn < 2 ? 0 : (u.pn < 8 ? 1 : (u.pn < 14 ? 2 : 3));
        const int pnl = kind == 0 ? u.pn : (kind == 1 ? u.pn - 2 : (kind == 2 ? u.pn - 8 : u.pn - 14));
        const int colt = pnl * 256 + wc * 32 + 4 * fq;
        bf16_t* dst = kind == 0 ? ZP : (kind == 1 ? Q : (kind == 2 ? Kb : Vb));
        const int ld = kind == 0 ? 512 : 1536;
        const bool dorope = (kind == 1 || kind == 2) && !isctx;
        const int ax = wc & 1;
#pragma unroll
        for (int ai = 0; ai < 2; ++ai)
#pragma unroll
            for (int m = 0; m < 4; ++m) {
                const int rl = ai * 128 + wr * 64 + m * 16 + fr;
                int orow, t = 0;
                if (!isctx) { const int g = u.pm * 256 + rl; t = g & 2047; orow = (kind >= 2) ? (g >> 11) * 2304 + 256 + t : g; }
                else orow = (u.pm - 32) * 2304 + rl;
                f32x4 cs0 = {1.f, 0.f, 1.f, 0.f}, cs1 = {1.f, 0.f, 1.f, 0.f};
                if (dorope) { const float* rp = rope + ((t * 2 + ax) * 16 + 4 * fq) * 2; cs0 = *(const f32x4*)rp; cs1 = *(const f32x4*)(rp + 4); }
#pragma unroll
                for (int bj = 0; bj < 2; ++bj) {
                    f32x4 v0 = acc[ai][bj][m][0], v1 = acc[ai][bj][m][1];
                    if (dorope) {
                        f32x4 o0, o1;
                        o0[0] = v0[0] * cs0[0] - v1[0] * cs0[1]; o1[0] = v0[0] * cs0[1] + v1[0] * cs0[0];
                        o0[1] = v0[1] * cs0[2] - v1[1] * cs0[3]; o1[1] = v0[1] * cs0[3] + v1[1] * cs0[2];
                        o0[2] = v0[2] * cs1[0] - v1[2] * cs1[1]; o1[2] = v0[2] * cs1[1] + v1[2] * cs1[0];
                        o0[3] = v0[3] * cs1[2] - v1[3] * cs1[3]; o1[3] = v0[3] * cs1[3] + v1[3] * cs1[2];
                        v0 = o0; v1 = o1;
                    }
                    bf16_t* p = dst + (size_t)orow * ld + colt + bj * 128;
                    u32x2 w0, w1; w0.x = cvt_pk_bf16(v0[0], v0[1]); w0.y = cvt_pk_bf16(v0[2], v0[3]); w1.x = cvt_pk_bf16(v1[0], v1[1]); w1.y = cvt_pk_bf16(v1[2], v1[3]);
                    *(u32x2*)p = w0; *(u32x2*)(p + 16) = w1;
                }
            }
    }
};

struct EpiOutProj {
    static constexpr bool PERM = false, AFTER_DRAIN = false;
    const float* x; const float* mod; float* x1; float* ssq;
    __device__ __forceinline__ void operator()(const f32x4 (&acc)[2][2][4][2], const Unit& u, int wr, int wc, int fr, int fq) const {
        const float* g1 = mod + (size_t)(u.pm >> 3) * (6 * 2048) + 2 * 2048;
        const int col0 = u.pn * 256 + wc * 32 + 4 * fq;
        f32x4 gv[2][2];
#pragma unroll
        for (int bj = 0; bj < 2; ++bj)
#pragma unroll
            for (int n = 0; n < 2; ++n) gv[bj][n] = *(const f32x4*)(g1 + col0 + bj * 128 + n * 16);
#pragma unroll
        for (int ai = 0; ai < 2; ++ai)
#pragma unroll
            for (int m = 0; m < 4; ++m) {
                const int row = u.pm * 256 + ai * 128 + wr * 64 + m * 16 + fr;
                float s = 0.f;
#pragma unroll
                for (int bj = 0; bj < 2; ++bj)
#pragma unroll
                    for (int n = 0; n < 2; ++n) {
                        const size_t off = (size_t)row * 2048 + col0 + bj * 128 + n * 16;
                        const f32x4 xv = *(const f32x4*)(x + off);
                        const f32x4 o = xv + gv[bj][n] * acc[ai][bj][m][n];
                        *(f32x4*)(x1 + off) = o;
                        s += (o[0] * o[0] + o[1] * o[1]) + (o[2] * o[2] + o[3] * o[3]);
                    }
                s += __shfl_xor(s, 16); s += __shfl_xor(s, 32);
                if (fq == 0) ssq[(size_t)row * 32 + u.pn * 4 + wc] = s;
            }
    }
};

struct EpiBf16Plain {
    static constexpr bool PERM = true, AFTER_DRAIN = false;
    bf16_t* O; int ldc;
    __device__ __forceinline__ void operator()(const f32x4 (&acc)[2][2][4][2], const Unit& u, int wr, int wc, int fr, int fq) const {
        const int row0 = u.pm * BM + wr * 64 + fr, col0 = u.pn * BM + wc * 32 + 8 * fq;
#pragma unroll
        for (int ai = 0; ai < 2; ++ai)
#pragma unroll
            for (int m = 0; m < 4; ++m) { bf16_t* rowp = O + (size_t)(row0 + ai * HALF + m * 16) * ldc + col0;
#pragma unroll
                for (int bj = 0; bj < 2; ++bj) { const f32x4 v0 = acc[ai][bj][m][0], v1 = acc[ai][bj][m][1];
                    u32x4 w; w.x = cvt_pk_bf16(v0[0], v0[1]); w.y = cvt_pk_bf16(v0[2], v0[3]); w.z = cvt_pk_bf16(v1[0], v1[1]); w.w = cvt_pk_bf16(v1[2], v1[3]);
                    *(u32x4*)(rowp + bj * HALF) = w; } }
    }
};

template <class Epi, class Sched, bool ALIGN_EPI = false, bool SP2 = false>
__device__ __forceinline__ void gemm_phase(PG8_LAS unsigned char* lds, const Gemm g, const Sched& S, const Epi& E) {
    const int tid = threadIdx.x, wid = __builtin_amdgcn_readfirstlane(tid >> 6), lane = tid & 63, wr = wid >> 2, wc = wid & 3, fr = lane & 15, fq = lane >> 4;
    const int K = g.K, nt = K / BK;
    unsigned voffA[2], voffB[2];
#pragma unroll
    for (int i = 0; i < 2; ++i) { int R, C; stage_rc(tid * 16 + i * 8192, R, C); const int Rb = Epi::PERM ? ((R & ~31) + perm32(R & 31)) : R;
        voffA[i] = (unsigned)(R * K + C) * 2u; voffB[i] = (unsigned)(Rb * K + C) * 2u; }
    const size_t kstep = (size_t)(BK * 2);
    const size_t hstep = (size_t)HALF * K * 2;
    const size_t tstep = 2 * hstep;
    const unsigned ldsw = (unsigned)wid * 1024u;
    const int aoff = lds_byte(wr * 64 + fr, fq * 8), boff = lds_byte(wc * 32 + fr, fq * 8);
#define PG8_SA(b, h) (((b) * 2 + (h)) * HTB)
#define PG8_SB(b, h) ((4 + (b) * 2 + (h)) * HTB)
#define PG8_STAGE(bufoff, gbase, voff) do { _Pragma("unroll") for (int _i = 0; _i < 2; ++_i) \
        __builtin_amdgcn_global_load_lds((const unsigned*)((const char*)(gbase) + (voff)[_i]), (PG8_LAS unsigned*)(lds + (bufoff) + ldsw + _i * 8192), 16, 0, 0); } while (0)
#define PG8_LDA(dst, b, h) do { _Pragma("unroll") for (int m = 0; m < 4; ++m) _Pragma("unroll") for (int k = 0; k < 2; ++k) dst[m][k] = *(const PG8_LAS bf16x8*)(lds + PG8_SA(b, h) + aoff + m * 2048 + k * 1024); } while (0)
#define PG8_LDB(dst, b, h) do { _Pragma("unroll") for (int n = 0; n < 2; ++n) _Pragma("unroll") for (int k = 0; k < 2; ++k) dst[n][k] = *(const PG8_LAS bf16x8*)(lds + PG8_SB(b, h) + boff + n * 2048 + k * 1024); } while (0)
#define PG8_MMA(ai, bj, At, Bt) do { __builtin_amdgcn_s_setprio(1); _Pragma("unroll") for (int m = 0; m < 4; ++m) _Pragma("unroll") for (int n = 0; n < 2; ++n) _Pragma("unroll") for (int k = 0; k < 2; ++k) \
        acc[ai][bj][m][n] = __builtin_amdgcn_mfma_f32_16x16x32_bf16(Bt[n][k], At[m][k], acc[ai][bj][m][n], 0, 0, 0); __builtin_amdgcn_s_setprio(0); } while (0)
#define PG8_WAIT_V(n) asm volatile("s_waitcnt vmcnt(" #n ")" ::: "memory")
#define PG8_WAIT_L(n) asm volatile("s_waitcnt lgkmcnt(" #n ")" ::: "memory")
#define PG8_BAR __builtin_amdgcn_s_barrier()
#define PG8_SCHED __builtin_amdgcn_sched_barrier(0)
    Unit cur, nxt; int ui = 0;
    if (!S.next(0, cur)) return;
    f32x4 acc[2][2][4][2];
#pragma unroll
    for (int a = 0; a < 2; ++a)
#pragma unroll
        for (int b = 0; b < 2; ++b)
#pragma unroll
            for (int m = 0; m < 4; ++m)
#pragma unroll
                for (int n = 0; n < 2; ++n) acc[a][b][m][n] = (f32x4){0.f, 0.f, 0.f, 0.f};
    bf16x8 At[4][2], B0[2][2], B1[2][2];
    const char* cA = (const char*)g.A + (size_t)cur.pm * tstep; const char* cB = (const char*)g.Bt + (size_t)cur.pn * tstep;
    S.a_ready(cur);
    if constexpr (SP2) {
        PG8_STAGE(PG8_SB(0, 0), cB, voffB); PG8_STAGE(PG8_SB(0, 1), cB + hstep, voffB); PG8_STAGE(PG8_SA(0, 0), cA, voffA); PG8_STAGE(PG8_SA(0, 1), cA + hstep, voffA);
        if (wr == 1) PG8_BAR;
        PG8_WAIT_V(2); PG8_BAR;
        PG8_STAGE(PG8_SB(1, 0), cB + kstep, voffB); PG8_STAGE(PG8_SA(1, 0), cA + kstep, voffA); PG8_STAGE(PG8_SB(1, 1), cB + hstep + kstep, voffB);
        PG8_WAIT_V(6); PG8_BAR;
    } else {
        PG8_STAGE(PG8_SB(0, 0), cB, voffB); PG8_STAGE(PG8_SA(0, 0), cA, voffA); PG8_STAGE(PG8_SB(0, 1), cB + hstep, voffB); PG8_STAGE(PG8_SA(0, 1), cA + hstep, voffA);
        if (wr == 1) PG8_BAR;
        PG8_WAIT_V(4); PG8_BAR;
        PG8_STAGE(PG8_SB(1, 0), cB + kstep, voffB); PG8_STAGE(PG8_SA(1, 0), cA + kstep, voffA); PG8_STAGE(PG8_SB(1, 1), cB + hstep + kstep, voffB);
        PG8_WAIT_V(6); PG8_BAR;
    }
    for (;;) {
        const bool has_next = S.next(ui + 1, nxt);
        const char* nA = has_next ? (const char*)g.A + (size_t)nxt.pm * tstep : cA; const char* nB = has_next ? (const char*)g.Bt + (size_t)nxt.pn * tstep : cB;
        for (int t = 0; t < nt; t += 2) {
            const bool last = (t == nt - 2);
            const char* a1 = cA + (size_t)(t + 1) * kstep;
            const char* a2 = last ? nA : cA + (size_t)(t + 2) * kstep; const char* b2 = last ? nB : cB + (size_t)(t + 2) * kstep;
            const char* a3 = a2 + kstep; const char* b3 = b2 + kstep;
            if (last && has_next) S.a_ready(nxt);
            if constexpr (SP2) {
            PG8_LDB(B0, 0, 0); PG8_LDB(B1, 0, 1); PG8_SCHED; PG8_LDA(At, 0, 0); PG8_STAGE(PG8_SA(1, 1), a1 + hstep, voffA);
            PG8_WAIT_V(8); PG8_WAIT_L(0); PG8_BAR; PG8_MMA(0, 0, At, B0); PG8_MMA(0, 1, At, B1); PG8_BAR; PG8_SCHED;
            PG8_LDA(At, 0, 1); PG8_STAGE(PG8_SB(0, 0), b2, voffB); PG8_STAGE(PG8_SB(0, 1), b2 + hstep, voffB); PG8_STAGE(PG8_SA(0, 0), a2, voffA);
            PG8_WAIT_V(8); PG8_WAIT_L(0); PG8_BAR; PG8_MMA(1, 0, At, B0); PG8_MMA(1, 1, At, B1); PG8_BAR; PG8_SCHED;
            PG8_LDB(B0, 1, 0); PG8_LDB(B1, 1, 1); PG8_SCHED; PG8_LDA(At, 1, 0); PG8_STAGE(PG8_SA(0, 1), a2 + hstep, voffA);
            PG8_WAIT_V(8); PG8_WAIT_L(0); PG8_BAR; PG8_MMA(0, 0, At, B0); PG8_MMA(0, 1, At, B1); PG8_BAR; PG8_SCHED;
            PG8_LDA(At, 1, 1); PG8_STAGE(PG8_SB(1, 0), b3, voffB); PG8_STAGE(PG8_SB(1, 1), b3 + hstep, voffB); PG8_STAGE(PG8_SA(1, 0), a3, voffA);
            PG8_WAIT_V(8); PG8_WAIT_L(0); PG8_BAR; PG8_MMA(1, 0, At, B0); PG8_MMA(1, 1, At, B1); PG8_BAR; PG8_SCHED;
            } else {
            PG8_LDB(B0, 0, 0); PG8_SCHED; PG8_LDA(At, 0, 0); PG8_STAGE(PG8_SA(1, 1), a1 + hstep, voffA);
            PG8_WAIT_L(8); PG8_BAR; PG8_WAIT_L(0); PG8_MMA(0, 0, At, B0); PG8_BAR; PG8_SCHED;
            PG8_LDB(B1, 0, 1); PG8_STAGE(PG8_SB(0, 0), b2, voffB);
            PG8_BAR; PG8_WAIT_L(0); PG8_MMA(0, 1, At, B1); PG8_BAR;
            PG8_LDA(At, 0, 1); PG8_STAGE(PG8_SA(0, 0), a2, voffA);
            PG8_BAR; PG8_WAIT_L(0); PG8_MMA(1, 0, At, B0); PG8_BAR; PG8_SCHED;
            PG8_STAGE(PG8_SB(0, 1), b2 + hstep, voffB);
            PG8_WAIT_V(6); PG8_BAR; PG8_MMA(1, 1, At, B1); PG8_BAR;
            PG8_LDB(B0, 1, 0); PG8_SCHED; PG8_LDA(At, 1, 0); PG8_STAGE(PG8_SA(0, 1), a2 + hstep, voffA);
            PG8_WAIT_L(8); PG8_BAR; PG8_WAIT_L(0); PG8_MMA(0, 0, At, B0); PG8_BAR; PG8_SCHED;
            PG8_LDB(B1, 1, 1); PG8_STAGE(PG8_SB(1, 0), b3, voffB);
            PG8_BAR; PG8_WAIT_L(0); PG8_MMA(0, 1, At, B1); PG8_BAR;
            PG8_LDA(At, 1, 1); PG8_STAGE(PG8_SA(1, 0), a3, voffA);
            PG8_BAR; PG8_WAIT_L(0); PG8_MMA(1, 0, At, B0); PG8_BAR; PG8_SCHED;
            PG8_STAGE(PG8_SB(1, 1), b3 + hstep, voffB);
            PG8_WAIT_V(6); PG8_BAR; PG8_MMA(1, 1, At, B1); PG8_BAR;
            }
        }
        if constexpr (ALIGN_EPI) { if (wr == 0) PG8_BAR; }
        if constexpr (!Epi::AFTER_DRAIN) { E(acc, cur, wr, wc, fr, fq); S.done(cur); }
        if (!has_next) break;
#pragma unroll
        for (int a = 0; a < 2; ++a)
#pragma unroll
            for (int b = 0; b < 2; ++b)
#pragma unroll
                for (int m = 0; m < 4; ++m)
#pragma unroll
                    for (int n = 0; n < 2; ++n) acc[a][b][m][n] = (f32x4){0.f, 0.f, 0.f, 0.f};
        cur = nxt; cA = nA; cB = nB; ++ui;
        if constexpr (ALIGN_EPI) { if (wr == 1) PG8_BAR; }
    }
    PG8_WAIT_V(0);
    if constexpr (!ALIGN_EPI) { if (wr == 0) PG8_BAR; }
    PG8_BAR;
    if constexpr (Epi::AFTER_DRAIN) { E.fused(acc, cur, wr, wc, fr, fq, lds, wid, lane); S.done(cur); }
#undef PG8_SA
#undef PG8_SB
#undef PG8_STAGE
#undef PG8_LDA
#undef PG8_LDB
#undef PG8_MMA
#undef PG8_WAIT_V
#undef PG8_WAIT_L
#undef PG8_BAR
#undef PG8_SCHED
}
}
constexpr size_t MiB = 1u << 20, KiB = 1u << 10;
constexpr size_t WS_CTL = 0, CTL_ZERO_BYTES = 1 * MiB;
constexpr size_t WS_LAM = 1 * MiB;
constexpr size_t WS_ROPE = 1 * MiB + 64 * KiB;
constexpr size_t WS_MOD = 1 * MiB + 640 * KiB;
constexpr size_t WS_ADAP = 2 * MiB;
constexpr size_t WS_SSQ = 6 * MiB;
constexpr size_t WS_SU = 7 * MiB, WS_SV = 7 * MiB + 64 * KiB;
constexpr size_t WS_EIDX = 8 * MiB, WS_EGATE = 12 * MiB;
constexpr size_t WS_KEYS16 = 16 * MiB, WS_PWT16 = 16 * MiB + 512 * KiB;
constexpr size_t WS_WIN = 18 * MiB, WS_WOUT = 38 * MiB, WS_WQ = 46 * MiB;
constexpr size_t WS_HF = 54 * MiB, WS_ZF = 126 * MiB, WS_MIXF = 306 * MiB;
constexpr size_t WS_H16 = 370 * MiB, WS_Q16 = 406 * MiB, WS_K16 = 430 * MiB, WS_V16 = 457 * MiB, WS_ZP16 = 484 * MiB;
constexpr size_t WS_MIX16 = 370 * MiB, WS_F16 = 406 * MiB, WS_QP16 = 438 * MiB;
constexpr size_t WS_U8 = 192 * MiB, WS_V8 = 224 * MiB;
constexpr size_t WS_ESU = 256 * MiB;
constexpr size_t WS_END = 512 * MiB;
constexpr int CW_BAR = 4096;

constexpr int RING_OFF = 0, RING_BYTES = 131072;
constexpr int LDSCTL_OFF = RING_BYTES, MISC_OFF = LDSCTL_OFF + 320;
constexpr int LDS_BYTES = 147456;
constexpr int NWAVES = 8;
#define GAS __attribute__((address_space(1)))
#define LAS __attribute__((address_space(3)))
typedef unsigned short bf16;
typedef unsigned v4u __attribute__((ext_vector_type(4)));
typedef float f32x4 __attribute__((ext_vector_type(4)));
typedef short bf16x8 __attribute__((ext_vector_type(8)));
typedef GAS unsigned gu32;
typedef GAS unsigned long long gu64;
#define RLX_AGENT __ATOMIC_RELAXED, __HIP_MEMORY_SCOPE_AGENT
#define LDS_WAIT() asm volatile("s_waitcnt lgkmcnt(0)" ::: "memory")
#define VM_WAIT() asm volatile("s_waitcnt vmcnt(0)" ::: "memory")
__device__ __forceinline__ unsigned long long rt() { return __builtin_amdgcn_s_memrealtime(); }
__device__ __forceinline__ unsigned f2bf(float f) { unsigned u = __builtin_bit_cast(unsigned, f); return (u + 0x7fffu + ((u >> 16) & 1u)) >> 16; }
__device__ __forceinline__ unsigned pk2(float lo, float hi) { return f2bf(lo) | (f2bf(hi) << 16); }

#define XB_TMO      128
#define XB_XCNT(j)  (256  + 64 * (j))
#define XB_XSUB(j)  (1280 + 64 * (j))
#define XB_XGEN(j)  (2304 + 64 * (j))
#define XB_TOP      3328
#define XB_TOPGEN   3392
#define XCD_BAR_WORDS 3456
#define XB_SPIN_CAP (1u << 18)

__device__ __forceinline__ unsigned xb_ld(unsigned* p)              { return __hip_atomic_load(p, __ATOMIC_RELAXED, __HIP_MEMORY_SCOPE_AGENT); }
__device__ __forceinline__ unsigned xb_add(unsigned* p, unsigned v) { return __hip_atomic_fetch_add(p, v, __ATOMIC_RELAXED, __HIP_MEMORY_SCOPE_AGENT); }
__device__ __forceinline__ unsigned xb_xcc_id() { return (unsigned)__builtin_amdgcn_s_getreg((3 << 11) | 20) & 0xFu; }
#define XB_SPIN(cond, bar) do { unsigned _sp = 0; while (cond) { __builtin_amdgcn_s_sleep(1); \
    if ((++_sp & 255u) == 0u) { if (xb_ld(&(bar)[XB_TMO])) break; if (_sp > XB_SPIN_CAP) { atomicAdd(&(bar)[XB_TMO], 1u); break; } } } } while (0)

struct XcdBarrier {
    unsigned* bar; unsigned x;
    volatile LAS unsigned* st;
};

__device__ __forceinline__ XcdBarrier xcd_barrier_post(unsigned* bar, volatile LAS unsigned* st) {
    XcdBarrier b; b.bar = bar; b.x = xb_xcc_id(); b.st = st;
    if (threadIdx.x == 0) (void)xb_add(&bar[XB_XCNT(b.x)], 1u);
    return b;
}
__device__ __forceinline__ void xcd_barrier_complete(unsigned* bar, unsigned x, unsigned& nloc, unsigned& nx) {
    const unsigned G = gridDim.x * gridDim.y * gridDim.z;
    unsigned sum, cnt, mine, sp = 0u;
    for (;;) {
        sum = 0u; cnt = 0u; mine = 0u;
#pragma unroll
        for (unsigned j = 0; j < 16; ++j) { const unsigned c = xb_ld(&bar[XB_XCNT(j)]); sum += c; cnt += (c > 0u) ? 1u : 0u; mine = (j == x) ? c : mine; }
        if (sum == G) break;
        __builtin_amdgcn_s_sleep(1);
        if ((++sp & 255u) == 0u) { if (xb_ld(&bar[XB_TMO])) break; if (sp > XB_SPIN_CAP) { atomicAdd(&bar[XB_TMO], 1u); break; } }
    }
    nloc = mine > 0u ? mine : 1u; nx = cnt > 0u ? cnt : 1u;
}

__device__ __forceinline__ void xcd_barrier(const XcdBarrier& b) {
    asm volatile("s_waitcnt vmcnt(0)" ::: "memory");
    __syncthreads();
    if (threadIdx.x == 0) {
        unsigned* bar = b.bar;
        __builtin_amdgcn_s_waitcnt(0);
        unsigned nloc = b.st[0], nx = b.st[1];
        if (nloc == 0u) { xcd_barrier_complete(bar, b.x, nloc, nx); b.st[0] = nloc; b.st[1] = nx; }
        const unsigned old = xb_add(&bar[XB_XSUB(b.x)], 1u);
        const unsigned gen = old / nloc;
        if (old + 1u == (gen + 1u) * nloc) {
            __builtin_amdgcn_fence(__ATOMIC_RELEASE, "agent");
            asm volatile("s_waitcnt vmcnt(0)" ::: "memory");
            const unsigned og = xb_add(&bar[XB_TOP], 1u);
            const unsigned tg = og / nx;
            if (og + 1u == (tg + 1u) * nx) xb_add(&bar[XB_TOPGEN], 1u);
            else XB_SPIN(xb_ld(&bar[XB_TOPGEN]) == tg, bar);
            __builtin_amdgcn_fence(__ATOMIC_ACQUIRE, "agent");
            xb_add(&bar[XB_XGEN(b.x)], 1u);
            asm volatile("s_waitcnt vmcnt(0)" ::: "memory");
        } else {
            XB_SPIN(xb_ld(&bar[XB_XGEN(b.x)]) == gen, bar);
            __builtin_amdgcn_fence(__ATOMIC_ACQUIRE, "agent");
            asm volatile("s_waitcnt vmcnt(0)" ::: "memory");
        }
    }
    __syncthreads();
}
namespace att {
using s16x4  = __attribute__((ext_vector_type(4))) short;
using f32x16 = __attribute__((ext_vector_type(16))) float;
constexpr int NW = 8, QBLK = 32, KVBLK = 64, LDQ = 1536, LDK = 1536;
constexpr float SCALE = 0.125f, THR = 8.f;
constexpr int SHM_V = KVBLK * 128 * 2, SHM_K = KVBLK * 128 * 2;
#define KSWZ(row, colB) ((row) * 256 + ((colB) ^ (((row) & 7) << 4)))
#define SBAR() __builtin_amdgcn_sched_barrier(0)
__device__ __forceinline__ int crow(int r, int hi) { return (r & 3) + 8 * (r >> 2) + 4 * hi; }
__device__ __forceinline__ unsigned cvtpk(float lo, float hi) { unsigned r; asm volatile("v_cvt_pk_bf16_f32 %0, %1, %2" : "=v"(r) : "v"(lo), "v"(hi)); return r; }

__device__ __forceinline__ void partialSM(f32x16& p0, f32x16& p1, float& m_reg, float& mn, float& alpha) {
  constexpr float C = SCALE * 1.4426950408889634f;
  float pmax = p0[0]; for (int r = 1; r < 16; ++r) pmax = fmaxf(pmax, p0[r]); for (int r = 0; r < 16; ++r) pmax = fmaxf(pmax, p1[r]);
  { auto rr = __builtin_amdgcn_permlane32_swap(__float_as_uint(pmax), __float_as_uint(pmax), false, false);
    pmax = fmaxf(__uint_as_float(rr[0]), __uint_as_float(rr[1])); }
  if (__builtin_expect(__all(pmax - m_reg <= THR / SCALE), 1)) { mn = m_reg; alpha = 1.f; }
  else { mn = fmaxf(m_reg, pmax); alpha = __builtin_amdgcn_exp2f((m_reg - mn) * C); m_reg = mn; }
  float mnC = -mn * C;
  for (int r = 0; r < 16; ++r) p0[r] = fmaf(p0[r], C, mnC); for (int r = 0; r < 16; ++r) p1[r] = fmaf(p1[r], C, mnC);
  for (int r = 0; r < 16; ++r) p0[r] = __builtin_amdgcn_exp2f(p0[r]);
}
__device__ __forceinline__ void finishSM(f32x16& p0, f32x16& p1, float alpha, float& l_reg, bf16x8& pa0, bf16x8& pa1, bf16x8& pa2, bf16x8& pa3) {
  for (int r = 0; r < 16; ++r) p1[r] = __builtin_amdgcn_exp2f(p1[r]);
  float ps = 0; for (int r = 0; r < 16; ++r) ps += p0[r]; for (int r = 0; r < 16; ++r) ps += p1[r];
  { auto rr = __builtin_amdgcn_permlane32_swap(__float_as_uint(ps), __float_as_uint(ps), false, false);
    ps = __uint_as_float(rr[0]) + __uint_as_float(rr[1]); }
  l_reg = l_reg * alpha + ps;
#define PK4(P, BASE, OUT) do { unsigned a0 = cvtpk(P[BASE + 0], P[BASE + 1]), a1 = cvtpk(P[BASE + 2], P[BASE + 3]);   \
    unsigned b0 = cvtpk(P[BASE + 4], P[BASE + 5]), b1 = cvtpk(P[BASE + 6], P[BASE + 7]);                              \
    auto r0 = __builtin_amdgcn_permlane32_swap(a0, b0, false, false); auto r1 = __builtin_amdgcn_permlane32_swap(a1, b1, false, false); \
    v4u w = {r0[0], r1[0], r0[1], r1[1]}; OUT = *reinterpret_cast<bf16x8*>(&w); } while (0)
  PK4(p0, 0, pa0); PK4(p0, 8, pa1); PK4(p1, 0, pa2); PK4(p1, 8, pa3);
#undef PK4
}
__device__ __forceinline__ void qkt(f32x16& p0, f32x16& p1, const bf16* Ks, const bf16x8* qr, int r32, int hi, int mp) {
  p0 = f32x16{}; p1 = f32x16{};
  for (int d0 = 0; d0 < 4; ++d0) { int cb = (mp * 64 + d0 * 16 + hi * 8) * 2;
    bf16x8 b0 = *reinterpret_cast<const bf16x8*>((const char*)Ks + KSWZ(r32, cb));
    bf16x8 b1 = *reinterpret_cast<const bf16x8*>((const char*)Ks + KSWZ(32 + r32, cb));
    p0 = __builtin_amdgcn_mfma_f32_32x32x16_bf16(b0, qr[d0], p0, 0, 0, 0);
    p1 = __builtin_amdgcn_mfma_f32_32x32x16_bf16(b1, qr[d0], p1, 0, 0, 0); }
}
__device__ __forceinline__ int v_st(int k, int c) { const int kk = (k & ~0xC) | ((k & 4) << 1) | ((k & 8) >> 1); return ((kk >> 3) * 4 + (c >> 5)) * 512 + ((kk & 7) * 32 + (c & 31)) * 2; }
__device__ __forceinline__ int v_rd_base(int lane) { return ((lane & 3) << 3) | (((lane >> 2) & 3) << 6) | (((lane >> 4) & 1) << 5) | (((lane >> 5) & 1) << 8); }
constexpr int v_rd_off(int d0, int ks, int half) { return d0 * 512 + ks * 4096 + half * 2048; }
template <int OFF> __device__ __forceinline__ s16x4 tr_read(int vb) {
  s16x4 r; asm volatile("ds_read_b64_tr_b16 %0, %1 offset:%2" : "=&v"(r) : "v"(vb), "i"(OFF) : "memory"); return r;
}
template <int D0> __device__ __forceinline__ void pv_one(f32x16& od, int vb, bf16x8 pa0, bf16x8 pa1, bf16x8 pa2, bf16x8 pa3) {
  const s16x4 l0 = tr_read<v_rd_off(D0, 0, 0)>(vb), h0 = tr_read<v_rd_off(D0, 0, 1)>(vb), l1 = tr_read<v_rd_off(D0, 1, 0)>(vb), h1 = tr_read<v_rd_off(D0, 1, 1)>(vb);
  const s16x4 l2 = tr_read<v_rd_off(D0, 2, 0)>(vb), h2 = tr_read<v_rd_off(D0, 2, 1)>(vb), l3 = tr_read<v_rd_off(D0, 3, 0)>(vb), h3 = tr_read<v_rd_off(D0, 3, 1)>(vb);
  asm volatile("s_waitcnt lgkmcnt(0)" ::: "memory"); SBAR();
#define PK(L, H) (bf16x8){L[0], L[1], L[2], L[3], H[0], H[1], H[2], H[3]}
  od = __builtin_amdgcn_mfma_f32_32x32x16_bf16(pa0, PK(l0, h0), od, 0, 0, 0);
  od = __builtin_amdgcn_mfma_f32_32x32x16_bf16(pa1, PK(l1, h1), od, 0, 0, 0);
  od = __builtin_amdgcn_mfma_f32_32x32x16_bf16(pa2, PK(l2, h2), od, 0, 0, 0);
  od = __builtin_amdgcn_mfma_f32_32x32x16_bf16(pa3, PK(l3, h3), od, 0, 0, 0);
#undef PK
}
__device__ __forceinline__ void pv_d0(f32x16* o, int vb, bf16x8 pa0, bf16x8 pa1, bf16x8 pa2, bf16x8 pa3) {
  pv_one<0>(o[0], vb, pa0, pa1, pa2, pa3); pv_one<1>(o[1], vb, pa0, pa1, pa2, pa3); pv_one<2>(o[2], vb, pa0, pa1, pa2, pa3); pv_one<3>(o[3], vb, pa0, pa1, pa2, pa3);
}

__device__ __forceinline__ void attn_unit(int b, int h, int qb, const bf16* __restrict__ Q16, const bf16* __restrict__ K16, const bf16* __restrict__ V16,
                                          bf16* __restrict__ mix16, float lam, const float* __restrict__ subg, char* lds) {
  const int tid = threadIdx.x, wid = tid >> 6, lane = tid & 63, r32 = lane & 31, hi = lane >> 5, mp = wid >> 2, qs = wid & 3;
  bf16* V_lds = (bf16*)lds; bf16* K_lds = (bf16*)(lds + 2 * SHM_V);
  float* wsx = (float*)(lds + 2 * SHM_V + 2 * SHM_K) + wid * 64; float* li_l = wsx; float* al_l = wsx + 32;
  float m_reg = -1e30f, l_reg = 0; f32x16 o[4] = {}; bf16x8 qr[4];
  const bf16* Qw = Q16 + (size_t)(b * L + qb * 128 + qs * 32 + r32) * LDQ + h * 128 + mp * 64 + hi * 8;
#pragma unroll
  for (int d0 = 0; d0 < 4; ++d0) qr[d0] = *reinterpret_cast<const bf16x8*>(Qw + d0 * 16);
  const bf16* Kh = K16 + (size_t)(b * LK) * LDK + h * 128;
  const bf16* Vh = V16 + (size_t)(b * LK) * LDK + h * 128;
  const int sr = tid >> 4, sc = (tid & 15) * 8, vst0 = v_st(sr, sc), vst1 = v_st(32 + sr, sc);
  const int vb0 = (int)(uintptr_t)V_lds + v_rd_base(lane);
  struct { bf16x8 vs0, vs1, ks0, ks1; } sr_[2];
#define SLOAD(i, k0) do { sr_[i].vs0 = *(const bf16x8*)(&Vh[(size_t)((k0) + sr) * LDK + sc]); sr_[i].vs1 = *(const bf16x8*)(&Vh[(size_t)((k0) + 32 + sr) * LDK + sc]); \
    sr_[i].ks0 = *(const bf16x8*)(&Kh[(size_t)((k0) + sr) * LDK + sc]); sr_[i].ks1 = *(const bf16x8*)(&Kh[(size_t)((k0) + 32 + sr) * LDK + sc]); } while (0)
#define SWRITE(bb, i) do { *(bf16x8*)((char*)V_lds + (bb) * SHM_V + vst0) = sr_[i].vs0;          \
    *(bf16x8*)((char*)V_lds + (bb) * SHM_V + vst1) = sr_[i].vs1; int kc = sc * 2;               \
    *(bf16x8*)((char*)K_lds + (bb) * SHM_K + KSWZ(sr, kc)) = sr_[i].ks0;                       \
    *(bf16x8*)((char*)K_lds + (bb) * SHM_K + KSWZ(32 + sr, kc)) = sr_[i].ks1; } while (0)
#define SWAIT() asm volatile("s_waitcnt vmcnt(4)" ::: "memory")
#define RESC(a) do { if (__any((a) < 1.f)) { if (hi == 0) al_l[r32] = (a); asm volatile("s_waitcnt lgkmcnt(0)" ::: "memory"); \
    for (int d = 0; d < 4; ++d) for (int r = 0; r < 16; ++r) o[d][r] *= al_l[crow(r, hi)]; } } while (0)
  f32x16 pA0, pA1, pB0, pB1; float mnA, mnB, alA, alB; bf16x8 pa0, pa1, pa2, pa3; constexpr int NT = LK / KVBLK;
  constexpr int SE = 0, SO = 1;
  SLOAD(SE, 0); asm volatile("s_waitcnt vmcnt(0)" ::: "memory"); SWRITE(0, SE); __syncthreads();
  qkt(pA0, pA1, K_lds, qr, r32, hi, mp); partialSM(pA0, pA1, m_reg, mnA, alA);
  SLOAD(SO, KVBLK); SLOAD(SE, 2 * KVBLK);
  SWAIT(); SWRITE(1, SO); __syncthreads();
  for (int j = 1; j + 1 < NT; j += 2) {
    SBAR(); qkt(pB0, pB1, (bf16*)((char*)K_lds + SHM_K), qr, r32, hi, mp);
    finishSM(pA0, pA1, alA, l_reg, pa0, pa1, pa2, pa3); SBAR();
    SLOAD(SO, (j + 2) * KVBLK); SBAR();
    pv_d0(o, vb0, pa0, pa1, pa2, pa3); partialSM(pB0, pB1, m_reg, mnB, alB);
    __syncthreads(); SWAIT(); SWRITE(0, SE);
    RESC(alB); __syncthreads();
    SBAR(); qkt(pA0, pA1, K_lds, qr, r32, hi, mp);
    finishSM(pB0, pB1, alB, l_reg, pa0, pa1, pa2, pa3); SBAR();
    if (j + 3 < NT) SLOAD(SE, (j + 3) * KVBLK); SBAR();
    pv_d0(o, vb0 + SHM_V, pa0, pa1, pa2, pa3); partialSM(pA0, pA1, m_reg, mnA, alA);
    __syncthreads(); SWAIT(); SWRITE(1, SO);
    RESC(alA); __syncthreads();
  }
  SBAR(); qkt(pB0, pB1, (bf16*)((char*)K_lds + SHM_K), qr, r32, hi, mp);
  finishSM(pA0, pA1, alA, l_reg, pa0, pa1, pa2, pa3); SBAR();
  pv_d0(o, vb0, pa0, pa1, pa2, pa3); partialSM(pB0, pB1, m_reg, mnB, alB);
  __syncthreads(); RESC(alB);
  finishSM(pB0, pB1, alB, l_reg, pa0, pa1, pa2, pa3); SBAR();
  pv_d0(o, vb0 + SHM_V, pa0, pa1, pa2, pa3);
  if (hi == 0) li_l[r32] = l_reg;
  asm volatile("s_waitcnt lgkmcnt(0)" ::: "memory");
  float rli[16];
#pragma unroll
  for (int r = 0; r < 16; ++r) rli[r] = 1.0f / li_l[crow(r, hi)];
  __syncthreads();
  float* X = (float*)lds + qs * (32 * 128);
  if (mp == 1) {
#pragma unroll
    for (int r = 0; r < 16; ++r)
#pragma unroll
      for (int d0 = 0; d0 < 4; ++d0) X[crow(r, hi) * 128 + d0 * 32 + r32] = lam * o[d0][r] * rli[r];
  }
  __syncthreads();
  if (mp == 0) {
    float ssq[16];
#pragma unroll
    for (int r = 0; r < 16; ++r) { float s = 0.f;
#pragma unroll
      for (int d0 = 0; d0 < 4; ++d0) { const float v = o[d0][r] * rli[r] - X[crow(r, hi) * 128 + d0 * 32 + r32]; o[d0][r] = v; s += v * v; }
      ssq[r] = s; }
#pragma unroll
    for (int r = 0; r < 16; ++r) {
      float s = ssq[r];
      s += __shfl_xor(s, 1); s += __shfl_xor(s, 2); s += __shfl_xor(s, 4); s += __shfl_xor(s, 8); s += __shfl_xor(s, 16);
      ssq[r] = 1.0f / sqrtf(s * (1.0f / 128.f) + EPS);
    }
    float sg[4];
#pragma unroll
    for (int d0 = 0; d0 < 4; ++d0) sg[d0] = subg[d0 * 32 + r32] * 0.8f;
    asm volatile("s_waitcnt lgkmcnt(0)" ::: "memory");
    unsigned short* Y = (unsigned short*)X;
#pragma unroll
    for (int r = 0; r < 16; ++r)
#pragma unroll
      for (int d0 = 0; d0 < 4; ++d0) Y[crow(r, hi) * 128 + d0 * 32 + r32] = (unsigned short)f2bf(o[d0][r] * ssq[r] * sg[d0]);
    asm volatile("s_waitcnt lgkmcnt(0)" ::: "memory");
    bf16* Ob = mix16 + (size_t)(b * L + qb * 128 + qs * 32) * D + POOLW + h * 128;
#pragma unroll
    for (int j = 0; j < 8; ++j) { const int idx = j * 64 + lane, row = idx >> 4, ch = idx & 15;
      const v4u w = *(const v4u*)(Y + row * 128 + ch * 8);
      *(v4u*)(Ob + (size_t)row * D + ch * 8) = w; }
  }
  __syncthreads();
#undef SLOAD
#undef SWRITE
#undef SWAIT
#undef RESC
}

__device__ __forceinline__ void pool_item(int tile, int g, const bf16* __restrict__ ZP16, const bf16* __restrict__ pwT16, const float* __restrict__ pool_b,
                                          const float* __restrict__ pool_scale, bf16* __restrict__ mix16, int lane) {
  const int r32 = lane & 31, hi = lane >> 5;
  const int row0 = tile * 32, t = (row0 & 2047) + r32, rb = row0 & ~2047;
  const int w = 2 << g, hw = w >> 1;
  const int lo = t - hw < 0 ? 0 : t - hw, hi_ = t + hw > L ? L : t + hw;
  const float inv = 1.0f / (float)(hi_ - lo);
  bf16x8 af[8];
#pragma unroll
  for (int ks = 0; ks < 8; ++ks) {
    const int c0 = g * 128 + ks * 16 + hi * 8;
    float s[8];
#pragma unroll
    for (int e = 0; e < 8; ++e) s[e] = 0.f;
    for (int j = 0; j < w; ++j) {
      const int tt = t - hw + j; const bool ok = tt >= 0 && tt < L; const int tc = tt < 0 ? 0 : (tt >= L ? L - 1 : tt);
      const bf16x8 v = *(const bf16x8*)(ZP16 + (size_t)(rb + tc) * 512 + c0);
      const float m = ok ? 1.f : 0.f;
#pragma unroll
      for (int e = 0; e < 8; ++e) s[e] += m * __uint_as_float((unsigned)(unsigned short)v[e] << 16);
    }
    const bf16x8 own = *(const bf16x8*)(ZP16 + (size_t)(rb + t) * 512 + c0);
    v4u pk;
    pk.x = cvtpk(s[0] * inv - __uint_as_float((unsigned)(unsigned short)own[0] << 16), s[1] * inv - __uint_as_float((unsigned)(unsigned short)own[1] << 16));
    pk.y = cvtpk(s[2] * inv - __uint_as_float((unsigned)(unsigned short)own[2] << 16), s[3] * inv - __uint_as_float((unsigned)(unsigned short)own[3] << 16));
    pk.z = cvtpk(s[4] * inv - __uint_as_float((unsigned)(unsigned short)own[4] << 16), s[5] * inv - __uint_as_float((unsigned)(unsigned short)own[5] << 16));
    pk.w = cvtpk(s[6] * inv - __uint_as_float((unsigned)(unsigned short)own[6] << 16), s[7] * inv - __uint_as_float((unsigned)(unsigned short)own[7] << 16));
    af[ks] = *reinterpret_cast<bf16x8*>(&pk);
  }
  f32x16 acc[4] = {};
#pragma unroll
  for (int d0 = 0; d0 < 4; ++d0)
#pragma unroll
    for (int ks = 0; ks < 8; ++ks) {
      const bf16x8 bfr = *(const bf16x8*)(pwT16 + ((size_t)g * 128 + d0 * 32 + r32) * 128 + ks * 16 + hi * 8);
      acc[d0] = __builtin_amdgcn_mfma_f32_32x32x16_bf16(af[ks], bfr, acc[d0], 0, 0, 0);
    }
#pragma unroll
  for (int d0 = 0; d0 < 4; ++d0) {
    const int dcol = g * 128 + d0 * 32 + r32; const float pb = pool_b[dcol], ps = pool_scale[dcol];
#pragma unroll
    for (int r = 0; r < 16; ++r) mix16[(size_t)(row0 + crow(r, hi)) * D + dcol] = (unsigned short)f2bf((acc[d0][r] + pb) * ps);
  }
}
#undef KSWZ
#undef SBAR
}
__device__ __forceinline__ float wave_sum(float v) {
#pragma unroll
    for (int o = 1; o < 64; o <<= 1) v += __shfl_xor(v, o);
    return v;
}
__device__ __forceinline__ float wave_max(float v) {
#pragma unroll
    for (int o = 1; o < 64; o <<= 1) v = fmaxf(v, __shfl_xor(v, o));
    return v;
}
__device__ __forceinline__ void p0_lam_rope(const float* __restrict__ dl, float* __restrict__ lam_out, float* __restrict__ rope, int gtid, int gthreads) {
    if (gtid == 0) {
        double s01 = 0, s23 = 0;
        for (int i = 0; i < 64; ++i) { s01 += (double)dl[i] * dl[64 + i]; s23 += (double)dl[128 + i] * dl[192 + i]; }
        lam_out[0] = (float)(exp(s01) - exp(s23) + 0.2);
    }
    for (int gid = gtid; gid < L * 32; gid += gthreads) {
        const int t = gid / 32, a = (gid / 16) & 1, i = gid & 15;
        const double pos = a == 0 ? (double)(t / 64) : (double)(t % 64);
        const double ang = pos * pow(10000.0, -(double)i / 16.0);
        rope[gid * 2 + 0] = (float)cos(ang);
        rope[gid * 2 + 1] = (float)sin(ang);
    }
}
__device__ __forceinline__ void p0_ada_unit(int unit, const float* __restrict__ ada_w, float* __restrict__ part, LAS float* sv, LAS float* red, int wave, int lane, int tid) {
    const int cc = unit % 48, ks = unit / 48;
    const int col = cc * 256 + lane * 4;
    f32x4 acc[5];
#pragma unroll
    for (int r = 0; r < 5; ++r) acc[r] = (f32x4){0.f, 0.f, 0.f, 0.f};
    const int k0 = ks * 128 + wave * 16;
#pragma unroll 4
    for (int kk = 0; kk < 16; ++kk) {
        const int k = k0 + kk;
        const f32x4 wv = *(const f32x4*)(ada_w + (size_t)k * (6 * D) + col);
#pragma unroll
        for (int r = 0; r < 5; ++r) acc[r] += wv * sv[r * D + k];
    }
#pragma unroll
    for (int r = 0; r < 5; ++r) *(LAS f32x4*)(red + (wave * 5 + r) * 256 + lane * 4) = acc[r];
    __syncthreads();
    for (int idx = tid; idx < 5 * 256; idx += NWAVES * 64) {
        float s = 0.f;
#pragma unroll
        for (int w = 0; w < 8; ++w) s += red[w * 1280 + idx];
        part[((size_t)ks * 5 + idx / 256) * (6 * D) + cc * 256 + (idx & 255)] = s;
    }
    __syncthreads();
}
__device__ __forceinline__ void p0_row_to_fp8(const float* __restrict__ src, unsigned char* __restrict__ dst, float* __restrict__ inv_scale, int lane) {
    f32x4 v[8];
#pragma unroll
    for (int j = 0; j < 4; ++j) { v[j] = *(const f32x4*)(src + lane * 16 + j * 4); v[4 + j] = *(const f32x4*)(src + 1024 + lane * 16 + j * 4); }
    float am = 0.f;
#pragma unroll
    for (int j = 0; j < 8; ++j) am = fmaxf(am, fmaxf(fmaxf(fabsf(v[j][0]), fabsf(v[j][1])), fmaxf(fabsf(v[j][2]), fabsf(v[j][3]))));
    am = wave_max(am);
    float s = 1.f;
    if (am > 0.f) s = exp2f(floorf(log2f(224.f / am)));
    if (lane == 0) *inv_scale = 1.0f / s;
    v4u o0, o1;
#define PK8(a, b) ({ int _w = 0; _w = __builtin_amdgcn_cvt_pk_fp8_f32((a)[0] * s, (a)[1] * s, _w, false); _w = __builtin_amdgcn_cvt_pk_fp8_f32((a)[2] * s, (a)[3] * s, _w, true); (unsigned)_w; })
    o0.x = PK8(v[0], 0); o0.y = PK8(v[1], 0); o0.z = PK8(v[2], 0); o0.w = PK8(v[3], 0);
    o1.x = PK8(v[4], 0); o1.y = PK8(v[5], 0); o1.z = PK8(v[6], 0); o1.w = PK8(v[7], 0);
#undef PK8
    *(v4u*)(dst + lane * 16) = o0;
    *(v4u*)(dst + 1024 + lane * 16) = o1;
}
__device__ __forceinline__ unsigned pack_i8x4(f32x4 v, float s) {
    const int a = (int)rintf(v[0] * s), b = (int)rintf(v[1] * s), c = (int)rintf(v[2] * s), d = (int)rintf(v[3] * s);
    return (unsigned)(a & 0xFF) | ((unsigned)(b & 0xFF) << 8) | ((unsigned)(c & 0xFF) << 16) | ((unsigned)d << 24);
}
__device__ __forceinline__ void p0_row_to_i8(const float* __restrict__ src, unsigned char* __restrict__ dst, float* __restrict__ inv_scale, int lane) {
    f32x4 v[8];
#pragma unroll
    for (int j = 0; j < 4; ++j) { v[j] = *(const f32x4*)(src + lane * 16 + j * 4); v[4 + j] = *(const f32x4*)(src + 1024 + lane * 16 + j * 4); }
    float am = 0.f;
#pragma unroll
    for (int j = 0; j < 8; ++j) am = fmaxf(am, fmaxf(fmaxf(fabsf(v[j][0]), fabsf(v[j][1])), fmaxf(fabsf(v[j][2]), fabsf(v[j][3]))));
    am = wave_max(am);
    const float s = am > 0.f ? 127.f / am : 0.f;
    if (lane == 0) *inv_scale = am * (1.0f / 127.f);
    v4u o0, o1;
    o0.x = pack_i8x4(v[0], s); o0.y = pack_i8x4(v[1], s); o0.z = pack_i8x4(v[2], s); o0.w = pack_i8x4(v[3], s);
    o1.x = pack_i8x4(v[4], s); o1.y = pack_i8x4(v[5], s); o1.z = pack_i8x4(v[6], s); o1.w = pack_i8x4(v[7], s);
    *(v4u*)(dst + lane * 16) = o0;
    *(v4u*)(dst + 1024 + lane * 16) = o1;
}
constexpr int U4_ROW = 1024;
__device__ __forceinline__ void p0_row_to_i4(const float* __restrict__ src, unsigned char* __restrict__ dst, float* __restrict__ scale_out, int lane) {
    f32x4 v[8]; float ss = 0.f;
#pragma unroll
    for (int j = 0; j < 8; ++j) { v[j] = *(const f32x4*)(src + lane * 4 + 256 * j); ss += (v[j][0] * v[j][0] + v[j][1] * v[j][1]) + (v[j][2] * v[j][2] + v[j][3] * v[j][3]); }
    const float sg = sqrtf(wave_sum(ss) * (1.0f / D));
    const float sf = sg * (2.5f / 7.0f), inv = sf > 0.f ? 1.0f / sf : 0.f;
    if (lane == 0) *scale_out = sf;
    unsigned w[4];
#pragma unroll
    for (int d = 0; d < 4; ++d) {
        unsigned x = 0;
#pragma unroll
        for (int jj = 0; jj < 2; ++jj)
#pragma unroll
            for (int e = 0; e < 4; ++e) {
                int q = (int)rintf(v[2 * d + jj][e] * inv); q = q > 7 ? 7 : (q < -7 ? -7 : q);
                x |= ((unsigned)q & 0xFu) << (4 * (4 * jj + e));
            }
        w[d] = x;
    }
    *(v4u*)(dst + lane * 16) = (v4u){w[0], w[1], w[2], w[3]};
}
__device__ __forceinline__ void p0_row_to_fp4(const float* __restrict__ src, unsigned char* __restrict__ dst, float* __restrict__ scale_out, int lane) {
    f32x4 v[8]; float ss = 0.f;
#pragma unroll
    for (int j = 0; j < 8; ++j) { v[j] = *(const f32x4*)(src + lane * 4 + 256 * j); ss += (v[j][0] * v[j][0] + v[j][1] * v[j][1]) + (v[j][2] * v[j][2] + v[j][3] * v[j][3]); }
    const float sg = sqrtf(wave_sum(ss) * (1.0f / D));
    const float sf = sg * 0.5f, inv = sf > 0.f ? 1.0f / sf : 0.f;
    if (lane == 0) *scale_out = sf;
    unsigned w[4];
#pragma unroll
    for (int d = 0; d < 4; ++d) {
        unsigned x = 0;
        x = __builtin_amdgcn_cvt_scalef32_pk_fp4_f32(x, v[2 * d][0] * inv, v[2 * d][1] * inv, 1.0f, 0);
        x = __builtin_amdgcn_cvt_scalef32_pk_fp4_f32(x, v[2 * d][2] * inv, v[2 * d][3] * inv, 1.0f, 1);
        x = __builtin_amdgcn_cvt_scalef32_pk_fp4_f32(x, v[2 * d + 1][0] * inv, v[2 * d + 1][1] * inv, 1.0f, 2);
        x = __builtin_amdgcn_cvt_scalef32_pk_fp4_f32(x, v[2 * d + 1][2] * inv, v[2 * d + 1][3] * inv, 1.0f, 3);
        w[d] = x;
    }
    *(v4u*)(dst + lane * 16) = (v4u){w[0], w[1], w[2], w[3]};
}
template <class LD4>
__device__ __forceinline__ void norm_row_bf16(const float* __restrict__ xr, const float* __restrict__ g, LD4 ldmod, bf16* __restrict__ orow, int lane, float rstd_in, bool have_rstd) {
    f32x4 v[8]; float ss = 0.f;
#pragma unroll
    for (int j = 0; j < 8; ++j) { v[j] = *(const f32x4*)(xr + lane * 4 + 256 * j); ss += (v[j][0] * v[j][0] + v[j][1] * v[j][1]) + (v[j][2] * v[j][2] + v[j][3] * v[j][3]); }
    float rstd = rstd_in;
    if (!have_rstd) rstd = 1.0f / sqrtf(wave_sum(ss) * (1.0f / D) + EPS);
#pragma unroll
    for (int j = 0; j < 8; ++j) {
        const int col = lane * 4 + 256 * j;
        const f32x4 gv = *(const f32x4*)(g + col);
        const f32x4 sh = ldmod(0, col), sc = ldmod(1, col);
        const f32x4 o = v[j] * rstd * gv * (sc + 1.0f) + sh;
        uint2 w; w.x = pk2(o[0], o[1]); w.y = pk2(o[2], o[3]);
        *(uint2*)(orow + col) = w;
    }
}
namespace peer {
using f32x16 = __attribute__((ext_vector_type(16))) float;
using f32x2 = __attribute__((ext_vector_type(2))) float;
__device__ __forceinline__ int crow(int r, int hi) { return (r & 3) + 8 * (r >> 2) + 4 * hi; }
__device__ __forceinline__ float med3(float a, float b, float c) { return __builtin_amdgcn_fmed3f(a, b, c); }
__device__ __forceinline__ void ins16(float (&l)[16], float x) {
#pragma unroll
    for (int i = 15; i >= 1; --i) l[i] = med3(l[i - 1], l[i], x);
    l[0] = fmaxf(l[0], x);
}
__device__ __forceinline__ void merge_pair(float (&l)[16]) {
    float c[16];
#pragma unroll
    for (int i = 0; i < 16; ++i) { const float o = __shfl_xor(l[15 - i], 32); c[i] = fmaxf(l[i], o); }
#pragma unroll
    for (int d = 8; d >= 1; d >>= 1)
#pragma unroll
        for (int i = 0; i < 16; ++i) if ((i & d) == 0) { const float a = c[i], b = c[i + d]; c[i] = fmaxf(a, b); c[i + d] = fminf(a, b); }
#pragma unroll
    for (int i = 0; i < 16; ++i) l[i] = c[i];
}
__device__ __forceinline__ void topk_unit(int t0, int h, const bf16* __restrict__ qp16, const bf16* __restrict__ keys16, const float* __restrict__ su, const float* __restrict__ sv,
                                          int* __restrict__ eidx, float* __restrict__ egsv, float* __restrict__ esu, LAS unsigned char* scr, int lane) {
    const int r32 = lane & 31, hi = lane >> 5;
    float la[16], lb[16];
#pragma unroll
    for (int p = 0; p < 2; ++p) {
        f32x16 acc[4] = {};
        const bf16* qrow = qp16 + (size_t)(t0 + r32) * D + h * 256 + p * 128 + hi * 8;
        const bf16* kbase = keys16 + ((size_t)(h * 2 + p) * PNK + r32) * 128 + hi * 8;
#pragma unroll 4
        for (int ks = 0; ks < 8; ++ks) {
            const bf16x8 qf = *(const bf16x8*)(qrow + ks * 16);
#pragma unroll
            for (int kb = 0; kb < 4; ++kb) {
                const bf16x8 kf = *(const bf16x8*)(kbase + (size_t)kb * 32 * 128 + ks * 16);
                acc[kb] = __builtin_amdgcn_mfma_f32_32x32x16_bf16(kf, qf, acc[kb], 0, 0, 0);
            }
        }
        float l[16];
#pragma unroll
        for (int i = 0; i < 16; ++i) l[i] = -INFINITY;
#pragma unroll
        for (int kb = 0; kb < 4; ++kb)
#pragma unroll
            for (int r = 0; r < 16; ++r) {
                const unsigned k = (unsigned)(32 * kb + crow(r, hi));
                const float x = __uint_as_float((__float_as_uint(acc[kb][r]) & ~0x7Fu) | k);
                ins16(l, x);
            }
        merge_pair(l);
        if (p == 0) {
#pragma unroll
            for (int i = 0; i < 16; ++i) la[i] = l[i];
        } else {
#pragma unroll
            for (int i = 0; i < 16; ++i) lb[i] = l[i];
        }
    }
    {
        unsigned w[4];
#pragma unroll
        for (int q = 0; q < 4; ++q) {
            unsigned x = 0;
#pragma unroll
            for (int e = 0; e < 4; ++e) { float va = la[4 * q + e], vb_ = lb[4 * q + e]; asm volatile("" : "+v"(va), "+v"(vb_)); const float v = hi ? vb_ : va; x |= (__float_as_uint(v) & 0x7Fu) << (8 * e); }
            w[q] = x;
        }
        *(LAS v4u*)(scr + r32 * 32 + hi * 16) = (v4u){w[0], w[1], w[2], w[3]};
    }
    float l[16];
#pragma unroll
    for (int i = 0; i < 16; ++i) l[i] = -INFINITY;
    {
        int n = 0; float pend = 0.f;
#pragma unroll
        for (int i = 0; i < 16; ++i)
#pragma unroll
            for (int j = 0; j < 16; ++j) if ((i + 1) * (j + 1) <= 16) {
                const float s = la[i] + lb[j];
                const float x = __uint_as_float((__float_as_uint(s) & ~0xFFu) | (unsigned)(i * 16 + j));
                if ((n & 1) == 0) pend = x; else ins16(l, hi ? x : pend);
                ++n;
            }
    }
    merge_pair(l);
    asm volatile("s_waitcnt lgkmcnt(0)" ::: "memory");
    float ex[16], sum = 0.f;
#pragma unroll
    for (int i = 0; i < 16; ++i) { ex[i] = __expf(l[i] - l[0]); sum += ex[i]; }
    const float inv = 1.0f / sum;
    const size_t ob = ((size_t)(t0 + r32) * PH + h) * PTOPK + hi * 8;
#pragma unroll
    for (int n = 0; n < 8; ++n) {
        float vlo = l[n], vhi = l[8 + n], elo = ex[n], ehi = ex[8 + n];
        asm volatile("" : "+v"(vlo), "+v"(vhi), "+v"(elo), "+v"(ehi));
        const float v = hi ? vhi : vlo;
        const float g = (hi ? ehi : elo) * inv;
        const unsigned c = __float_as_uint(v) & 0xFFu;
        const unsigned ia = scr[r32 * 32 + (c >> 4)], ib = scr[r32 * 32 + 16 + (c & 15)];
        const int e = (int)(ia * PNK + ib);
        eidx[ob + n] = e; egsv[ob + n] = g * sv[e]; esu[ob + n] = su[e];
    }
}

__device__ __forceinline__ f32x2 cvt8(unsigned w, bool hiw) { return hiw ? __builtin_amdgcn_cvt_pk_f32_fp8((int)w, true) : __builtin_amdgcn_cvt_pk_f32_fp8((int)w, false); }
__device__ __forceinline__ void peer_token(int t, const bf16* __restrict__ f16, const int* __restrict__ eidx, const float* __restrict__ egsv, const float* __restrict__ esu,
                                           const unsigned char* __restrict__ U8, const unsigned char* __restrict__ V8, const float* __restrict__ g2, const float* __restrict__ fg,
                                           const float* xin, float* xout, int lane) {
    f32x2 fr[16], acc[16];
    {
        const bf16* fp = f16 + (size_t)t * D + lane * 16;
        const v4u a0 = *(const v4u*)fp, a1 = *(const v4u*)(fp + 8), b0 = *(const v4u*)(fp + 1024), b1 = *(const v4u*)(fp + 1032);
        const unsigned w[16] = {a0.x, a0.y, a0.z, a0.w, a1.x, a1.y, a1.z, a1.w, b0.x, b0.y, b0.z, b0.w, b1.x, b1.y, b1.z, b1.w};
#pragma unroll
        for (int i = 0; i < 16; ++i) { fr[i] = (f32x2){__uint_as_float(w[i] << 16), __uint_as_float(w[i] & 0xFFFF0000u)}; acc[i] = (f32x2){0.f, 0.f}; }
    }
    const int e_a = eidx[(size_t)t * 128 + lane], e_b = eidx[(size_t)t * 128 + 64 + lane];
    const float g_a = egsv[(size_t)t * 128 + lane], g_b = egsv[(size_t)t * 128 + 64 + lane];
    const float s_a = esu[(size_t)t * 128 + lane], s_b = esu[(size_t)t * 128 + 64 + lane];
    const int k2 = lane >> 4;
    v4u ub[4][2], vb[4][2];
#define LOADROWS(buf, base, grp) do { _Pragma("unroll") for (int k = 0; k < 4; ++k) { \
        const int ee = (grp) < 16 ? __builtin_amdgcn_readlane(e_a, ((grp) & 15) * 4 + k) : __builtin_amdgcn_readlane(e_b, ((grp) & 15) * 4 + k); \
        const unsigned char* rp = (base) + (size_t)ee * D + lane * 16; buf[k][0] = *(const v4u*)rp; buf[k][1] = *(const v4u*)(rp + 1024); } } while (0)
    LOADROWS(ub, U8, 0); LOADROWS(vb, V8, 0);
#pragma unroll 1
    for (int grp = 0; grp < 32; ++grp) {
        float dt[4];
#pragma unroll
        for (int k = 0; k < 4; ++k) {
            f32x2 s = {0.f, 0.f};
#pragma unroll
            for (int hf = 0; hf < 2; ++hf) {
                const unsigned w[4] = {ub[k][hf].x, ub[k][hf].y, ub[k][hf].z, ub[k][hf].w};
#pragma unroll
                for (int q = 0; q < 4; ++q) { s += cvt8(w[q], false) * fr[hf * 8 + q * 2]; s += cvt8(w[q], true) * fr[hf * 8 + q * 2 + 1]; }
            }
            dt[k] = s[0] + s[1];
        }
        if (grp + 1 < 32) LOADROWS(ub, U8, grp + 1);
        {
            auto r0 = __builtin_amdgcn_permlane32_swap(__float_as_uint(dt[0]), __float_as_uint(dt[2]), false, false);
            auto r1 = __builtin_amdgcn_permlane32_swap(__float_as_uint(dt[1]), __float_as_uint(dt[3]), false, false);
            float x0 = __uint_as_float(r0[0]) + __uint_as_float(r0[1]);
            float x1 = __uint_as_float(r1[0]) + __uint_as_float(r1[1]);
            const bool b4 = (lane & 16) != 0;
            const float keep = b4 ? x1 : x0, send = b4 ? x0 : x1;
            float y = keep + __shfl_xor(send, 16);
            y += __shfl_xor(y, 8); y += __shfl_xor(y, 4); y += __shfl_xor(y, 2); y += __shfl_xor(y, 1);
            dt[0] = y;
        }
        const int ent = (grp & 15) * 4 + k2;
        const float gsv = grp < 16 ? __shfl(g_a, ent) : __shfl(g_b, ent);
        const float isu = grp < 16 ? __shfl(s_a, ent) : __shfl(s_b, ent);
        const float dv = dt[0] * isu;
        const float wgt = gsv * 0.5f * dv * (1.f + erff(dv * 0.70710678118654752f));
#pragma unroll
        for (int k = 0; k < 4; ++k) {
            const float wk = __uint_as_float(__builtin_amdgcn_readlane(__float_as_uint(wgt), 16 * k));
            const f32x2 wk2 = {wk, wk};
#pragma unroll
            for (int hf = 0; hf < 2; ++hf) {
                const unsigned w[4] = {vb[k][hf].x, vb[k][hf].y, vb[k][hf].z, vb[k][hf].w};
#pragma unroll
                for (int q = 0; q < 4; ++q) { acc[hf * 8 + q * 2] += cvt8(w[q], false) * wk2; acc[hf * 8 + q * 2 + 1] += cvt8(w[q], true) * wk2; }
            }
        }
        if (grp + 1 < 32) LOADROWS(vb, V8, grp + 1);
    }
#undef LOADROWS
    const float* xr = xin + (size_t)t * D + lane * 16; float* xw = xout + (size_t)t * D + lane * 16;
    const float* gr = g2 + lane * 16; const float* fgr = fg + lane * 16;
    f32x4 xv[8]; float ss = 0.f;
#pragma unroll
    for (int j = 0; j < 8; ++j) {
        const int off = (j >> 2) * 1024 + (j & 3) * 4;
        const f32x4 x1v = *(const f32x4*)(xr + off), gv = *(const f32x4*)(gr + off);
        const f32x4 pv = {acc[2 * j][0], acc[2 * j][1], acc[2 * j + 1][0], acc[2 * j + 1][1]};
        xv[j] = x1v + gv * pv;
        ss += (xv[j][0] * xv[j][0] + xv[j][1] * xv[j][1]) + (xv[j][2] * xv[j][2] + xv[j][3] * xv[j][3]);
    }
    ss = wave_sum(ss);
    const float rstd = 1.0f / sqrtf(ss * (1.0f / D) + EPS);
#pragma unroll
    for (int j = 0; j < 8; ++j) { const int off = (j >> 2) * 1024 + (j & 3) * 4; *(f32x4*)(xw + off) = xv[j] * rstd * *(const f32x4*)(fgr + off); }
}
}

#ifndef PEER_NSTU
#define PEER_NSTU 4
#endif
#ifndef PEER_NSTV
#define PEER_NSTV 4
#endif
namespace peer {
__device__ __forceinline__ void sort128x4(int (&key)[4][2], int lane) {
#pragma unroll
    for (int k = 2; k <= 128; k <<= 1) {
#pragma unroll
        for (int j = k >> 1; j > 0; j >>= 1) {
            if (j == 64) {
#pragma unroll
                for (int t = 0; t < 4; ++t) { const int a = key[t][0], b = key[t][1]; key[t][0] = a < b ? a : b; key[t][1] = a < b ? b : a; }
            } else {
                const bool lower = (lane & j) == 0;
#pragma unroll
                for (int r = 0; r < 2; ++r) {
                    const int i = r * 64 + lane;
                    const bool keepmin = (lower == ((i & k) == 0));
#pragma unroll
                    for (int t = 0; t < 4; ++t) {
                        const int o = __shfl_xor(key[t][r], j);
                        const int mn = key[t][r] < o ? key[t][r] : o, mx = key[t][r] < o ? o : key[t][r];
                        key[t][r] = keepmin ? mn : mx;
                    }
                }
            }
        }
    }
}
__device__ __forceinline__ float dot32_i4(const v4u u, const int (&fh)[4], const int (&fl)[4]) {
    int sh = __builtin_amdgcn_sdot8((int)u.x, fh[0], 0, false), sl = __builtin_amdgcn_sdot8((int)u.x, fl[0], 0, false);
    sh = __builtin_amdgcn_sdot8((int)u.y, fh[1], sh, false); sl = __builtin_amdgcn_sdot8((int)u.y, fl[1], sl, false);
    sh = __builtin_amdgcn_sdot8((int)u.z, fh[2], sh, false); sl = __builtin_amdgcn_sdot8((int)u.z, fl[2], sl, false);
    sh = __builtin_amdgcn_sdot8((int)u.w, fh[3], sh, false); sl = __builtin_amdgcn_sdot8((int)u.w, fl[3], sl, false);
    return (float)(sh * 16 + sl);
}
__device__ __forceinline__ float gelu_as(float v) {
    const float av = fabsf(v), t = __builtin_amdgcn_rcpf(av * 0.2316418882f + 1.0f);
    float q = t * 0.5307027145f + (-0.7265760135f); q = q * t + 0.7107068705f; q = q * t + (-0.142248368f); q = q * t + 0.127414796f; q = q * t;
    const float e = __builtin_amdgcn_exp2f((v * v) * (-0.72134752044f));
    const float m = v * (q * e);
    return v < 0.f ? m : v - m;
}
__device__ __forceinline__ float bfu(unsigned h) { return __uint_as_float(h << 16); }
__device__ __forceinline__ int qi8(float x, float qs) { return (int)rintf(x * qs) & 0xFF; }
__device__ __forceinline__ void axpy16(f32x2 (&a)[8], const v4u v, float wk) {
    f32x2 wk2 = {wk, wk};
    const unsigned w[4] = {v.x, v.y, v.z, v.w};
#pragma unroll
    for (int q = 0; q < 4; ++q) {
        const f32x2 c0 = cvt8(w[q], false), c1 = cvt8(w[q], true);
        asm volatile("v_pk_fma_f32 %0, %1, %2, %0" : "+v"(a[q * 2]) : "v"(c0), "v"(wk2));
        asm volatile("v_pk_fma_f32 %0, %1, %2, %0" : "+v"(a[q * 2 + 1]) : "v"(c1), "v"(wk2));
    }
}
__device__ __forceinline__ void loadf8(f32x2 (&f)[8], const bf16* fp) {
    const v4u a0 = *(const v4u*)fp, a1 = *(const v4u*)(fp + 8);
    const unsigned w[8] = {a0.x, a0.y, a0.z, a0.w, a1.x, a1.y, a1.z, a1.w};
#pragma unroll
    for (int i = 0; i < 8; ++i) f[i] = (f32x2){__uint_as_float(w[i] << 16), __uint_as_float(w[i] & 0xFFFF0000u)};
}
#define RFL_I(x) __builtin_amdgcn_readfirstlane(x)
#define RFL_F(x) __uint_as_float(__builtin_amdgcn_readfirstlane(__float_as_uint(x)))

__device__ __forceinline__ int keyat(const int (&key)[4][2], int tk, int i) {
    int k0 = key[tk][0], k1 = key[tk][1]; asm volatile("" : "+v"(k0), "+v"(k1));
    return __builtin_amdgcn_readlane((i & 64) ? k1 : k0, i & 63);
}
__device__ __forceinline__ void peer_usweep(const int (&fa0)[4], const int (&fb0)[4], const int (&fa1)[4], const int (&fb1)[4], const int (&fa2)[4], const int (&fb2)[4],
                                            const int (&fa3)[4], const int (&fb3)[4], float sfk, const unsigned char* __restrict__ U4,
                                            const int (&key)[4][2], const float (&gq)[4][2], const float (&sq)[4][2], int (&wr)[4][2], int lane) {
    const int k2 = lane >> 4;
    constexpr int NST = PEER_NSTU;
    v4u ub[NST][4];
#define LOADU(S, I) do { _Pragma("unroll") for (int tk = 0; tk < 4; ++tk) { const unsigned char* rp_ = U4 + (size_t)(unsigned)(keyat(key, tk, (I)) >> 7) * U4_ROW;     \
        ub[S][tk] = *(const v4u*)(rp_ + lane * 16); } } while (0)
#pragma unroll
    for (int s = 0; s < NST - 1; ++s) LOADU(s, s);
    static_assert(PEER_NSTU == 4, "the batched reduction below takes the four steps of one ring turn together");
    const int g16 = lane >> 2, mytk = g16 & 3, mys = g16 >> 2;
#pragma unroll
    for (int R = 0; R < 2; ++R) {
#pragma unroll 1
        for (int i0 = 64 * R; i0 < 64 * R + 64; i0 += NST) {
            float v[16];
#pragma unroll
            for (int s = 0; s < NST; ++s) {
                const int i = i0 + s;
                if (i + NST - 1 < 128) LOADU((s + NST - 1) % NST, i + NST - 1);
                v[4 * s + 0] = dot32_i4(ub[s][0], fa0, fb0); v[4 * s + 1] = dot32_i4(ub[s][1], fa1, fb1);
                v[4 * s + 2] = dot32_i4(ub[s][2], fa2, fb2); v[4 * s + 3] = dot32_i4(ub[s][3], fa3, fb3);
            }
            float x[8];
#pragma unroll
            for (int j = 0; j < 8; ++j) { auto r_ = __builtin_amdgcn_permlane32_swap(__float_as_uint(v[j]), __float_as_uint(v[j + 8]), false, false);
                x[j] = __uint_as_float(r_[0]) + __uint_as_float(r_[1]); }
            const bool b4 = (lane & 16) != 0, b3 = (lane & 8) != 0, b2 = (lane & 4) != 0;
            float y4[4];
#pragma unroll
            for (int j = 0; j < 4; ++j) { const float keep = b4 ? x[j + 4] : x[j], send = b4 ? x[j] : x[j + 4]; y4[j] = keep + __shfl_xor(send, 16); }
            float z2[2];
#pragma unroll
            for (int j = 0; j < 2; ++j) { const float keep = b3 ? y4[j + 2] : y4[j], send = b3 ? y4[j] : y4[j + 2]; z2[j] = keep + __shfl_xor(send, 8); }
            float y;
            { const float keep = b2 ? z2[1] : z2[0], send = b2 ? z2[0] : z2[1]; y = keep + __shfl_xor(send, 4); }
            y += __shfl_xor(y, 2); y += __shfl_xor(y, 1);
            const int src = (i0 + mys) & 63;
            float gg[4], sg[4];
#pragma unroll
            for (int tk = 0; tk < 4; ++tk) { gg[tk] = __shfl(gq[tk][R], src); sg[tk] = __shfl(sq[tk][R], src); }
            const float gsel = mytk == 0 ? gg[0] : (mytk == 1 ? gg[1] : (mytk == 2 ? gg[2] : gg[3]));
            const float ssel = mytk == 0 ? sg[0] : (mytk == 1 ? sg[1] : (mytk == 2 ? sg[2] : sg[3]));
            const float wgt = gsel * gelu_as(y * (ssel * sfk));
            const int srel = (lane - i0) & 63;
#pragma unroll
            for (int tk = 0; tk < 4; ++tk) { const int got = __shfl(__float_as_int(wgt), (16 * srel + 4 * tk) & 63); wr[tk][R] = srel < 4 ? got : wr[tk][R]; }
        }
    }
#undef LOADU
}
__device__ __forceinline__ void axpy32_fp4(f32x2 (&a)[16], const v4u v, float wks) {
    f32x2 wk2 = {wks, wks};
    const unsigned w[4] = {v.x, v.y, v.z, v.w};
#pragma unroll
    for (int d = 0; d < 4; ++d) {
        const f32x2 c0 = __builtin_amdgcn_cvt_scalef32_pk_f32_fp4(w[d], 1.0f, 0), c1 = __builtin_amdgcn_cvt_scalef32_pk_f32_fp4(w[d], 1.0f, 1);
        const f32x2 c2 = __builtin_amdgcn_cvt_scalef32_pk_f32_fp4(w[d], 1.0f, 2), c3 = __builtin_amdgcn_cvt_scalef32_pk_f32_fp4(w[d], 1.0f, 3);
        asm volatile("v_pk_fma_f32 %0, %1, %2, %0" : "+v"(a[4 * d + 0]) : "v"(c0), "v"(wk2));
        asm volatile("v_pk_fma_f32 %0, %1, %2, %0" : "+v"(a[4 * d + 1]) : "v"(c1), "v"(wk2));
        asm volatile("v_pk_fma_f32 %0, %1, %2, %0" : "+v"(a[4 * d + 2]) : "v"(c2), "v"(wk2));
        asm volatile("v_pk_fma_f32 %0, %1, %2, %0" : "+v"(a[4 * d + 3]) : "v"(c3), "v"(wk2));
    }
}
__device__ __forceinline__ void peer_vsweep(const unsigned char* __restrict__ V4, const int (&key)[4][2], const int (&wr)[4][2],
                                            f32x2 (&a0)[16], f32x2 (&a1)[16], f32x2 (&a2)[16], f32x2 (&a3)[16], int lane) {
    constexpr int NST = PEER_NSTV;
    v4u vb[NST][4];
#define LOADV(S, I) do { _Pragma("unroll") for (int tk = 0; tk < 4; ++tk) { const unsigned char* rp_ = V4 + (size_t)(unsigned)(keyat(key, tk, (I)) >> 7) * U4_ROW; \
        vb[S][tk] = *(const v4u*)(rp_ + lane * 16); } } while (0)
#define WAT(TK) __uint_as_float(__builtin_amdgcn_readlane(wr[TK][R], i & 63))
#pragma unroll
    for (int s = 0; s < NST - 1; ++s) LOADV(s, s);
#pragma unroll
    for (int R = 0; R < 2; ++R) {
#pragma unroll 1
        for (int i0 = 64 * R; i0 < 64 * R + 64; i0 += NST) {
#pragma unroll
            for (int s = 0; s < NST; ++s) {
                const int i = i0 + s;
                if (i + NST - 1 < 128) LOADV((s + NST - 1) % NST, i + NST - 1);
                axpy32_fp4(a0, vb[s][0], WAT(0)); axpy32_fp4(a1, vb[s][1], WAT(1));
                axpy32_fp4(a2, vb[s][2], WAT(2)); axpy32_fp4(a3, vb[s][3], WAT(3));
            }
        }
    }
#undef WAT
#undef LOADV
}
__device__ __forceinline__ void peer_finish4(int t, const f32x2 (&a)[16], const GAS float* g2, const GAS float* fg, const GAS float* xin, GAS float* xout, int lane) {
    const GAS float* xr = xin + (size_t)t * D + lane * 4; GAS float* xw = xout + (size_t)t * D + lane * 4;
    f32x4 xv[8]; float ss = 0.f;
#pragma unroll
    for (int j = 0; j < 8; ++j) {
        const f32x4 x1v = *(const GAS f32x4*)(xr + 256 * j), gv = *(const GAS f32x4*)(g2 + lane * 4 + 256 * j);
        const f32x4 pv = {a[2 * j][0], a[2 * j][1], a[2 * j + 1][0], a[2 * j + 1][1]};
        xv[j] = x1v + gv * pv;
        ss += (xv[j][0] * xv[j][0] + xv[j][1] * xv[j][1]) + (xv[j][2] * xv[j][2] + xv[j][3] * xv[j][3]);
    }
    ss = wave_sum(ss);
    const float rstd = 1.0f / sqrtf(ss * (1.0f / D) + EPS);
#pragma unroll
    for (int j = 0; j < 8; ++j) *(GAS f32x4*)(xw + 256 * j) = xv[j] * rstd * *(const GAS f32x4*)(fg + lane * 4 + 256 * j);
}
__device__ __forceinline__ float peer_x2(f32x2 (&a)[8], const GAS float* xr, const GAS float* gr) {
    float ss = 0.f;
#pragma unroll
    for (int j = 0; j < 4; ++j) {
        const f32x4 x1v = *(const GAS f32x4*)(xr + j * 4), gv = *(const GAS f32x4*)(gr + j * 4);
        const f32x4 pv = {a[2 * j][0], a[2 * j][1], a[2 * j + 1][0], a[2 * j + 1][1]};
        const f32x4 o = x1v + gv * pv;
        a[2 * j] = (f32x2){o[0], o[1]}; a[2 * j + 1] = (f32x2){o[2], o[3]};
        ss += (o[0] * o[0] + o[1] * o[1]) + (o[2] * o[2] + o[3] * o[3]);
    }
    return ss;
}
__device__ __forceinline__ void peer_store_raw(const f32x2 (&a)[8], float* __restrict__ xw) {
#pragma unroll
    for (int j = 0; j < 4; ++j) { const f32x4 o = {a[2 * j][0], a[2 * j][1], a[2 * j + 1][0], a[2 * j + 1][1]}; *(f32x4*)(xw + j * 4) = o; }
}
__device__ __forceinline__ void peer_rescale(float rstd, const GAS float* fgr, float* xw_) {
    GAS float* xw = (GAS float*)xw_; asm volatile("" : "+v"(xw));
#pragma unroll
    for (int j = 0; j < 4; ++j) { const f32x4 o = *(const GAS f32x4*)(xw + j * 4); *(GAS f32x4*)(xw + j * 4) = o * rstd * *(const GAS f32x4*)(fgr + j * 4); }
}
__device__ __forceinline__ void peer_store(const f32x2 (&a)[8], float rstd, const GAS float* fgr, float* __restrict__ xw) {
#pragma unroll
    for (int j = 0; j < 4; ++j) { const f32x4 o = {a[2 * j][0], a[2 * j][1], a[2 * j + 1][0], a[2 * j + 1][1]}; *(f32x4*)(xw + j * 4) = o * rstd * *(const GAS f32x4*)(fgr + j * 4); }
}

__device__ __forceinline__ void peer_wave4(int t0, const bf16* __restrict__ f16, const int* __restrict__ eidx, const float* __restrict__ egsv, const float* __restrict__ esu,
                                           const unsigned char* __restrict__ U8, const unsigned char* __restrict__ V8, const float* __restrict__ g2, const float* __restrict__ fg,
                                           const float* xin, float* xout, LAS unsigned* lw, int lane, int probe) {
    (void)lw;
    int key[4][2]; float gq[4][2], sq[4][2];
#pragma unroll
    for (int tk = 0; tk < 4; ++tk)
#pragma unroll
        for (int r = 0; r < 2; ++r) { const size_t ix = (size_t)(t0 + tk) * 128 + r * 64 + lane; key[tk][r] = (eidx[ix] << 7) | (r * 64 + lane); gq[tk][r] = egsv[ix]; sq[tk][r] = esu[ix]; }
    uint2 fr_[4][8];
#pragma unroll
    for (int tk = 0; tk < 4; ++tk) { const bf16* fp_ = f16 + (size_t)(t0 + tk) * D + lane * 4;
#pragma unroll
        for (int j = 0; j < 8; ++j) fr_[tk][j] = *(const uint2*)(fp_ + 256 * j); }
    sort128x4(key, lane);
    int wr[4][2] = {{0, 0}, {0, 0}, {0, 0}, {0, 0}};
#pragma unroll
    for (int tk = 0; tk < 4; ++tk) {
        const float g0_ = gq[tk][0], g1_ = gq[tk][1], s0_ = sq[tk][0], s1_ = sq[tk][1];
#pragma unroll
        for (int r = 0; r < 2; ++r) { const int sl = key[tk][r] & 127; const float v0 = __shfl(g0_, sl & 63), v1 = __shfl(g1_, sl & 63), w0 = __shfl(s0_, sl & 63), w1 = __shfl(s1_, sl & 63);
            gq[tk][r] = (sl & 64) ? v1 : v0; sq[tk][r] = (sl & 64) ? w1 : w0; }
    }
    {
        int fa0[4], fb0[4], fa1[4], fb1[4], fa2[4], fb2[4], fa3[4], fb3[4]; float sfk = 0.f;
        float am_[4];
#pragma unroll
        for (int tk = 0; tk < 4; ++tk) { float m = 0.f;
#pragma unroll
            for (int j = 0; j < 8; ++j) m = fmaxf(m, fmaxf(fmaxf(fabsf(bfu(fr_[tk][j].x & 0xFFFFu)), fabsf(bfu(fr_[tk][j].x >> 16))), fmaxf(fabsf(bfu(fr_[tk][j].y & 0xFFFFu)), fabsf(bfu(fr_[tk][j].y >> 16)))));
            am_[tk] = m; }
#pragma unroll
        for (int o = 1; o < 64; o <<= 1)
#pragma unroll
            for (int tk = 0; tk < 4; ++tk) am_[tk] = fmaxf(am_[tk], __shfl_xor(am_[tk], o));
#define QUANTF(TK, FA, FB) do { const float qs_ = am_[TK] > 0.f ? 119.f / am_[TK] : 0.f; \
        _Pragma("unroll") for (int d = 0; d < 4; ++d) { unsigned xh_ = 0, xl_ = 0; \
            _Pragma("unroll") for (int jj = 0; jj < 2; ++jj) { const uint2 pp_ = fr_[TK][2 * d + jj]; \
                const float ev_[4] = {bfu(pp_.x & 0xFFFFu), bfu(pp_.x >> 16), bfu(pp_.y & 0xFFFFu), bfu(pp_.y >> 16)}; \
                _Pragma("unroll") for (int e = 0; e < 4; ++e) { const int q_ = (int)rintf(ev_[e] * qs_); const int l_ = ((q_ + 8) & 15) - 8; const int h_ = (q_ - l_) >> 4; \
                    xl_ |= ((unsigned)l_ & 0xFu) << (4 * (4 * jj + e)); xh_ |= ((unsigned)h_ & 0xFu) << (4 * (4 * jj + e)); } } \
            FA[d] = (int)xh_; FB[d] = (int)xl_; } \
        if (((lane >> 2) & 3) == TK) sfk = am_[TK] * (1.0f / 119.f); } while (0)
        QUANTF(0, fa0, fb0); QUANTF(1, fa1, fb1); QUANTF(2, fa2, fb2); QUANTF(3, fa3, fb3);
#undef QUANTF
        __builtin_amdgcn_sched_barrier(0);
        if (probe != 3) peer_usweep(fa0, fb0, fa1, fb1, fa2, fb2, fa3, fb3, sfk, U8, key, gq, sq, wr, lane);
    }
    __builtin_amdgcn_sched_barrier(0);
    {
        f32x2 a0[16], a1[16], a2[16], a3[16];
#pragma unroll
        for (int i = 0; i < 16; ++i) { a0[i] = (f32x2){0.f, 0.f}; a1[i] = a0[i]; a2[i] = a0[i]; a3[i] = a0[i]; }
        if (probe != 2) peer_vsweep(V8, key, wr, a0, a1, a2, a3, lane);
        __builtin_amdgcn_sched_barrier(0);
        const GAS float* g2_ = (const GAS float*)g2; const GAS float* fg_ = (const GAS float*)fg; const GAS float* xin_ = (const GAS float*)xin; GAS float* xout_ = (GAS float*)xout;
        asm volatile("" : "+v"(g2_), "+v"(fg_), "+v"(xin_), "+v"(xout_));
        peer_finish4(t0 + 0, a0, g2_, fg_, xin_, xout_, lane); peer_finish4(t0 + 1, a1, g2_, fg_, xin_, xout_, lane);
        peer_finish4(t0 + 2, a2, g2_, fg_, xin_, xout_, lane); peer_finish4(t0 + 3, a3, g2_, fg_, xin_, xout_, lane);
    }
}
}
__device__ __forceinline__ void p0_transpose_item(const float* W, int K, int N, bf16* WT, int row_off, LAS float* scr, int item, int lane) {
    const int nblk = N / 32, kb = item / nblk, nb = item % nblk, k0 = 64 * kb, n0 = 32 * nb;
#pragma unroll 8
    for (int i = 0; i < 32; ++i) { const int kk = 2 * i + (lane >> 5); scr[kk * 33 + (lane & 31)] = W[(size_t)(k0 + kk) * N + n0 + (lane & 31)]; }
    LDS_WAIT(); asm volatile("" ::: "memory");
    const int c = lane & 7;
#pragma unroll
    for (int j = 0; j < 4; ++j) { const int n = (lane >> 3) + 8 * j; const LAS float* s = scr + (8 * c) * 33 + n;
        v4u o; o.x = pk2(s[0 * 33], s[1 * 33]); o.y = pk2(s[2 * 33], s[3 * 33]); o.z = pk2(s[4 * 33], s[5 * 33]); o.w = pk2(s[6 * 33], s[7 * 33]);
        *(GAS v4u*)(WT + (size_t)(row_off + n0 + n) * K + k0 + 8 * c) = o; }
    LDS_WAIT(); asm volatile("" ::: "memory");
}

constexpr int TBL_ROWS_IN_P2 = 12288;
struct Args { const float* in[20]; float* out; unsigned char* ws; int ph_lo, ph_hi, li, pad; };
__device__ __forceinline__ const float* karg_ptr(int off) {
    const __attribute__((address_space(4))) char* kp = (const __attribute__((address_space(4))) char*)__builtin_amdgcn_kernarg_segment_ptr();
    asm volatile("" : "+s"(off));
    return *(const float* const __attribute__((address_space(4)))*)(kp + off);
}

__global__ void __launch_bounds__(NWAVES * 64, 2) mega(Args args) {
    extern __shared__ __attribute__((aligned(16))) unsigned char lds[];
    LAS unsigned char* ldsl = (LAS unsigned char*)lds;
    volatile LAS unsigned* MISC = (volatile LAS unsigned*)(ldsl + MISC_OFF);
    const int G = gridDim.x;
#define PHASE_IDS() int tid = threadIdx.x; asm volatile("" : "+v"(tid)); const int lane = tid & 63, wave = __builtin_amdgcn_readfirstlane(tid >> 6); \
    const int gw = blockIdx.x * NWAVES + wave, NGW = G * NWAVES, gtid = blockIdx.x * (NWAVES * 64) + tid, gthreads = G * NWAVES * 64; (void)lane; (void)gw; (void)NGW; (void)gtid; (void)gthreads
    unsigned char* ws = args.ws;
    gu32* ctl = (gu32*)(ws + WS_CTL);
    for (int u = threadIdx.x; u < (LDS_BYTES - LDSCTL_OFF) / 4; u += NWAVES * 64) ((LAS unsigned*)(ldsl + LDSCTL_OFF))[u] = 0u;
    __syncthreads();
    XcdBarrier bar = xcd_barrier_post((unsigned*)(ctl + CW_BAR) + args.li * XCD_BAR_WORDS, MISC + 8);
    const int lo = args.ph_lo, hi = args.ph_hi;
#define IN(k) (lo <= (k) && (k) < hi)
#ifndef PROBE_MASK
#define PROBE_MASK 0
#endif
#define PROBE_REP(k) ((((PROBE_MASK) >> (k)) & 1) ? 2 : 1)
#define SEAM(k) do { if (IN(k) && (k) + 1 < hi) xcd_barrier(bar); } while (0)

#define ARGP(i) karg_ptr((i) * 8)
#define ARG_OUT ((float*)karg_ptr(160))
#define Wt_in ((bf16*)(ws + WS_WIN))
#define Wt_out ((bf16*)(ws + WS_WOUT))
#define Wt_q ((bf16*)(ws + WS_WQ))
#define pwT16 ((bf16*)(ws + WS_PWT16))
#define mod ((float*)(ws + WS_MOD))
#define rope ((float*)(ws + WS_ROPE))
#define adap ((float*)(ws + WS_ADAP))
#define ssq ((float*)(ws + WS_SSQ))

    if (IN(0)) for (int rp = 0; rp < PROBE_REP(0); ++rp) { if (rp) xcd_barrier(bar);
        PHASE_IDS();
        LAS float* scr = (LAS float*)(ldsl + RING_OFF + wave * 16384);
        const float* w_in = ARGP(7); const float* w_out = ARGP(13); const float* peer_wq = ARGP(15); const float* pool_w = ARGP(8);
        constexpr int I_IN = (D / 64) * (INW / 32), I_O = (D / 64) * (D / 32);
        for (int it = gw; it < I_IN + 2 * I_O + 32; it += NGW) {
            int r = it;
            if (r < I_IN) { p0_transpose_item(w_in, D, INW, Wt_in, 0, scr, r, lane); continue; } r -= I_IN;
            if (r < I_O) { p0_transpose_item(w_out, D, D, Wt_out, 0, scr, r, lane); continue; } r -= I_O;
            if (r < I_O) { p0_transpose_item(peer_wq, D, D, Wt_q, 0, scr, r, lane); continue; } r -= I_O;
            p0_transpose_item(pool_w + (size_t)(r >> 3) * 16384, 128, 128, pwT16 + (size_t)(r >> 3) * 16384, 0, scr, r & 7, lane);
        }
        { const float* keys = ARGP(16); bf16* keys16 = (bf16*)(ws + WS_KEYS16);
          for (int i = gtid; i < 2 * PH * PNK * 128 / 4; i += gthreads) { const f32x4 v = *(const f32x4*)(keys + (size_t)i * 4); uint2 o; o.x = pk2(v[0], v[1]); o.y = pk2(v[2], v[3]); *(uint2*)(keys16 + (size_t)i * 4) = o; } }
        p0_lam_rope(ARGP(11), (float*)(ws + WS_LAM), rope, gtid, gthreads);
        __syncthreads();
        { LAS float* sv = (LAS float*)(ldsl + RING_OFF); LAS float* red = sv + 5 * D;
          const float* cvec = ARGP(1); const float* cctx = ARGP(3); const float* ada_w = ARGP(4);
          for (int i = tid; i < 5 * D; i += NWAVES * 64) { const int r = i / D, k = i % D; const float xv = r < 4 ? cvec[r * D + k] : cctx[k]; sv[i] = xv / (1.f + expf(-xv)); }
          __syncthreads();
          for (int unit = blockIdx.x; unit < 768; unit += G) p0_ada_unit(unit, ada_w, adap, sv, red, wave, lane, tid); }
        { const float* pu = ARGP(17); const float* pv = ARGP(18);
          unsigned char* U8 = ws + WS_U8; unsigned char* V8 = ws + WS_V8; float* su = (float*)(ws + WS_SU); float* svs = (float*)(ws + WS_SV);
          for (int row = (G == 256 ? TBL_ROWS_IN_P2 : 0) + gw; row < 2 * NEXP; row += NGW) {
              if (row < NEXP) p0_row_to_i4(pu + (size_t)row * D, U8 + (size_t)row * U4_ROW, su + row, lane);
              else p0_row_to_fp4(pv + (size_t)(row - NEXP) * D, V8 + (size_t)(row - NEXP) * U4_ROW, svs + (row - NEXP), lane);
          } }
    }
    SEAM(0);
    if (IN(1)) for (int rp = 0; rp < PROBE_REP(1); ++rp) { if (rp) xcd_barrier(bar);
        PHASE_IDS();
        const float* ada_b = ARGP(5); const float* norm1_g = ARGP(6); const float* ctxp = ARGP(2); const float* x = ARGP(0);
        bf16* h16 = (bf16*)(ws + WS_H16);
        if (tid < 240) { const int idx = blockIdx.x * 240 + tid; const int r = idx / (6 * D), col = idx % (6 * D);
            float s = ada_b[col];
#pragma unroll
            for (int ks = 0; ks < 16; ++ks) s += adap[((size_t)ks * 5 + r) * (6 * D) + col];
            mod[(size_t)r * (6 * D) + col] = s; }
        LAS float* modl = (LAS float*)(ldsl + RING_OFF);
        const int bb = blockIdx.x >> 6;
        for (int i = tid; i < 8192; i += NWAVES * 64) { const int r = i < 4096 ? bb : 4, col = i & 4095;
            float s = ada_b[col];
#pragma unroll
            for (int ks = 0; ks < 16; ++ks) s += adap[((size_t)ks * 5 + r) * (6 * D) + col];
            modl[i] = s; }
        __syncthreads();
#pragma unroll 1
        for (int j = 0; j < 4; ++j) { const int row = blockIdx.x * 32 + wave * 4 + j;
            norm_row_bf16(x + (size_t)row * D, norm1_g, [=](int which, int col) { return *(const LAS f32x4*)(modl + which * 2048 + col); }, h16 + (size_t)row * D, lane, 0.f, false); }
        if (wave < 4) { const int r = blockIdx.x * 4 + wave;
            norm_row_bf16(ctxp + (size_t)r * D, norm1_g, [=](int which, int col) { return *(const LAS f32x4*)(modl + 4096 + which * 2048 + col); }, h16 + (size_t)(NLAT + r) * D, lane, 0.f, false); }
    }
    SEAM(1);
    if (IN(2)) for (int rp = 0; rp < PROBE_REP(2); ++rp) { if (rp) xcd_barrier(bar);
        pg8::Gemm g{(const bf16*)(ws + WS_H16), Wt_in, NTOK, INW, D};
        pg8::InProjOrder S; S.init(G, (int)blockIdx.x);
        pg8::EpiInProj E{(bf16*)(ws + WS_ZP16), (bf16*)(ws + WS_Q16), (bf16*)(ws + WS_K16), (bf16*)(ws + WS_V16), rope};
        pg8::gemm_phase<pg8::EpiInProj, pg8::InProjOrder, true, true>(ldsl + RING_OFF, g, S, E);
        if (G == 256 && blockIdx.x >= 176) { PHASE_IDS();
            const float* pu = ARGP(17); unsigned char* U8 = ws + WS_U8; float* su = (float*)(ws + WS_SU);
            for (int row = (blockIdx.x - 176) * NWAVES + wave; row < TBL_ROWS_IN_P2; row += 80 * NWAVES) p0_row_to_i4(pu + (size_t)row * D, U8 + (size_t)row * U4_ROW, su + row, lane); }
    }
    SEAM(2);
    if (IN(3)) for (int rp = 0; rp < PROBE_REP(3); ++rp) { if (rp) xcd_barrier(bar);
        PHASE_IDS();
        bf16* mix16 = (bf16*)(ws + WS_MIX16);
        const float* pool_b = ARGP(9); const float* pool_scale = ARGP(10); const float* subln_g = ARGP(12);
        if (wave < 4) for (int tile = blockIdx.x; tile < NLAT / 32; tile += G) att::pool_item(tile, wave, (const bf16*)(ws + WS_ZP16), pwT16, pool_b, pool_scale, mix16, lane);
        const float lam = *(const float*)(ws + WS_LAM);
        for (int u = blockIdx.x; u < 768; u += G) {
            int bh, qb;
            if (G == 256) { const int i = u >> 8, c = u & 255, xcd = c & 7, j = c >> 3; bh = i * 16 + xcd * 2 + (j >> 4); qb = j & 15; }
            else { bh = u >> 4; qb = u & 15; }
            att::attn_unit(bh / NH, bh % NH, qb, (const bf16*)(ws + WS_Q16), (const bf16*)(ws + WS_K16), (const bf16*)(ws + WS_V16), mix16, lam, subln_g, (char*)lds + RING_OFF);
        }
    }
    SEAM(3);
    if (IN(4)) for (int rp = 0; rp < PROBE_REP(4); ++rp) { if (rp) xcd_barrier(bar);
        pg8::Gemm g{(const bf16*)(ws + WS_MIX16), Wt_out, NLAT, D, D};
        pg8::StaticOrder S; S.init(NLAT, D, G, (int)blockIdx.x);
        pg8::EpiOutProj E{ARGP(0), mod, ARG_OUT, (float*)(ws + WS_SSQ)};
        pg8::gemm_phase<pg8::EpiOutProj, pg8::StaticOrder, true, true>(ldsl + RING_OFF, g, S, E);
    }
    SEAM(4);
    if (IN(5)) for (int rp = 0; rp < PROBE_REP(5); ++rp) { if (rp) xcd_barrier(bar);
        PHASE_IDS();
        const float* norm2_g = ARGP(14); float* xo = ARG_OUT; bf16* f16 = (bf16*)(ws + WS_F16);
        const float* sh2 = mod + (size_t)(blockIdx.x >> 6) * (6 * D) + 3 * D; const float* sc2 = sh2 + D;
#pragma unroll 1
        for (int j = 0; j < 4; ++j) { const int row = blockIdx.x * 32 + wave * 4 + j;
            const float p = lane < 32 ? ssq[(size_t)row * 32 + lane] : 0.f;
            const float rstd = 1.0f / sqrtf(wave_sum(p) * (1.0f / D) + EPS);
            norm_row_bf16(xo + (size_t)row * D, norm2_g, [=](int which, int col) { return *(const f32x4*)((which ? sc2 : sh2) + col); }, f16 + (size_t)row * D, lane, rstd, true); }
    }
    SEAM(5);
    if (IN(6)) for (int rp = 0; rp < PROBE_REP(6); ++rp) { if (rp) xcd_barrier(bar);
        pg8::Gemm g{(const bf16*)(ws + WS_F16), Wt_q, NLAT, D, D};
        pg8::StaticOrder S; S.init(NLAT, D, G, (int)blockIdx.x);
        pg8::EpiBf16Plain E{(bf16*)(ws + WS_QP16), D};
        pg8::gemm_phase<pg8::EpiBf16Plain, pg8::StaticOrder, true, true>(ldsl + RING_OFF, g, S, E);
    }
    SEAM(6);
    if (IN(7)) for (int rp = 0; rp < PROBE_REP(7); ++rp) { if (rp) xcd_barrier(bar);
        PHASE_IDS();
        for (int unit = gw; unit < (NLAT / 32) * PH; unit += NGW)
            peer::topk_unit((unit >> 3) * 32, unit & 7, (const bf16*)(ws + WS_QP16), (const bf16*)(ws + WS_KEYS16), (const float*)(ws + WS_SU), (const float*)(ws + WS_SV),
                            (int*)(ws + WS_EIDX), (float*)(ws + WS_EGATE), (float*)(ws + WS_ESU), ldsl + RING_OFF + wave * 1024, lane);
    }
    if (IN(7) && 8 < hi) { asm volatile("s_waitcnt vmcnt(0)" ::: "memory"); __syncthreads();
        if (threadIdx.x == 0) { __builtin_amdgcn_fence(__ATOMIC_ACQUIRE, "agent"); asm volatile("s_waitcnt vmcnt(0)" ::: "memory"); }
        __syncthreads(); }
    if (IN(8)) for (int rp = 0; rp < PROBE_REP(8); ++rp) { if (rp) xcd_barrier(bar);
        PHASE_IDS();
        const float* fgp = ARGP(19); float* xo = ARG_OUT; float* xo2 = args.pad ? (float*)(ws + WS_ZF) : xo;
        { const int t0 = gw * 4;
          if (t0 < NLAT) peer::peer_wave4(t0, (const bf16*)(ws + WS_F16), (const int*)(ws + WS_EIDX), (const float*)(ws + WS_EGATE), (const float*)(ws + WS_ESU),
                             ws + WS_U8, ws + WS_V8, mod + (size_t)(t0 >> 11) * (6 * D) + 5 * D, fgp, xo, xo2, (LAS unsigned*)(ldsl + RING_OFF + wave * 8192), lane, args.pad); }
    }
#undef IN
#undef SEAM
#undef mod
#undef rope
#undef adap
#undef ssq
#undef Wt_in
#undef Wt_out
#undef Wt_q
#undef pwT16
}
extern "C" void kernel_launch(void* const* d_in, const int* in_sizes, int n_in, void* d_out, int out_size, void* d_ws, size_t ws_size, hipStream_t stream) {
    static int grid = 0;
    if (grid == 0) {
        if (n_in != 20 || out_size != NLAT * D || ws_size < WS_END) { fprintf(stderr, "kernel_launch: unexpected shapes (n_in %d out %d ws %zu)\n", n_in, out_size, ws_size); grid = -1; return; }
        int dev = 0, cus = 0, per_cu = 0;
        if (hipGetDevice(&dev) != hipSuccess || hipDeviceGetAttribute(&cus, hipDeviceAttributeMultiprocessorCount, dev) != hipSuccess) { grid = -1; return; }
        if (hipFuncSetAttribute((const void*)mega, hipFuncAttributeMaxDynamicSharedMemorySize, LDS_BYTES) != hipSuccess) { fprintf(stderr, "kernel_launch: hipFuncSetAttribute failed\n"); grid = -1; return; }
        if (hipOccupancyMaxActiveBlocksPerMultiprocessor(&per_cu, (const void*)mega, NWAVES * 64, LDS_BYTES) != hipSuccess || per_cu < 1) { fprintf(stderr, "kernel_launch: occupancy query says %d blocks per CU\n", per_cu); grid = -1; (void)hipGetLastError(); return; }
        (void)hipGetLastError();
        if (cus < 256) { fprintf(stderr, "kernel_launch: needs 256 CUs, device has %d\n", cus); grid = -1; return; }
        grid = 256;
    }
    if (grid < 0) return;
    unsigned char* ws = (unsigned char*)d_ws;
    (void)hipMemsetAsync(ws + WS_CTL, 0, CTL_ZERO_BYTES, stream);
    Args a{};
    for (int i = 0; i < 20; ++i) a.in[i] = (const float*)d_in[i];
    a.out = (float*)d_out; a.ws = ws;
#ifndef PROBE_PAD
#define PROBE_PAD 1
#endif
#ifndef PROBE_PHASE
    a.ph_lo = 0; a.ph_hi = 9; a.li = 0;
    hipLaunchKernelGGL(mega, dim3(grid), dim3(NWAVES * 64), LDS_BYTES, stream, a);
#else
    if (PROBE_PHASE > 0) { a.ph_lo = 0; a.ph_hi = PROBE_PHASE; a.li = 0; hipLaunchKernelGGL(mega, dim3(grid), dim3(NWAVES * 64), LDS_BYTES, stream, a); }
    for (int r = 0; r < PROBE_TIMES; ++r) { a.ph_lo = PROBE_PHASE; a.ph_hi = PROBE_PHASE + 1; a.li = 1; a.pad = (PROBE_PHASE == 8 && r + 1 < PROBE_TIMES) ? PROBE_PAD : 0;
        hipLaunchKernelGGL(mega, dim3(grid), dim3(NWAVES * 64), LDS_BYTES, stream, a); }
    a.pad = 0;
    if (PROBE_PHASE < 8) { a.ph_lo = PROBE_PHASE + 1; a.ph_hi = 9; a.li = 2; hipLaunchKernelGGL(mega, dim3(grid), dim3(NWAVES * 64), LDS_BYTES, stream, a); }
#endif
}
```
